# Optimizing an MI355X kernel written in HIP

```python
import math
import jax
import jax.numpy as jnp
from jax import lax
import numpy as np

D_MODEL = 1024
BATCH = 4
SEQ = 4096
DEPTH = 1

GRID_W = 64
CTX_LEN = 256
D_MIX = D_MODEL
D_RWKV = D_MIX // 2
RWKV_HEAD = 64
RWKV_HEADS = D_RWKV // RWKV_HEAD
D_S5 = D_MIX - D_RWKV
S5_GROUP = 16
S5_GROUPS = D_S5 // S5_GROUP
S5_STATE = 64
DECAY_LORA = 32
AAA_LORA = 32
GATE_LORA = 96
D_FF = ((8 * D_MODEL + 3 * 256 - 1) // (3 * 256)) * 256
IN_SPLITS = (D_RWKV, D_RWKV, D_RWKV, DECAY_LORA, DECAY_LORA, AAA_LORA, AAA_LORA, GATE_LORA, D_S5)
D_IN = sum(IN_SPLITS)
N_MOD = 6
NORM_EPS = 1e-6
RWKV_LN_EPS = 64e-5

kernel_name = "hybrid_rwkv7_s5_prefix_dit_block"


def rmsnorm(x, g):
    xf = x.astype(jnp.float32)
    y = xf * lax.rsqrt(jnp.mean(xf * xf, axis=-1, keepdims=True) + NORM_EPS)
    return (y * g.astype(jnp.float32)).astype(x.dtype)


def modulate(h, shift, scale):
    return h * (1 + scale) + shift


def split_proj(z):
    return jnp.split(z, np.cumsum(IN_SPLITS)[:-1].tolist(), axis=-1)


def swiglu(h, w1, w3, w2):
    return (jax.nn.silu(h @ w1) * (h @ w3)) @ w2


def dwconv3x3(x, w, rows):
    bsz, length, ch = x.shape
    xg = x.reshape(bsz, rows, length // rows, ch)
    y = lax.conv_general_dilated(xg, w[:, :, None, :].astype(x.dtype), (1, 1), "SAME",
                                 dimension_numbers=("NHWC", "HWIO", "NHWC"),
                                 feature_group_count=ch)
    return y.reshape(bsz, length, ch)


def _rwkv_step(state, inp):
    r_t, w_t, k_t, v_t, kk_t, a_t = inp
    sa = jnp.einsum("bhvk,bhk->bhv", state, -kk_t)
    state = (state * w_t[:, :, None, :]
             + sa[..., None] * (kk_t * a_t)[:, :, None, :]
             + v_t[..., None] * k_t[:, :, None, :])
    return state, jnp.einsum("bhvk,bhk->bhv", state, r_t)


def rwkv_scan(r, w, k, v, kk, a, s0, reverse):
    xs = tuple(jnp.moveaxis(t, 1, 0) for t in (r, w, k, v, kk, a))
    s_fin, y = lax.scan(_rwkv_step, s0, xs, reverse=reverse)
    return jnp.moveaxis(y, 0, 1), s_fin


def rwkv_mixer(zr, zk, zv, wd, ad, gd, rows, s0, conv_w, w0, w2, a0, a2, g2, k_k, k_a, r_k,
               ln_w, ln_b, readout):
    f32 = jnp.float32
    bsz, length, _ = zr.shape

    def heads(t):
        return t.reshape(bsz, length, RWKV_HEADS, RWKV_HEAD)

    rkv = dwconv3x3(jnp.concatenate([zr, zk, zv], axis=-1).astype(f32), conv_w.astype(f32), rows)
    r, k, v = jnp.split(rkv, 3, axis=-1)
    kk = heads(k * k_k.astype(f32))
    kk = kk * lax.rsqrt(jnp.maximum(jnp.sum(kk * kk, axis=-1, keepdims=True), 1e-12))
    rh, vh = heads(r), heads(v)
    ys, kds, finals = [], [], []
    for d, reverse in ((0, False), (1, True)):
        logw = -jax.nn.softplus(-(w0[d] + jnp.tanh(wd[d]) @ w2[d]).astype(f32)) - 0.5
        decay = jnp.exp(-jnp.exp(logw))
        a = jax.nn.sigmoid((a0[d] + ad[d] @ a2[d]).astype(f32))
        kd = heads(k * (1 + (a - 1) * k_a.astype(f32)))
        y, s_fin = rwkv_scan(rh, heads(decay), kd, vh, kk, heads(a), s0[d], reverse)
        ys.append(y)
        kds.append(kd)
        finals.append(s_fin)
    if not readout:
        return None, (finals[0], finals[1])
    y = ys[0] + ys[1]
    mu = jnp.mean(y, axis=-1, keepdims=True)
    var = jnp.mean(jnp.square(y - mu), axis=-1, keepdims=True)
    yn = ((y - mu) * lax.rsqrt(var + RWKV_LN_EPS)).reshape(bsz, length, D_RWKV)
    yn = yn * ln_w.astype(f32) + ln_b.astype(f32)
    rk = r_k.astype(f32)
    bonus = jnp.sum(rh * (kds[0] + kds[1]) * rk, axis=-1, keepdims=True)
    yn = yn + (bonus * vh).reshape(bsz, length, D_RWKV)
    g = jax.nn.sigmoid(gd.astype(f32)) @ g2.astype(f32)
    return (yn * g).astype(zr.dtype), (finals[0], finals[1])


def _complex_affine_combine(e1, e2):
    a1r, a1i, b1r, b1i = e1
    a2r, a2i, b2r, b2i = e2
    return (a2r * a1r - a2i * a1i,
            a2r * a1i + a2i * a1r,
            a2r * b1r - a2i * b1i + b2r,
            a2r * b1i + a2i * b1r + b2i)


def s5_discretize(lam_re, lam_im, log_step, b_re, b_im):
    step = jnp.exp(log_step)[:, None]
    mag = jnp.exp(lam_re * step)
    lb_re = mag * jnp.cos(lam_im * step)
    lb_im = mag * jnp.sin(lam_im * step)
    den = lam_re * lam_re + lam_im * lam_im
    nr = lb_re - 1
    q_re = (nr * lam_re + lb_im * lam_im) / den
    q_im = (lb_im * lam_re - nr * lam_im) / den
    bb_re = q_re[..., None] * b_re - q_im[..., None] * b_im
    bb_im = q_re[..., None] * b_im + q_im[..., None] * b_re
    return lb_re, lb_im, bb_re, bb_im


def s5_mixer(u, h0, lam_re, lam_im, log_step, b_re, b_im, c_re, c_im, d_skip, glu_w, glu_b, readout):
    f32 = jnp.float32
    bsz, length, _ = u.shape
    uf = u.astype(f32)
    ug = uf.reshape(bsz, length, S5_GROUPS, S5_GROUP)
    bre, bim = b_re.astype(f32), b_im.astype(f32)
    states, finals = [], []
    for d, reverse in ((0, False), (1, True)):
        lb_re, lb_im, bb_re, bb_im = s5_discretize(lam_re[d].astype(f32), lam_im[d].astype(f32),
                                                   log_step[d].astype(f32), bre, bim)
        bu_re = jnp.einsum("blgh,gph->blgp", ug, bb_re)
        bu_im = jnp.einsum("blgh,gph->blgp", ug, bb_im)
        first, final = (length - 1, 0) if reverse else (0, length - 1)
        h0_re, h0_im = h0[d]
        bu_re = bu_re.at[:, first].add(lb_re * h0_re - lb_im * h0_im)
        bu_im = bu_im.at[:, first].add(lb_re * h0_im + lb_im * h0_re)
        a_re = jnp.broadcast_to(lb_re, bu_re.shape)
        a_im = jnp.broadcast_to(lb_im, bu_im.shape)
        _, _, h_re, h_im = lax.associative_scan(_complex_affine_combine, (a_re, a_im, bu_re, bu_im),
                                                reverse=reverse, axis=1)
        states.append((h_re, h_im))
        finals.append((h_re[:, final], h_im[:, final]))
    if not readout:
        return None, (finals[0], finals[1])
    h_re = states[0][0] + states[1][0]
    h_im = states[0][1] + states[1][1]
    y = (jnp.einsum("blgp,ghp->blgh", h_re, c_re.astype(f32))
         - jnp.einsum("blgp,ghp->blgh", h_im, c_im.astype(f32)))
    y = y.reshape(bsz, length, D_S5) + d_skip.astype(f32) * uf
    z = jax.nn.gelu(y)
    out = z * jax.nn.sigmoid(z @ glu_w.astype(f32) + glu_b.astype(f32))
    return out.astype(u.dtype), (finals[0], finals[1])


def setup_inputs(seed: int = 0) -> dict:
    key = jax.random.key(seed)
    ks = jax.random.split(key, 40)
    f32 = jnp.float32

    def nrm(i, shape, scale):
        return scale * jax.random.normal(ks[i], shape, f32)

    conv_center = jnp.zeros((DEPTH, 3, 3, 3 * D_RWKV), f32).at[:, 1, 1].set(1.0)
    return {
        "x": nrm(0, (BATCH, SEQ, D_MODEL), 1.0),
        "c": nrm(1, (BATCH, D_MODEL), 1.0),
        "ctx": nrm(2, (BATCH, CTX_LEN, D_MODEL), 1.0),
        "c_ctx": nrm(3, (D_MODEL,), 1.0),
        "mod_w": nrm(4, (DEPTH, D_MODEL, N_MOD * D_MODEL), 0.5 * D_MODEL ** -0.5),
        "mod_b": nrm(5, (DEPTH, N_MOD * D_MODEL), 0.02),
        "norm1_g": 1.0 + nrm(6, (DEPTH, D_MODEL), 0.05),
        "norm2_g": 1.0 + nrm(7, (DEPTH, D_MODEL), 0.05),
        "w_in": nrm(8, (DEPTH, D_MODEL, D_IN), D_MODEL ** -0.5),
        "w_out": nrm(9, (DEPTH, D_MIX, D_MODEL), D_MIX ** -0.5),
        "rwkv_conv": conv_center + nrm(10, (DEPTH, 3, 3, 3 * D_RWKV), 0.1),
        "rwkv_w0": -6.0 + 5.0 * jnp.linspace(0.0, 1.0, D_RWKV, dtype=f32) + nrm(11, (DEPTH, 2, D_RWKV), 0.2),
        "rwkv_w2": nrm(12, (DEPTH, 2, DECAY_LORA, D_RWKV), 0.5 * DECAY_LORA ** -0.5),
        "rwkv_a0": nrm(13, (DEPTH, 2, D_RWKV), 0.3),
        "rwkv_a2": nrm(14, (DEPTH, 2, AAA_LORA, D_RWKV), 0.5 * AAA_LORA ** -0.5),
        "rwkv_g2": nrm(15, (DEPTH, GATE_LORA, D_RWKV), GATE_LORA ** -0.5),
        "rwkv_kk": 0.85 + nrm(16, (DEPTH, D_RWKV), 0.05),
        "rwkv_ka": 1.0 + nrm(17, (DEPTH, D_RWKV), 0.05),
        "rwkv_rk": nrm(18, (DEPTH, RWKV_HEADS, RWKV_HEAD), 0.1),
        "rwkv_ln_w": 1.0 + nrm(19, (DEPTH, D_RWKV), 0.05),
        "rwkv_ln_b": nrm(20, (DEPTH, D_RWKV), 0.01),
        "s5_lam_re": -0.5 + nrm(21, (DEPTH, 2, S5_GROUPS, S5_STATE), 0.01),
        "s5_lam_im": math.pi * jnp.arange(S5_STATE, dtype=f32) + nrm(22, (DEPTH, 2, S5_GROUPS, S5_STATE), 0.01),
        "s5_log_step": jax.random.uniform(ks[23], (DEPTH, 2, S5_GROUPS), f32,
                                          minval=math.log(1e-3), maxval=math.log(1e-1)),
        "s5_b_re": nrm(24, (DEPTH, S5_GROUPS, S5_STATE, S5_GROUP), (2 * S5_GROUP) ** -0.5),
        "s5_b_im": nrm(25, (DEPTH, S5_GROUPS, S5_STATE, S5_GROUP), (2 * S5_GROUP) ** -0.5),
        "s5_c_re": nrm(26, (DEPTH, S5_GROUPS, S5_GROUP, S5_STATE), S5_STATE ** -0.5),
        "s5_c_im": nrm(27, (DEPTH, S5_GROUPS, S5_GROUP, S5_STATE), S5_STATE ** -0.5),
        "s5_d": nrm(28, (DEPTH, D_S5), 1.0),
        "s5_glu_w": nrm(29, (DEPTH, D_S5, D_S5), D_S5 ** -0.5),
        "s5_glu_b": nrm(30, (DEPTH, D_S5), 0.01),
        "ffn_w1": nrm(31, (DEPTH, D_MODEL, D_FF), D_MODEL ** -0.5),
        "ffn_w3": nrm(32, (DEPTH, D_MODEL, D_FF), D_MODEL ** -0.5),
        "ffn_w2": nrm(33, (DEPTH, D_FF, D_MODEL), D_FF ** -0.5),
        "final_g": 1.0 + nrm(34, (D_MODEL,), 0.05),
    }


def reference(x, c, ctx, c_ctx, mod_w, mod_b, norm1_g, norm2_g, w_in, w_out, rwkv_conv, rwkv_w0,
              rwkv_w2, rwkv_a0, rwkv_a2, rwkv_g2, rwkv_kk, rwkv_ka, rwkv_rk, rwkv_ln_w, rwkv_ln_b,
              s5_lam_re, s5_lam_im, s5_log_step, s5_b_re, s5_b_im, s5_c_re, s5_c_im, s5_d, s5_glu_w,
              s5_glu_b, ffn_w1, ffn_w3, ffn_w2, final_g):
    f32 = jnp.float32
    bsz, length, _ = x.shape
    rows = length // GRID_W
    zero_rwkv = jnp.zeros((bsz, RWKV_HEADS, RWKV_HEAD, RWKV_HEAD), f32)
    zero_s5 = jnp.zeros((bsz, S5_GROUPS, S5_STATE), f32)
    for layer in range(DEPTH):
        last = layer == DEPTH - 1
        mod_x = jnp.split((jax.nn.silu(c) @ mod_w[layer] + mod_b[layer])[:, None, :], N_MOD, axis=-1)
        mod_c = jnp.split(jax.nn.silu(c_ctx) @ mod_w[layer] + mod_b[layer], N_MOD, axis=-1)
        z_x = split_proj(modulate(rmsnorm(x, norm1_g[layer]), mod_x[0], mod_x[1]) @ w_in[layer])
        z_c = split_proj(modulate(rmsnorm(ctx, norm1_g[layer]), mod_c[0], mod_c[1]) @ w_in[layer])

        def run_rwkv(z, grid_rows, s0, readout):
            return rwkv_mixer(z[0], z[1], z[2], (z[3], z[4]), (z[5], z[6]), z[7], grid_rows, s0,
                              rwkv_conv[layer], rwkv_w0[layer], rwkv_w2[layer], rwkv_a0[layer],
                              rwkv_a2[layer], rwkv_g2[layer], rwkv_kk[layer], rwkv_ka[layer],
                              rwkv_rk[layer], rwkv_ln_w[layer], rwkv_ln_b[layer], readout)

        def run_s5(z, h0, readout):
            return s5_mixer(z[8], h0, s5_lam_re[layer], s5_lam_im[layer], s5_log_step[layer],
                            s5_b_re[layer], s5_b_im[layer], s5_c_re[layer], s5_c_im[layer],
                            s5_d[layer], s5_glu_w[layer], s5_glu_b[layer], readout)

        rwkv_c, rwkv_state = run_rwkv(z_c, 1, (zero_rwkv, zero_rwkv), not last)
        s5_c, s5_state = run_s5(z_c, ((zero_s5, zero_s5), (zero_s5, zero_s5)), not last)
        rwkv_x, _ = run_rwkv(z_x, rows, rwkv_state, True)
        s5_x, _ = run_s5(z_x, s5_state, True)

        x = x + mod_x[2] * (jnp.concatenate([rwkv_x, s5_x], axis=-1) @ w_out[layer])
        x = x + mod_x[5] * swiglu(modulate(rmsnorm(x, norm2_g[layer]), mod_x[3], mod_x[4]),
                                  ffn_w1[layer], ffn_w3[layer], ffn_w2[layer])
        if not last:
            ctx = ctx + mod_c[2] * (jnp.concatenate([rwkv_c, s5_c], axis=-1) @ w_out[layer])
            ctx = ctx + mod_c[5] * swiglu(modulate(rmsnorm(ctx, norm2_g[layer]), mod_c[3], mod_c[4]),
                                          ffn_w1[layer], ffn_w3[layer], ffn_w2[layer])
    return rmsnorm(x, final_g)
```

```cpp
#include <hip/hip_runtime.h>
#include <hip/hip_cooperative_groups.h>
#include <cstdio>
namespace cg = cooperative_groups;

#define LAS __attribute__((address_space(3)))
typedef unsigned short bf16_t;
typedef short bf16x8 __attribute__((ext_vector_type(8)));
typedef float f32x4 __attribute__((ext_vector_type(4)));
typedef float f32x2 __attribute__((ext_vector_type(2)));
typedef unsigned u32x4 __attribute__((ext_vector_type(4)));
typedef unsigned u32x2 __attribute__((ext_vector_type(2)));

constexpr int NTHREADS = 512;
constexpr int LDS_BYTES = 131072 + 4096;
constexpr int DM = 1024, BATCH = 4, SEQ = 4096, CTXL = 256;
constexpr int NTL = BATCH * SEQ, NTC = BATCH * CTXL, NTOK = NTL + NTC;
constexpr int DIN = 2272, DINP = 2304, ZLD = 1792;
constexpr int COL_K = 512, COL_V = 1024, COL_WD = 1536, COL_AD = 1600, COL_GD = 1664, COL_U = 1760;
constexpr int DFF = 2816;
constexpr int S5C = 32;
constexpr int S5ROWS = 768;
constexpr int S5EROWS = 544;
constexpr int S5K1 = 768;

constexpr size_t al256(size_t x) { return (x + 255) & ~(size_t)255; }
constexpr size_t WS_CTL   = 0;
constexpr size_t CTL_BYTES = 65536;
constexpr size_t WS_MOD   = CTL_BYTES;
constexpr size_t WS_WTIN  = al256(WS_MOD + (size_t)5 * 6144 * 4);
constexpr size_t WS_WTOUT = al256(WS_WTIN + (size_t)DINP * DM * 2);
constexpr size_t WS_WT13  = al256(WS_WTOUT + (size_t)DM * DM * 2);
constexpr size_t WS_WT2   = al256(WS_WT13 + (size_t)2 * DFF * DM * 2);
constexpr size_t WS_WTGLU = al256(WS_WT2 + (size_t)DM * DFF * 2);
constexpr size_t WS_S5TAB = al256(WS_WTGLU + (size_t)512 * 512 * 2);
constexpr size_t WS_KT    = al256(WS_S5TAB + (size_t)2 * 32 * 64 * 2 * 4);
constexpr size_t WS_W2T   = al256(WS_KT + (size_t)32 * 16384 * 4);
constexpr size_t WS_BON   = al256(WS_W2T + (size_t)2 * 2 * 512 * 32 * 2);
constexpr size_t WS_ZG    = al256(WS_BON + (size_t)2 * NTL * 8 * 4);
constexpr size_t WS_HMOD  = al256(WS_ZG + (size_t)NTL * 512 * 2);
constexpr size_t WS_Z     = al256(WS_HMOD + (size_t)NTOK * DM * 2);
constexpr size_t WS_AALL  = al256(WS_Z + (size_t)NTOK * ZLD * 2);
constexpr size_t WS_BT1   = al256(WS_AALL + (size_t)32 * S5ROWS * S5K1 * 2);
constexpr size_t WS_BT2   = al256(WS_BT1 + (size_t)32 * 512 * S5K1 * 2);
constexpr size_t WS_E     = al256(WS_BT2 + (size_t)32 * 256 * 512 * 2);
constexpr size_t WS_S5END = al256(WS_E + (size_t)32 * S5EROWS * 256 * 4);
constexpr size_t WS_SIG   = WS_S5END;
constexpr size_t WS_G2T   = al256(WS_SIG + (size_t)NTL * 256 * 2);
constexpr size_t WS_GATE  = al256(WS_G2T + (size_t)512 * 256 * 2);
constexpr size_t WS_XBUF  = al256(WS_GATE + (size_t)NTL * 512 * 2);
constexpr size_t WS_END2  = al256(WS_XBUF + (size_t)2 * 64 * 256 * 4 * 4);
constexpr size_t WS_ACT   = WS_Z;

constexpr size_t WS_END = WS_END2;
static_assert(WS_ACT + (size_t)NTL * DFF * 2 <= WS_S5END, "ACT alias");

#ifndef PROBE_RPT
#define PROBE_RPT 0
#endif
struct Args { const float* in[35]; float* out; unsigned char* ws; int ph_lo, ph_hi; };

typedef __bf16 bf16x2_t __attribute__((ext_vector_type(2)));
__device__ __forceinline__ unsigned pk2(float lo, float hi) { const f32x2 v = {lo, hi}; return __builtin_bit_cast(unsigned, __builtin_convertvector(v, bf16x2_t)); }
__device__ __forceinline__ unsigned f2bf(float f) { return pk2(f, f) & 0xffffu; }
__device__ __forceinline__ float bflo(unsigned w) { return __builtin_bit_cast(float, w << 16); }
__device__ __forceinline__ float bfhi(unsigned w) { return __builtin_bit_cast(float, w & 0xffff0000u); }
__device__ __forceinline__ float bf2f(bf16_t b) { return __builtin_bit_cast(float, ((unsigned)b) << 16); }
__device__ __forceinline__ float wave_sum(float v) {
#pragma unroll
    for (int o = 1; o < 64; o <<= 1) v += __shfl_xor(v, o);
    return v;
}
template <int CTRL> __device__ __forceinline__ float dppf(float v) { return __builtin_bit_cast(float, __builtin_amdgcn_update_dpp(0, __builtin_bit_cast(int, v), CTRL, 0xf, 0xf, false)); }
__device__ __forceinline__ float row16_sum(float v) { v += dppf<0x128>(v); v += dppf<0x124>(v); v += dppf<0x122>(v); v += dppf<0x121>(v); return v; }
__device__ __forceinline__ int opaque_tid() { int t = threadIdx.x; asm volatile("" : "+v"(t)); return t; }
__device__ __forceinline__ float sigmoidf_(float x) { return __builtin_amdgcn_rcpf(1.0f + __expf(-x)); }
__device__ __forceinline__ float siluf_(float x) { return x * __builtin_amdgcn_rcpf(1.0f + __expf(-x)); }
__device__ __forceinline__ float tanh_fast(float x) { return 1.0f - 2.0f * __builtin_amdgcn_rcpf(1.0f + __expf(2.0f * x)); }
__device__ __forceinline__ float gelu_tanh(float x) { const float u = 0.7978845608028654f * (x + 0.044715f * x * x * x); return x - x * __builtin_amdgcn_rcpf(1.0f + __expf(2.0f * u)); }

#define XB_TMO      128
#define XB_XCNT(j)  (256  + 64 * (j))
#define XB_XSUB(j)  (1280 + 64 * (j))
#define XB_XGEN(j)  (2304 + 64 * (j))
#define XB_TOP      3328
#define XB_TOPGEN   3392
#define XCD_BAR_WORDS 3456
#define XB_SPIN_CAP (1u << 20)
static_assert(XCD_BAR_WORDS * 4 <= CTL_BYTES, "ctl");
__device__ __forceinline__ unsigned xb_ld(unsigned* p)              { return __hip_atomic_load(p, __ATOMIC_RELAXED, __HIP_MEMORY_SCOPE_AGENT); }
__device__ __forceinline__ unsigned xb_add(unsigned* p, unsigned v) { return __hip_atomic_fetch_add(p, v, __ATOMIC_RELAXED, __HIP_MEMORY_SCOPE_AGENT); }
__device__ __forceinline__ unsigned xb_xcc_id() { return (unsigned)__builtin_amdgcn_s_getreg((3 << 11) | 20) & 0xFu; }
#define XB_SPIN(cond, bar) do { unsigned _sp = 0; while (cond) { __builtin_amdgcn_s_sleep(1); \
    if ((++_sp & 255u) == 0u) { if (xb_ld(&(bar)[XB_TMO])) break; if (_sp > XB_SPIN_CAP) { atomicAdd(&(bar)[XB_TMO], 1u); break; } } } } while (0)
struct XcdBarrier { unsigned* bar; unsigned x; volatile LAS unsigned* st; };
__device__ __forceinline__ XcdBarrier xcd_barrier_post(unsigned* bar, volatile LAS unsigned* st) {
    XcdBarrier b; b.bar = bar; b.x = xb_xcc_id(); b.st = st;
    if (threadIdx.x == 0) (void)xb_add(&bar[XB_XCNT(b.x)], 1u);
    return b;
}
__device__ __forceinline__ void xcd_barrier_complete(unsigned* bar, unsigned x, unsigned& nloc, unsigned& nx) {
    const unsigned G = gridDim.x * gridDim.y * gridDim.z;
    unsigned sum, cnt, mine, sp = 0u;
    for (;;) {
        sum = 0u; cnt = 0u; mine = 0u;
#pragma unroll
        for (unsigned j = 0; j < 16; ++j) { const unsigned c = xb_ld(&bar[XB_XCNT(j)]); sum += c; cnt += (c > 0u) ? 1u : 0u; mine = (j == x) ? c : mine; }
        if (sum == G) break;
        __builtin_amdgcn_s_sleep(1);
        if ((++sp & 255u) == 0u) { if (xb_ld(&bar[XB_TMO])) break; if (sp > XB_SPIN_CAP) { atomicAdd(&bar[XB_TMO], 1u); break; } }
    }
    nloc = mine > 0u ? mine : 1u; nx = cnt > 0u ? cnt : 1u;
}
__device__ __forceinline__ void xcd_barrier(const XcdBarrier& b) {
    asm volatile("s_waitcnt vmcnt(0)" ::: "memory");
    __syncthreads();
    if (threadIdx.x == 0) {
        unsigned* bar = b.bar;
        __builtin_amdgcn_s_waitcnt(0);
        unsigned nloc = b.st[0], nx = b.st[1];
        if (nloc == 0u) { xcd_barrier_complete(bar, b.x, nloc, nx); b.st[0] = nloc; b.st[1] = nx; }
        const unsigned old = xb_add(&bar[XB_XSUB(b.x)], 1u);
        const unsigned gen = old / nloc;
        if (old + 1u == (gen + 1u) * nloc) {
            __builtin_amdgcn_fence(__ATOMIC_RELEASE, "agent");
            asm volatile("s_waitcnt vmcnt(0)" ::: "memory");
            const unsigned og = xb_add(&bar[XB_TOP], 1u);
            const unsigned tg = og / nx;
            if (og + 1u == (tg + 1u) * nx) xb_add(&bar[XB_TOPGEN], 1u);
            else XB_SPIN(xb_ld(&bar[XB_TOPGEN]) == tg, bar);
            __builtin_amdgcn_fence(__ATOMIC_ACQUIRE, "agent");
            xb_add(&bar[XB_XGEN(b.x)], 1u);
            asm volatile("s_waitcnt vmcnt(0)" ::: "memory");
        } else {
            XB_SPIN(xb_ld(&bar[XB_XGEN(b.x)]) == gen, bar);
            __builtin_amdgcn_fence(__ATOMIC_ACQUIRE, "agent");
            asm volatile("s_waitcnt vmcnt(0)" ::: "memory");
        }
    }
    __syncthreads();
}

namespace pg8 {
constexpr int BM = 256, BK = 64, HALF = 128, HTB = HALF * BK * 2, STAGE_BYTES = 8 * HTB, NXCD = 8, WGM = 8;
__host__ __device__ __forceinline__ int lds_byte(int r, int c) { const int st = (r >> 4) * 2 + (c >> 5), rr = r & 15, cc = c & 31, ob = rr * 64 + cc * 2; return st * 1024 + (ob ^ (((ob >> 9) & 1) << 5)); }
__host__ __device__ __forceinline__ void stage_rc(int b, int& R, int& C) { const int st = b / 1024, sb = b % 1024, swz = sb ^ (((sb >> 9) & 1) << 5); R = (st >> 1) * 16 + swz / 64; C = (st & 1) * 32 + (swz % 64) / 2; }
__host__ __device__ __forceinline__ int perm32(int rho) { const int n = rho >> 4, i = rho & 15; return 8 * (i >> 2) + 4 * n + (i & 3); }
struct Unit { int pm, pn; };
struct Gemm { const bf16_t* A; const bf16_t* Bt; int lda, ldb, K; };
struct StaticOrder {
    int nM, nN, nwg, G, c;
    __device__ void init(int M, int N, int G_, int c_) { nM = M / BM; nN = N / BM; nwg = nM * nN; G = G_; c = c_; }
    __device__ bool next(int i, Unit& u) const {
        const long L = (long)i * G + c; if (L >= nwg) return false;
        int wgid = (int)L; { const int q = nwg / NXCD, r = nwg % NXCD, xcd = wgid % NXCD, off = wgid / NXCD; wgid = (xcd < r ? xcd * (q + 1) : r * (q + 1) + (xcd - r) * q) + off; }
        const int nig = WGM * nN, gid = wgid / nig, fm = gid * WGM, gsz = (nM - fm) < WGM ? (nM - fm) : WGM;
        u.pm = fm + ((wgid % nig) % gsz); u.pn = (wgid % nig) / gsz; return true;
    }
};
struct S5Order2 { int G, c; __device__ bool next(int i, Unit& u) const { const int L = i * G + c; if (L >= 96) return false; const int g = L / 3; u.pm = g * 3 + L % 3; u.pn = g; return true; } };
struct S5Order1 { int G, c; __device__ bool next(int i, Unit& u) const { const int L = i * G + c; if (L >= 128) return false; const int g = L >> 2; u.pm = g * 3 + ((L >> 1) & 1); u.pn = g * 2 + (L & 1); return true; } };

template <class Epi, class Sched>
__device__ __forceinline__ void gemm_phase(LAS unsigned char* lds, const Gemm g, const Sched& S, const Epi& E) {
    int tid_ = threadIdx.x; asm volatile("" : "+v"(tid_));
    const int tid = tid_, wid = __builtin_amdgcn_readfirstlane(tid >> 6), lane = tid & 63, wr = wid >> 2, wc = wid & 3, fr = lane & 15, fq = lane >> 4;
    const int K = g.K, nt = K / BK;
    unsigned voffA[2], voffB[2];
#pragma unroll
    for (int i = 0; i < 2; ++i) { int R, C; stage_rc(tid * 16 + i * 8192, R, C); const int Rb = Epi::PERM ? ((R & ~31) + perm32(R & 31)) : R;
        voffA[i] = (unsigned)(R * g.lda + C) * 2u; voffB[i] = (unsigned)(Rb * g.ldb + C) * 2u; }
    const size_t kstep = (size_t)(BK * 2);
    const size_t hstepA = (size_t)HALF * g.lda * 2, hstepB = (size_t)HALF * g.ldb * 2;
    const size_t tstepA = 2 * hstepA, tstepB = 2 * hstepB;
    const unsigned ldsw = (unsigned)wid * 1024u;
    const int aoff = lds_byte(wr * 64 + fr, fq * 8), boff = lds_byte(wc * 32 + fr, fq * 8);
#define PG8_SA(b, h) (((b) * 2 + (h)) * HTB)
#define PG8_SB(b, h) ((4 + (b) * 2 + (h)) * HTB)
#define PG8_STAGE(bufoff, gbase, voff) do { _Pragma("unroll") for (int _i = 0; _i < 2; ++_i) \
        __builtin_amdgcn_global_load_lds((const unsigned*)((const char*)(gbase) + (voff)[_i]), (LAS unsigned*)(lds + (bufoff) + ldsw + _i * 8192), 16, 0, 0); } while (0)
#define PG8_LDA(dst, b, h) do { _Pragma("unroll") for (int m = 0; m < 4; ++m) _Pragma("unroll") for (int k = 0; k < 2; ++k) dst[m][k] = *(const LAS bf16x8*)(lds + PG8_SA(b, h) + aoff + m * 2048 + k * 1024); } while (0)
#define PG8_LDB(dst, b, h) do { _Pragma("unroll") for (int n = 0; n < 2; ++n) _Pragma("unroll") for (int k = 0; k < 2; ++k) dst[n][k] = *(const LAS bf16x8*)(lds + PG8_SB(b, h) + boff + n * 2048 + k * 1024); } while (0)
#define PG8_MMA(ai, bj, At, Bt) do { __builtin_amdgcn_s_setprio(1); _Pragma("unroll") for (int m = 0; m < 4; ++m) _Pragma("unroll") for (int n = 0; n < 2; ++n) _Pragma("unroll") for (int k = 0; k < 2; ++k) \
        acc[ai][bj][m][n] = __builtin_amdgcn_mfma_f32_16x16x32_bf16(Bt[n][k], At[m][k], acc[ai][bj][m][n], 0, 0, 0); __builtin_amdgcn_s_setprio(0); } while (0)
#define PG8_WAIT_V(n) asm volatile("s_waitcnt vmcnt(" #n ")" ::: "memory")
#define PG8_WAIT_L(n) asm volatile("s_waitcnt lgkmcnt(" #n ")" ::: "memory")
#define PG8_BAR __builtin_amdgcn_s_barrier()
#define PG8_SCHED __builtin_amdgcn_sched_barrier(0)
    Unit cur, nxt; int ui = 0;
    if (!S.next(0, cur)) return;
    f32x4 acc[2][2][4][2];
#pragma unroll
    for (int a = 0; a < 2; ++a)
#pragma unroll
        for (int b = 0; b < 2; ++b)
#pragma unroll
            for (int m = 0; m < 4; ++m)
#pragma unroll
                for (int n = 0; n < 2; ++n) acc[a][b][m][n] = (f32x4){0.f, 0.f, 0.f, 0.f};
    bf16x8 At[4][2], B0[2][2], B1[2][2];
    const char* cA = (const char*)g.A + (size_t)cur.pm * tstepA; const char* cB = (const char*)g.Bt + (size_t)cur.pn * tstepB;
    PG8_STAGE(PG8_SB(0, 0), cB, voffB); PG8_STAGE(PG8_SA(0, 0), cA, voffA); PG8_STAGE(PG8_SB(0, 1), cB + hstepB, voffB); PG8_STAGE(PG8_SA(0, 1), cA + hstepA, voffA);
    if (wr == 1) PG8_BAR;
    PG8_WAIT_V(4); PG8_BAR;
    PG8_STAGE(PG8_SB(1, 0), cB + kstep, voffB); PG8_STAGE(PG8_SA(1, 0), cA + kstep, voffA); PG8_STAGE(PG8_SB(1, 1), cB + hstepB + kstep, voffB);
    PG8_WAIT_V(6); PG8_BAR;
    for (;;) {
        const bool has_next = S.next(ui + 1, nxt);
        const char* nA = has_next ? (const char*)g.A + (size_t)nxt.pm * tstepA : cA; const char* nB = has_next ? (const char*)g.Bt + (size_t)nxt.pn * tstepB : cB;
        for (int t = 0; t < nt; t += 2) {
            const bool last = (t == nt - 2);
            const char* a1 = cA + (size_t)(t + 1) * kstep;
            const char* a2 = last ? nA : cA + (size_t)(t + 2) * kstep; const char* b2 = last ? nB : cB + (size_t)(t + 2) * kstep;
            const char* a3 = a2 + kstep; const char* b3 = b2 + kstep;
            PG8_LDB(B0, 0, 0); PG8_SCHED; PG8_LDA(At, 0, 0); PG8_STAGE(PG8_SA(1, 1), a1 + hstepA, voffA);
            PG8_WAIT_L(8); PG8_BAR; PG8_WAIT_L(0); PG8_MMA(0, 0, At, B0); PG8_BAR; PG8_SCHED;
            PG8_LDB(B1, 0, 1); PG8_STAGE(PG8_SB(0, 0), b2, voffB);
            PG8_BAR; PG8_WAIT_L(0); PG8_MMA(0, 1, At, B1); PG8_BAR;
            PG8_LDA(At, 0, 1); PG8_STAGE(PG8_SA(0, 0), a2, voffA);
            PG8_BAR; PG8_WAIT_L(0); PG8_MMA(1, 0, At, B0); PG8_BAR; PG8_SCHED;
            PG8_STAGE(PG8_SB(0, 1), b2 + hstepB, voffB);
            PG8_WAIT_V(6); PG8_BAR; PG8_MMA(1, 1, At, B1); PG8_BAR;
            PG8_LDB(B0, 1, 0); PG8_SCHED; PG8_LDA(At, 1, 0); PG8_STAGE(PG8_SA(0, 1), a2 + hstepA, voffA);
            PG8_WAIT_L(8); PG8_BAR; PG8_WAIT_L(0); PG8_MMA(0, 0, At, B0); PG8_BAR; PG8_SCHED;
            PG8_LDB(B1, 1, 1); PG8_STAGE(PG8_SB(1, 0), b3, voffB);
            PG8_BAR; PG8_WAIT_L(0); PG8_MMA(0, 1, At, B1); PG8_BAR;
            PG8_LDA(At, 1, 1); PG8_STAGE(PG8_SA(1, 0), a3, voffA);
            PG8_BAR; PG8_WAIT_L(0); PG8_MMA(1, 0, At, B0); PG8_BAR; PG8_SCHED;
            PG8_STAGE(PG8_SB(1, 1), b3 + hstepB, voffB);
            PG8_WAIT_V(6); PG8_BAR; PG8_MMA(1, 1, At, B1); PG8_BAR;
        }
        if constexpr (!Epi::AFTER_DRAIN) E(acc, cur, wr, wc, fr, fq);
        if (!has_next) break;
#pragma unroll
        for (int a = 0; a < 2; ++a)
#pragma unroll
            for (int b = 0; b < 2; ++b)
#pragma unroll
                for (int m = 0; m < 4; ++m)
#pragma unroll
                    for (int n = 0; n < 2; ++n) acc[a][b][m][n] = (f32x4){0.f, 0.f, 0.f, 0.f};
        cur = nxt; cA = nA; cB = nB; ++ui;
    }
    PG8_WAIT_V(0);
    if (wr == 0) PG8_BAR;
    PG8_BAR;
    if constexpr (Epi::AFTER_DRAIN) E.fused(acc, cur, wr, wc, fr, fq, lds, wid, lane);
#undef PG8_SA
#undef PG8_SB
#undef PG8_STAGE
#undef PG8_LDA
#undef PG8_LDB
#undef PG8_MMA
#undef PG8_WAIT_V
#undef PG8_WAIT_L
#undef PG8_BAR
#undef PG8_SCHED
}
typedef f32x4 Acc[2][2][4][2];

__device__ __forceinline__ u32x4 pack8(const f32x4 v0, const f32x4 v1) { u32x4 w; w.x = pk2(v0[0], v0[1]); w.y = pk2(v0[2], v0[3]); w.z = pk2(v1[0], v1[1]); w.w = pk2(v1[2], v1[3]); return w; }

struct EpiZ {
    static constexpr bool PERM = true, AFTER_DRAIN = false;
    bf16_t* Z; bf16_t* Aall; bf16_t* SIG;
    __device__ __forceinline__ void operator()(const Acc& acc, const Unit& u, int wr, int wc, int fr, int fq) const {
#pragma unroll
        for (int ai = 0; ai < 2; ++ai)
#pragma unroll
            for (int m = 0; m < 4; ++m) {
                const int row = u.pm * BM + ai * HALF + wr * 64 + m * 16 + fr;
                int cr, s; if (row < NTL) { cr = row >> 5; s = row & 31; } else { const int rc = row - NTL; cr = 512 + (rc >> 5); s = rc & 31; }
#pragma unroll
                for (int bj = 0; bj < 2; ++bj) {
                    const int col = u.pn * BM + bj * HALF + wc * 32 + 8 * fq;
                    const u32x4 w = pack8(acc[ai][bj][m][0], acc[ai][bj][m][1]);
                    if (col >= COL_GD && col < COL_U) { if (row < NTL) { f32x4 s0, s1;
#pragma unroll
                            for (int j = 0; j < 4; ++j) { s0[j] = sigmoidf_(acc[ai][bj][m][0][j]); s1[j] = sigmoidf_(acc[ai][bj][m][1][j]); }
                            *(u32x4*)(SIG + (size_t)row * 256 + (col - COL_GD)) = pack8(s0, s1); } }
                    else if (col < COL_U) *(u32x4*)(Z + (size_t)row * ZLD + col) = w;
                    else if (col < DIN) { const int g = (col - COL_U) >> 4, h0 = (col - COL_U) & 15; *(u32x4*)(Aall + ((size_t)(g * S5ROWS + cr)) * S5K1 + s * 16 + h0) = w; }
                }
            }
    }
};
struct EpiE {
    static constexpr bool PERM = false, AFTER_DRAIN = false;
    float* E;
    __device__ __forceinline__ void operator()(const Acc& acc, const Unit& u, int wr, int wc, int fr, int fq) const {
        const int g = u.pn;
#pragma unroll
        for (int ai = 0; ai < 2; ++ai)
#pragma unroll
            for (int m = 0; m < 4; ++m) {
                const int cr = (u.pm - g * 3) * BM + ai * HALF + wr * 64 + m * 16 + fr;
                if (cr < S5EROWS) {
                    float* rowp = E + ((size_t)(g * S5EROWS + cr)) * 256 + wc * 32 + 4 * fq;
#pragma unroll
                    for (int bj = 0; bj < 2; ++bj)
#pragma unroll
                        for (int n = 0; n < 2; ++n) *(f32x4*)(rowp + bj * HALF + n * 16) = acc[ai][bj][m][n];
                }
            }
    }
};
struct EpiY {
    static constexpr bool PERM = true, AFTER_DRAIN = false;
    const bf16_t* Aall; const float* dskip; bf16_t* ZG;
    __device__ __forceinline__ void operator()(const Acc& acc, const Unit& u, int wr, int wc, int fr, int fq) const {
        const int g = u.pn >> 1, pnn = u.pn & 1;
#pragma unroll
        for (int ai = 0; ai < 2; ++ai)
#pragma unroll
            for (int m = 0; m < 4; ++m) {
                const int cr = (u.pm - g * 3) * BM + ai * HALF + wr * 64 + m * 16 + fr;
#pragma unroll
                for (int bj = 0; bj < 2; ++bj) {
                    const int n0 = pnn * BM + bj * HALF + wc * 32 + 8 * fq;
                    const int t = n0 >> 4, h0 = n0 & 15;
                    const int tok = cr * 32 + t;
                    const u32x4 uu = *(const u32x4*)(Aall + ((size_t)(g * S5ROWS + cr)) * S5K1 + n0);
                    const f32x4 d0 = *(const f32x4*)(dskip + g * 16 + h0), d1 = *(const f32x4*)(dskip + g * 16 + h0 + 4);
                    f32x4 y0 = acc[ai][bj][m][0], y1 = acc[ai][bj][m][1];
                    y0[0] += d0[0] * bflo(uu.x); y0[1] += d0[1] * bfhi(uu.x); y0[2] += d0[2] * bflo(uu.y); y0[3] += d0[3] * bfhi(uu.y);
                    y1[0] += d1[0] * bflo(uu.z); y1[1] += d1[1] * bfhi(uu.z); y1[2] += d1[2] * bflo(uu.w); y1[3] += d1[3] * bfhi(uu.w);
#pragma unroll
                    for (int j = 0; j < 4; ++j) { y0[j] = gelu_tanh(y0[j]); y1[j] = gelu_tanh(y1[j]); }
                    *(u32x4*)(ZG + (size_t)tok * 512 + g * 16 + h0) = pack8(y0, y1);
                }
            }
    }
};
struct EpiG {
    static constexpr bool PERM = true, AFTER_DRAIN = false;
    bf16_t* G;
    __device__ __forceinline__ void operator()(const Acc& acc, const Unit& u, int wr, int wc, int fr, int fq) const {
#pragma unroll
        for (int ai = 0; ai < 2; ++ai)
#pragma unroll
            for (int m = 0; m < 4; ++m) {
                const int row = u.pm * BM + ai * HALF + wr * 64 + m * 16 + fr;
#pragma unroll
                for (int bj = 0; bj < 2; ++bj) { const int col = u.pn * BM + bj * HALF + wc * 32 + 8 * fq; *(u32x4*)(G + (size_t)row * 512 + col) = pack8(acc[ai][bj][m][0], acc[ai][bj][m][1]); }
            }
    }
};
struct EpiGLU {
    static constexpr bool PERM = true, AFTER_DRAIN = false;
    const bf16_t* ZG; const float* bias; bf16_t* MIX;
    __device__ __forceinline__ void operator()(const Acc& acc, const Unit& u, int wr, int wc, int fr, int fq) const {
#pragma unroll
        for (int ai = 0; ai < 2; ++ai)
#pragma unroll
            for (int m = 0; m < 4; ++m) {
                const int row = u.pm * BM + ai * HALF + wr * 64 + m * 16 + fr;
#pragma unroll
                for (int bj = 0; bj < 2; ++bj) {
                    const int col = u.pn * BM + bj * HALF + wc * 32 + 8 * fq;
                    const u32x4 zz = *(const u32x4*)(ZG + (size_t)row * 512 + col);
                    const f32x4 b0 = *(const f32x4*)(bias + col), b1 = *(const f32x4*)(bias + col + 4);
                    f32x4 y0 = acc[ai][bj][m][0] + b0, y1 = acc[ai][bj][m][1] + b1;
                    y0[0] = bflo(zz.x) * sigmoidf_(y0[0]); y0[1] = bfhi(zz.x) * sigmoidf_(y0[1]); y0[2] = bflo(zz.y) * sigmoidf_(y0[2]); y0[3] = bfhi(zz.y) * sigmoidf_(y0[3]);
                    y1[0] = bflo(zz.z) * sigmoidf_(y1[0]); y1[1] = bfhi(zz.z) * sigmoidf_(y1[1]); y1[2] = bflo(zz.w) * sigmoidf_(y1[2]); y1[3] = bfhi(zz.w) * sigmoidf_(y1[3]);
                    *(u32x4*)(MIX + (size_t)row * DM + 512 + col) = pack8(y0, y1);
                }
            }
    }
};
struct EpiRes {
    static constexpr bool PERM = false, AFTER_DRAIN = false;
    const float* base; float* out; const float* gate;
    __device__ __forceinline__ void operator()(const Acc& acc, const Unit& u, int wr, int wc, int fr, int fq) const {
        const int b = u.pm >> 4;
        const int col0 = u.pn * BM + wc * 32 + 4 * fq;
        f32x4 gv[2][2];
#pragma unroll
        for (int bj = 0; bj < 2; ++bj)
#pragma unroll
            for (int n = 0; n < 2; ++n) gv[bj][n] = *(const f32x4*)(gate + (size_t)b * 6144 + col0 + bj * HALF + n * 16);
#pragma unroll
        for (int ai = 0; ai < 2; ++ai)
#pragma unroll
            for (int m = 0; m < 4; ++m) {
                const size_t off = (size_t)(u.pm * BM + ai * HALF + wr * 64 + m * 16 + fr) * DM + col0;
#pragma unroll
                for (int bj = 0; bj < 2; ++bj)
#pragma unroll
                    for (int n = 0; n < 2; ++n) { const f32x4 bs = *(const f32x4*)(base + off + bj * HALF + n * 16); *(f32x4*)(out + off + bj * HALF + n * 16) = bs + gv[bj][n] * acc[ai][bj][m][n]; }
            }
    }
};
struct EpiUp {
    static constexpr bool PERM = true, AFTER_DRAIN = false;
    bf16_t* ACT;
    __device__ __forceinline__ void operator()(const Acc& acc, const Unit& u, int wr, int wc, int fr, int fq) const {
#pragma unroll
        for (int ai = 0; ai < 2; ++ai)
#pragma unroll
            for (int m = 0; m < 4; ++m) {
                const int row = u.pm * BM + ai * HALF + wr * 64 + m * 16 + fr;
                const int col = u.pn * HALF + wc * 32 + 8 * fq;
                f32x4 y0, y1;
#pragma unroll
                for (int j = 0; j < 4; ++j) { y0[j] = siluf_(acc[ai][0][m][0][j]) * acc[ai][1][m][0][j]; y1[j] = siluf_(acc[ai][0][m][1][j]) * acc[ai][1][m][1][j]; }
                *(u32x4*)(ACT + (size_t)row * DFF + col) = pack8(y0, y1);
            }
    }
};
struct PanelSumsq {
    float* xbuf; unsigned* cnt;
    __device__ __forceinline__ void run(const Acc& v, const Unit& u, int wr, int wc, int fr, int fq, LAS unsigned char* lds, int wid, int lane) const {
        LAS float* P = (LAS float*)lds; LAS float* S = (LAS float*)(lds + 8192);
#pragma unroll
        for (int ai = 0; ai < 2; ++ai)
#pragma unroll
            for (int m = 0; m < 4; ++m) {
                float s = 0.f;
#pragma unroll
                for (int bj = 0; bj < 2; ++bj)
#pragma unroll
                    for (int n = 0; n < 2; ++n) { const f32x4 x = v[ai][bj][m][n]; s += (x[0] * x[0] + x[1] * x[1]) + (x[2] * x[2] + x[3] * x[3]); }
                s += __shfl_xor(s, 16); s += __shfl_xor(s, 32);
                if (fq == 0) P[(ai * HALF + wr * 64 + m * 16 + fr) * 4 + wc] = s;
            }
        asm volatile("s_waitcnt lgkmcnt(0)" ::: "memory"); __builtin_amdgcn_s_barrier(); asm volatile("" ::: "memory");
        const int row = wid * 32 + (lane & 31);
        if (lane < 32) { const f32x4 p = *(const LAS f32x4*)(P + row * 4);
            __hip_atomic_store(xbuf + ((size_t)(u.pm * BM + row)) * 4 + u.pn, (p[0] + p[1]) + (p[2] + p[3]), __ATOMIC_RELAXED, __HIP_MEMORY_SCOPE_AGENT); }
        asm volatile("s_waitcnt vmcnt(0)" ::: "memory");
        if (lane == 0) __hip_atomic_fetch_add(cnt + 64 * u.pm, 1u, __ATOMIC_RELAXED, __HIP_MEMORY_SCOPE_AGENT);
        if (wid == 0) {
            unsigned sp = 0;
            while ((unsigned)__builtin_amdgcn_readfirstlane(__hip_atomic_load(cnt + 64 * u.pm, __ATOMIC_RELAXED, __HIP_MEMORY_SCOPE_AGENT)) < 32u) { __builtin_amdgcn_s_sleep(2); if (++sp > (1u << 22)) break; }
            __builtin_amdgcn_fence(__ATOMIC_ACQUIRE, "agent");
        }
        asm volatile("s_waitcnt vmcnt(0) lgkmcnt(0)" ::: "memory"); __builtin_amdgcn_s_barrier(); asm volatile("" ::: "memory");
        if (lane < 32) { const float* slot = xbuf + ((size_t)(u.pm * BM + row)) * 4; float t = 0.f;
#pragma unroll
            for (int q = 0; q < 4; ++q) t += __hip_atomic_load(slot + q, __ATOMIC_RELAXED, __HIP_MEMORY_SCOPE_AGENT);
            S[row] = t; }
        asm volatile("s_waitcnt vmcnt(0) lgkmcnt(0)" ::: "memory"); __builtin_amdgcn_s_barrier(); asm volatile("" ::: "memory");
    }
};
struct EpiWoutNorm {
    static constexpr bool PERM = false, AFTER_DRAIN = true;
    const float* base; float* out; const float* mod; const float* g2; bf16_t* H2; PanelSumsq st;
    __device__ __forceinline__ void fused(Acc& acc, const Unit& u, int wr, int wc, int fr, int fq, LAS unsigned char* lds, int wid, int lane) const {
        const int b = u.pm >> 4, col0 = u.pn * BM + wc * 32 + 4 * fq;
        const float* mb = mod + (size_t)b * 6144;
#pragma unroll
        for (int ai = 0; ai < 2; ++ai)
#pragma unroll
            for (int m = 0; m < 4; ++m) { const size_t off = (size_t)(u.pm * BM + ai * HALF + wr * 64 + m * 16 + fr) * DM + col0;
#pragma unroll
                for (int bj = 0; bj < 2; ++bj)
#pragma unroll
                    for (int n = 0; n < 2; ++n) { const int co = bj * HALF + n * 16; const f32x4 bs = *(const f32x4*)(base + off + co), gv = *(const f32x4*)(mb + 2 * 1024 + col0 + co);
                        const f32x4 x1 = bs + gv * acc[ai][bj][m][n]; acc[ai][bj][m][n] = x1; *(f32x4*)(out + off + co) = x1; }
                asm volatile("" : "+v"(acc[ai][0][m][0]), "+v"(acc[ai][0][m][1]), "+v"(acc[ai][1][m][0]), "+v"(acc[ai][1][m][1]));
                if (m & 1) asm volatile("" ::: "memory"); }
        st.run(acc, u, wr, wc, fr, fq, lds, wid, lane);
        const LAS float* S = (const LAS float*)(lds + 8192);
#pragma unroll
        for (int ai = 0; ai < 2; ++ai)
#pragma unroll
            for (int m = 0; m < 4; ++m) { const int r = ai * HALF + wr * 64 + m * 16 + fr; const float rstd = 1.0f / sqrtf(S[r] * (1.f / DM) + 1e-6f); const size_t off = (size_t)(u.pm * BM + r) * DM + col0;
#pragma unroll
                for (int bj = 0; bj < 2; ++bj)
#pragma unroll
                    for (int n = 0; n < 2; ++n) { const int co = bj * HALF + n * 16;
                        const f32x4 gg = *(const f32x4*)(g2 + col0 + co), sh = *(const f32x4*)(mb + 3 * 1024 + col0 + co), sc = *(const f32x4*)(mb + 4 * 1024 + col0 + co);
                        const f32x4 y = acc[ai][bj][m][n] * rstd * gg * (sc + 1.0f) + sh;
                        u32x2 w; w.x = pk2(y[0], y[1]); w.y = pk2(y[2], y[3]); *(u32x2*)(H2 + off + co) = w; }
                asm volatile("" ::: "memory"); }
    }
};
struct EpiDownNorm {
    static constexpr bool PERM = false, AFTER_DRAIN = true;
    float* out; const float* mod; const float* fg; PanelSumsq st;
    __device__ __forceinline__ void fused(Acc& acc, const Unit& u, int wr, int wc, int fr, int fq, LAS unsigned char* lds, int wid, int lane) const {
        const int b = u.pm >> 4, col0 = u.pn * BM + wc * 32 + 4 * fq;
        const float* mb = mod + (size_t)b * 6144;
#pragma unroll
        for (int ai = 0; ai < 2; ++ai)
#pragma unroll
            for (int m = 0; m < 4; ++m) { const size_t off = (size_t)(u.pm * BM + ai * HALF + wr * 64 + m * 16 + fr) * DM + col0;
#pragma unroll
                for (int bj = 0; bj < 2; ++bj)
#pragma unroll
                    for (int n = 0; n < 2; ++n) { const int co = bj * HALF + n * 16; const f32x4 bs = *(const f32x4*)(out + off + co), gv = *(const f32x4*)(mb + 5 * 1024 + col0 + co);
                        acc[ai][bj][m][n] = bs + gv * acc[ai][bj][m][n]; }
                asm volatile("" : "+v"(acc[ai][0][m][0]), "+v"(acc[ai][0][m][1]), "+v"(acc[ai][1][m][0]), "+v"(acc[ai][1][m][1]));
                if (m & 1) asm volatile("" ::: "memory"); }
        st.run(acc, u, wr, wc, fr, fq, lds, wid, lane);
        const LAS float* S = (const LAS float*)(lds + 8192);
#pragma unroll
        for (int ai = 0; ai < 2; ++ai)
#pragma unroll
            for (int m = 0; m < 4; ++m) { const int r = ai * HALF + wr * 64 + m * 16 + fr; const float rstd = 1.0f / sqrtf(S[r] * (1.f / DM) + 1e-6f); const size_t off = (size_t)(u.pm * BM + r) * DM + col0;
#pragma unroll
                for (int bj = 0; bj < 2; ++bj)
#pragma unroll
                    for (int n = 0; n < 2; ++n) { const int co = bj * HALF + n * 16; *(f32x4*)(out + off + co) = acc[ai][bj][m][n] * rstd * *(const f32x4*)(fg + col0 + co); }
                asm volatile("" ::: "memory"); }
    }
};
}


__device__ __forceinline__ void transpose_item(const float* W, int K, int N, bf16_t* WT, int ldt, int k0, int n0, int drow0, LAS float* scr, int lane) {
#pragma unroll 8
    for (int i = 0; i < 32; ++i) { const int kk = 2 * i + (lane >> 5); scr[kk * 33 + (lane & 31)] = W[(size_t)(k0 + kk) * N + n0 + (lane & 31)]; }
    asm volatile("s_waitcnt lgkmcnt(0)" ::: "memory");
    const int c = lane & 7;
#pragma unroll
    for (int j = 0; j < 4; ++j) { const int n = (lane >> 3) + 8 * j; const LAS float* s = scr + (8 * c) * 33 + n;
        u32x4 o; o.x = pk2(s[0 * 33], s[1 * 33]); o.y = pk2(s[2 * 33], s[3 * 33]); o.z = pk2(s[4 * 33], s[5 * 33]); o.w = pk2(s[6 * 33], s[7 * 33]);
        *(u32x4*)(WT + (size_t)(drow0 + n) * ldt + k0 + 8 * c) = o; }
    asm volatile("s_waitcnt lgkmcnt(0)" ::: "memory");
}

__device__ __forceinline__ void p0_weights(const Args& a, LAS unsigned char* lds, int bid, int nb, int part) {
    const int tid = opaque_tid(), lane = tid & 63, wave = tid >> 6;
    LAS float* scr = (LAS float*)(lds + wave * 8704);
    bf16_t* WTIN = (bf16_t*)(a.ws + WS_WTIN); bf16_t* WTOUT = (bf16_t*)(a.ws + WS_WTOUT); bf16_t* WT13 = (bf16_t*)(a.ws + WS_WT13);
    bf16_t* WT2 = (bf16_t*)(a.ws + WS_WT2); bf16_t* WTGLU = (bf16_t*)(a.ws + WS_WTGLU);
    constexpr int I_IN = 16 * 71, I_OUT = 16 * 32, I_1 = 16 * 88, I_2 = 44 * 32, I_GLU = 8 * 16;
    constexpr int NIT = I_IN + I_OUT + 2 * I_1 + I_2 + I_GLU;
    const int gw = bid * 8 + wave, NGW = nb * 8;
    for (int it = (part ? I_IN : 0) + gw; it < (part ? NIT : I_IN); it += NGW) {
        int r = it;
        if (r < I_IN) { const int kb = r / 71, nbk = r % 71; transpose_item(a.in[8], 1024, DIN, WTIN, 1024, kb * 64, nbk * 32, nbk * 32, scr, lane); continue; } r -= I_IN;
        if (r < I_OUT) { const int kb = r / 32, nbk = r % 32; transpose_item(a.in[9], 1024, 1024, WTOUT, 1024, kb * 64, nbk * 32, nbk * 32, scr, lane); continue; } r -= I_OUT;
        if (r < 2 * I_1) { const int sel = r / I_1; r -= sel * I_1; const int kb = r / 88, nbk = r % 88, n0 = nbk * 32;
            transpose_item(a.in[sel ? 32 : 31], 1024, DFF, WT13, 1024, kb * 64, n0, (n0 >> 7) * 256 + (n0 & 127) + sel * 128, scr, lane); continue; } r -= 2 * I_1;
        if (r < I_2) { const int kb = r / 32, nbk = r % 32; transpose_item(a.in[33], DFF, 1024, WT2, DFF, kb * 64, nbk * 32, nbk * 32, scr, lane); continue; } r -= I_2;
        { const int kb = r / 16, nbk = r % 16; transpose_item(a.in[29], 512, 512, WTGLU, 512, kb * 64, nbk * 32, nbk * 32, scr, lane); }
    }
    if (part) return;
    bf16_t* W2T = (bf16_t*)(a.ws + WS_W2T);
    for (int i = bid * NTHREADS + tid; i < 2 * 2 * 512 * 32; i += nb * NTHREADS) { const int j = i & 31, c = (i >> 5) & 511, d = (i >> 14) & 1, which = i >> 15; W2T[i] = (bf16_t)f2bf(a.in[which ? 14 : 12][(d * 32 + j) * 512 + c]); }
    bf16_t* G2T = (bf16_t*)(a.ws + WS_G2T); bf16_t* SIG = (bf16_t*)(a.ws + WS_SIG);
    for (int i = bid * NTHREADS + tid; i < 512 * 256; i += nb * NTHREADS) { const int n = i >> 8, k = i & 255; G2T[i] = k < 96 ? (bf16_t)f2bf(a.in[15][k * 512 + n]) : (bf16_t)0; }
    for (int i = bid * NTHREADS + tid; i < NTL * 20; i += nb * NTHREADS) { const int row = i / 20, q = i % 20; *(u32x4*)(SIG + (size_t)row * 256 + 96 + q * 8) = (u32x4){0u, 0u, 0u, 0u}; }
}

__device__ __forceinline__ void p0_mod(const Args& a, LAS unsigned char* lds, int bid, int nb) {
    const int tid = opaque_tid();
    LAS float* sc = (LAS float*)lds;
    LAS float* red = sc + 5 * 1024;
    float* MOD = (float*)(a.ws + WS_MOD);
    bool filled = false;
    for (int cb = bid; cb < 192; cb += nb) {
        if (!filled) {
            for (int i = tid; i < 5 * 1024; i += NTHREADS) { const float v = (i < 4096) ? a.in[1][i] : a.in[3][i - 4096]; sc[i] = siluf_(v); }
            filled = true; __syncthreads();
        }
        const int col = cb * 32 + (tid & 31), kp = tid >> 5;
        float acc[5] = {0.f, 0.f, 0.f, 0.f, 0.f};
        const float* wp = a.in[4] + (size_t)(kp * 64) * 6144 + col;
#pragma unroll 8
        for (int k = 0; k < 64; ++k) { const float w = wp[(size_t)k * 6144];
#pragma unroll
            for (int r = 0; r < 5; ++r) acc[r] += sc[r * 1024 + kp * 64 + k] * w; }
#pragma unroll
        for (int r = 0; r < 5; ++r) red[(kp * 5 + r) * 32 + (tid & 31)] = acc[r];
        __syncthreads();
        if (tid < 160) { const int r = tid >> 5, c = tid & 31; float s = 0.f;
#pragma unroll
            for (int k = 0; k < 16; ++k) s += red[(k * 5 + r) * 32 + c];
            MOD[r * 6144 + cb * 32 + c] = s + a.in[5][cb * 32 + c]; }
        __syncthreads();
    }
}

__device__ __forceinline__ void p0_s5(const Args& a, LAS unsigned char* lds, int bid, int nb) {
    const int tid = opaque_tid();
    LAS float* pw  = (LAS float*)lds;
    LAS float* bb  = pw + 2 * 33 * 64 * 2;
    LAS float* cc  = bb + 2 * 64 * 16 * 2;
    bf16_t* BT1 = (bf16_t*)(a.ws + WS_BT1); bf16_t* BT2 = (bf16_t*)(a.ws + WS_BT2); float* TAB = (float*)(a.ws + WS_S5TAB); float* KT = (float*)(a.ws + WS_KT);
    const float* lam_re = a.in[21]; const float* lam_im = a.in[22]; const float* log_step = a.in[23];
    const float* b_re = a.in[24]; const float* b_im = a.in[25]; const float* c_re = a.in[26]; const float* c_im = a.in[27];
    for (int item = bid; item < 256; item += nb) {
        const int g = item >> 3, part = item & 7;
        __syncthreads();
        for (int i = tid; i < 2 * 33 * 64; i += NTHREADS) {
            const int p = i & 63, n = (i >> 6) % 33, d = i / (33 * 64);
            const float step = __expf(log_step[d * 32 + g]);
            const float lr = lam_re[(d * 32 + g) * 64 + p] * step, li = lam_im[(d * 32 + g) * 64 + p] * step;
            const float mag = expf((float)n * lr); float sn, cs; sincosf((float)n * li, &sn, &cs);
            pw[i * 2] = mag * cs; pw[i * 2 + 1] = mag * sn;
        }
        for (int i = tid; i < 2 * 64 * 16; i += NTHREADS) {
            const int h = i & 15, p = (i >> 4) & 63, d = i >> 10;
            const float step = __expf(log_step[d * 32 + g]);
            const float lr = lam_re[(d * 32 + g) * 64 + p], li = lam_im[(d * 32 + g) * 64 + p];
            const float mag = expf(lr * step); float sn, cs; sincosf(li * step, &sn, &cs);
            const float lbr = mag * cs, lbi = mag * sn, den = lr * lr + li * li, nr = lbr - 1.f;
            const float qr = (nr * lr + lbi * li) / den, qi = (lbi * lr - nr * li) / den;
            const float br = b_re[(g * 64 + p) * 16 + h], bi = b_im[(g * 64 + p) * 16 + h];
            bb[i * 2] = qr * br - qi * bi; bb[i * 2 + 1] = qr * bi + qi * br;
        }
        for (int i = tid; i < 16 * 64; i += NTHREADS) { cc[i * 2] = c_re[g * 1024 + i]; cc[i * 2 + 1] = c_im[g * 1024 + i]; }
        __syncthreads();
        if (part == 0 && tid < 128) { const int d = tid >> 6, p = tid & 63; TAB[((d * 32 + g) * 64 + p) * 2] = pw[((d * 33 + 32) * 64 + p) * 2]; TAB[((d * 32 + g) * 64 + p) * 2 + 1] = pw[((d * 33 + 32) * 64 + p) * 2 + 1]; }
        {
            const int hq = tid & 3, h = (tid >> 2) & 15, q = part * 8 + (tid >> 6), d = q >> 5, tau = q & 31;
            f32x4 s = {0.f, 0.f, 0.f, 0.f};
#pragma unroll 4
            for (int p = 0; p < 64; ++p) {
                const f32x2 c2 = *(LAS f32x2*)(cc + (h * 64 + p) * 2), p2 = *(LAS f32x2*)(pw + ((d * 33 + tau) * 64 + p) * 2);
                const float xr = c2.x * p2.x - c2.y * p2.y, xi = c2.x * p2.y + c2.y * p2.x;
                const f32x4 b0 = *(LAS f32x4*)(bb + ((d * 64 + p) * 16 + 4 * hq) * 2), b1 = *(LAS f32x4*)(bb + ((d * 64 + p) * 16 + 4 * hq) * 2 + 4);
                s[0] += xr * b0[0] - xi * b0[1]; s[1] += xr * b0[2] - xi * b0[3]; s[2] += xr * b1[0] - xi * b1[1]; s[3] += xr * b1[2] - xi * b1[3];
            }
            *(f32x4*)(KT + ((size_t)(g * 64 + q) * 16 + h) * 16 + 4 * hq) = s;
        }
        for (int i = tid; i < 64 * 128; i += NTHREADS) {
            const int rl = i >> 7, kp = (i & 127) * 2;
            const int n = part * 64 + rl, t = n >> 4, h = n & 15;
            const int d = kp >> 7, p = (kp >> 1) & 63;
            const int np = d ? (32 - t) : (t + 1);
            const float ar = pw[((d * 33 + np) * 64 + p) * 2], ai = pw[((d * 33 + np) * 64 + p) * 2 + 1];
            const float cr = cc[(h * 64 + p) * 2], ci = cc[(h * 64 + p) * 2 + 1];
            *(unsigned*)(BT1 + ((size_t)(g * 512 + n)) * S5K1 + 512 + kp) = pk2(cr * ar - ci * ai, -cr * ai - ci * ar);
        }
        for (int i = tid; i < 32 * 256; i += NTHREADS) {
            const int rl = i >> 8, kp = (i & 255) * 2;
            const int n = part * 32 + rl, d = n >> 7, p = (n >> 1) & 63, ri = n & 1;
            float v[2];
#pragma unroll
            for (int e = 0; e < 2; ++e) {
                const int k = kp + e, s = k >> 4, hp = k & 15;
                const int np = d ? s : (31 - s);
                const float ar = pw[((d * 33 + np) * 64 + p) * 2], ai = pw[((d * 33 + np) * 64 + p) * 2 + 1];
                const float br = bb[((d * 64 + p) * 16 + hp) * 2], bi = bb[((d * 64 + p) * 16 + hp) * 2 + 1];
                v[e] = ri ? (ar * bi + ai * br) : (ar * br - ai * bi);
            }
            *(unsigned*)(BT2 + ((size_t)(g * 256 + n)) * 512 + kp) = pk2(v[0], v[1]);
        }
    }
    __syncthreads();
}
__device__ __forceinline__ void p1_s5(const Args& a, LAS unsigned char* lds, int bid, int nb) {
    const int tid = opaque_tid();
    LAS float* kt = (LAS float*)lds;
    bf16_t* BT1 = (bf16_t*)(a.ws + WS_BT1); const float* KT = (const float*)(a.ws + WS_KT);
    for (int item = bid; item < 256; item += nb) {
        const int g = item >> 3, part = item & 7;
        __syncthreads();
        for (int i = tid; i < 4096; i += NTHREADS) *(LAS f32x4*)(kt + 4 * i) = *(const f32x4*)(KT + (size_t)g * 16384 + 4 * i);
        __syncthreads();
        for (int i = tid; i < 64 * 256; i += NTHREADS) {
            const int rl = i >> 8, kp = (i & 255) * 2;
            const int n = part * 64 + rl, t = n >> 4, h = n & 15, s = kp >> 4, hp = kp & 15;
            float v0, v1;
            if (t > s) { const LAS float* q = kt + ((0 * 32 + (t - s)) * 16 + h) * 16 + hp; v0 = q[0]; v1 = q[1]; }
            else if (s > t) { const LAS float* q = kt + ((1 * 32 + (s - t)) * 16 + h) * 16 + hp; v0 = q[0]; v1 = q[1]; }
            else { const LAS float* q0 = kt + (h * 16) + hp; const LAS float* q1 = kt + ((32 * 16 + h) * 16) + hp; v0 = q0[0] + q1[0]; v1 = q0[1] + q1[1]; }
            *(unsigned*)(BT1 + ((size_t)(g * 512 + n)) * S5K1 + kp) = pk2(v0, v1);
        }
    }
    __syncthreads();
}

struct RowV { f32x4 v[4]; };
__device__ __forceinline__ RowV row_load(const float* xrow, int lane) { RowV r; const f32x4* xr = (const f32x4*)xrow + lane;
#pragma unroll
    for (int j = 0; j < 4; ++j) r.v[j] = xr[64 * j];
    return r; }
__device__ __forceinline__ float row_rstd(const RowV& r) { float s = 0.f;
#pragma unroll
    for (int j = 0; j < 4; ++j) s += (r.v[j].x * r.v[j].x + r.v[j].y * r.v[j].y) + (r.v[j].z * r.v[j].z + r.v[j].w * r.v[j].w);
    return 1.0f / sqrtf(wave_sum(s) * (1.f / DM) + 1e-6f); }
__device__ __forceinline__ void norm_mod_finish(const RowV& r, const float* g, const float* shift, const float* scale, bf16_t* orow, int lane) {
    const float rstd = row_rstd(r);
    u32x2* o8 = (u32x2*)orow + lane;
#pragma unroll
    for (int j = 0; j < 4; ++j) {
        const f32x4 gg = ((const f32x4*)g)[lane + 64 * j], sh = ((const f32x4*)shift)[lane + 64 * j], sc = ((const f32x4*)scale)[lane + 64 * j];
        const f32x4 y = r.v[j] * rstd * gg * (sc + 1.0f) + sh;
        u32x2 w; w.x = pk2(y.x, y.y); w.y = pk2(y.z, y.w); o8[64 * j] = w;
    }
}

__device__ __forceinline__ void p_s5_carry(const Args& a, int bid, int nb) {
    const float* E = (const float*)(a.ws + WS_E); const float* TAB = (const float*)(a.ws + WS_S5TAB); bf16_t* Aall = (bf16_t*)(a.ws + WS_AALL);
    for (int gi = bid * NTHREADS + opaque_tid(); gi < BATCH * 32 * 2 * 64 * 8; gi += nb * NTHREADS) {
        const int seg = gi & 7, p = (gi >> 3) & 63, d = (gi >> 9) & 1, g = (gi >> 10) & 31, b = gi >> 15;
        const float lr = TAB[((d * 32 + g) * 64 + p) * 2], li = TAB[((d * 32 + g) * 64 + p) * 2 + 1];
        const size_t ecol = (size_t)d * 128 + p * 2;
        float hr = 0.f, hi = 0.f;
        if (seg == 0) {
            f32x2 e[8];
#pragma unroll
            for (int c = 0; c < 8; ++c) { const int cc = d ? 7 - c : c; e[c] = *(const f32x2*)(E + ((size_t)(g * S5EROWS + 512 + b * 8 + cc)) * 256 + ecol); }
#pragma unroll
            for (int c = 0; c < 8; ++c) { const float nr = lr * hr - li * hi + e[c].x, ni = lr * hi + li * hr + e[c].y; hr = nr; hi = ni; }
        }
        const float h0r = hr, h0i = hi;
        f32x2 e[16];
#pragma unroll
        for (int j = 0; j < 16; ++j) { const int jj = seg * 16 + j, cc = d ? 127 - jj : jj; e[j] = *(const f32x2*)(E + ((size_t)(g * S5EROWS + b * 128 + cc)) * 256 + ecol); }
#pragma unroll
        for (int j = 0; j < 16; ++j) { const float nr = lr * hr - li * hi + e[j].x, ni = lr * hi + li * hr + e[j].y; hr = nr; hi = ni; }
        float ar = lr, ai = li;
#pragma unroll
        for (int q = 0; q < 4; ++q) { const float nr = ar * ar - ai * ai, ni = 2.f * ar * ai; ar = nr; ai = ni; }
        float fr = hr, fi = hi;
#pragma unroll
        for (int st = 1; st < 8; ++st) {
            const float pr = __shfl_up(fr, 1, 8), pi = __shfl_up(fi, 1, 8);
            if (seg == st) { fr = ar * pr - ai * pi + hr; fi = ar * pi + ai * pr + hi; }
        }
        const float cr_ = __shfl_up(fr, 1, 8), ci_ = __shfl_up(fi, 1, 8);
        hr = seg ? cr_ : h0r; hi = seg ? ci_ : h0i;
#pragma unroll
        for (int j = 0; j < 16; ++j) { const int jj = seg * 16 + j, cc = d ? 127 - jj : jj;
            *(unsigned*)(Aall + ((size_t)(g * S5ROWS + b * 128 + cc)) * S5K1 + 512 + ecol) = pk2(hr, hi);
            const float nr = lr * hr - li * hi + e[j].x, ni = lr * hi + li * hr + e[j].y; hr = nr; hi = ni; }
    }
}

constexpr int RC = 64, RNCH = (CTXL + SEQ) / RC, RSTG0 = 32, RSTG1 = RNCH - RSTG0, RSTGM = RSTG1, RJOBS = 64 * RSTGM;
constexpr size_t WS_RACT = WS_AALL;
constexpr size_t WS_RRPT = WS_RACT + (size_t)RJOBS * 8192;
constexpr size_t WS_RSL  = WS_RRPT + (size_t)RJOBS * 8192;
constexpr size_t WS_RYL  = WS_RSL + (size_t)RJOBS * 8192;
constexpr size_t WS_RST  = WS_RYL + (size_t)RJOBS * 8192;
static_assert(WS_RST + (size_t)256 * 64 * 16 * 4 <= WS_S5END, "rwkv staging must fit the S5 region");
constexpr size_t WS_YOUT = WS_HMOD;
constexpr size_t WS_MIX  = WS_AALL;
static_assert((size_t)2 * NTL * 512 * 2 <= (size_t)NTOK * DM * 2, "YOUT fits HMOD region");

#define LSYNC() do { __syncthreads(); if ((PROBE_RPT >> 19) & 1) { __syncthreads(); __syncthreads(); __syncthreads(); } } while (0)
constexpr int SLB = 64 * 72 * 2;
typedef float f32x16 __attribute__((ext_vector_type(16)));
#define RSLOT(i) (lds + (i) * SLB)

__device__ __forceinline__ f32x16 tile_mm(const LAS unsigned char* Aop, const LAS unsigned char* Bop, int m0, int n0, f32x16 acc, int lane) {
    const int r = lane & 31, h = lane >> 5;
    const LAS unsigned char* ap = Aop + (m0 + r) * 144 + h * 16;
    const LAS unsigned char* bp = Bop + (n0 + r) * 144 + h * 16;
#pragma unroll
    for (int ks = 0; ks < 4; ++ks) {
        const bf16x8 av = *(const LAS bf16x8*)(ap + ks * 32), bv = *(const LAS bf16x8*)(bp + ks * 32);
        acc = __builtin_amdgcn_mfma_f32_32x32x16_bf16(av, bv, acc, 0, 0, 0);
    }
    return acc;
}
__device__ __forceinline__ f32x16 zero16() { f32x16 z;
#pragma unroll
    for (int i = 0; i < 16; ++i) z[i] = 0.f; return z; }
__device__ __forceinline__ void store_cr(LAS unsigned char* X, const f32x16& acc, int m0, int n0, int lane) {
    LAS unsigned char* p = X + (n0 + (lane & 31)) * 144 + (m0 + 4 * (lane >> 5)) * 2;
#pragma unroll
    for (int g = 0; g < 4; ++g) { u32x2 w; w.x = pk2(acc[4 * g], acc[4 * g + 1]); w.y = pk2(acc[4 * g + 2], acc[4 * g + 3]); *(LAS u32x2*)(p + g * 16) = w; }
}
__device__ __forceinline__ void store_rc(LAS unsigned char* X, const f32x16& acc, int m0, int n0, int lane, bool ident) {
    const int c = n0 + (lane & 31), h = lane >> 5;
#pragma unroll
    for (int r = 0; r < 16; ++r) { const int row = m0 + (r & 3) + 8 * (r >> 2) + 4 * h; float v = acc[r]; if (ident && row == c) v += 1.0f;
        *(LAS bf16_t*)(X + row * 144 + c * 2) = (bf16_t)f2bf(v); }
}
__device__ __forceinline__ f32x16 init_cr(const LAS unsigned char* X, int m0, int n0, int lane) {
    const LAS unsigned char* p = X + (n0 + (lane & 31)) * 144 + (m0 + 4 * (lane >> 5)) * 2;
    f32x16 acc;
#pragma unroll
    for (int g = 0; g < 4; ++g) { const u32x2 w = *(const LAS u32x2*)(p + g * 16); acc[4 * g] = bflo(w.x); acc[4 * g + 1] = bfhi(w.x); acc[4 * g + 2] = bflo(w.y); acc[4 * g + 3] = bfhi(w.y); }
    return acc;
}
__device__ __forceinline__ void mask_ge(f32x16& acc, int m0, int n0, int lane, int dmin) {
    const int c = n0 + (lane & 31), h = lane >> 5;
#pragma unroll
    for (int r = 0; r < 16; ++r) { const int row = m0 + (r & 3) + 8 * (r >> 2) + 4 * h; if (c - row < dmin) acc[r] = 0.f; }
}
__device__ __forceinline__ void store_g_perm(bf16_t* OUT, const f32x16& acc, int m0, int n0, int lane) {
    const int h = lane >> 5; bf16_t* rowp = OUT + (size_t)(n0 + (lane & 31)) * 64 + m0;
#pragma unroll
    for (int g4 = 0; g4 < 4; ++g4) { u32x2 w; w.x = pk2(acc[4 * g4], acc[4 * g4 + 1]); w.y = pk2(acc[4 * g4 + 2], acc[4 * g4 + 3]);
        *(u32x2*)(rowp + 8 * (2 * (g4 & 1) + h) + 4 * (g4 >> 1)) = w; }
}
__device__ __forceinline__ void store_g_cr(bf16_t* OUT, const f32x16& acc, int m0, int n0, int lane) {
    bf16_t* rowp = OUT + (size_t)(n0 + (lane & 31)) * 64 + m0 + 4 * (lane >> 5);
#pragma unroll
    for (int g = 0; g < 4; ++g) { u32x2 w; w.x = pk2(acc[4 * g], acc[4 * g + 1]); w.y = pk2(acc[4 * g + 2], acc[4 * g + 3]); *(u32x2*)(rowp + 8 * g) = w; }
}

typedef short s16x4 __attribute__((ext_vector_type(4)));
__device__ __forceinline__ bf16x8 frag_t(const LAS unsigned char* img, int m0, int ks, int lane) {
    const LAS unsigned char* a0 = img + (16 * ks + 8 * (lane >> 5) + ((lane & 15) >> 2)) * 144 + (m0 + 16 * ((lane >> 4) & 1) + 4 * (lane & 3)) * 2;
    const s16x4 lo = __builtin_amdgcn_ds_read_tr16_b64_v4i16((LAS s16x4*)a0), hi = __builtin_amdgcn_ds_read_tr16_b64_v4i16((LAS s16x4*)(a0 + 4 * 144));
    return (bf16x8){lo[0], lo[1], lo[2], lo[3], hi[0], hi[1], hi[2], hi[3]};
}
__device__ __forceinline__ bf16x8 frag_n(const LAS unsigned char* img, int m0, int ks, int lane) { return *(const LAS bf16x8*)(img + (m0 + (lane & 31)) * 144 + (lane >> 5) * 16 + ks * 32); }
template <bool TA, bool TB>
__device__ __forceinline__ f32x16 tile_mmx(const LAS unsigned char* Aimg, const LAS unsigned char* Bimg, int m0, int n0, int ks0, int ks1, f32x16 acc, int lane) {
#pragma unroll
    for (int ks = 0; ks < 4; ++ks) if (ks >= ks0 && ks < ks1) {
        const bf16x8 av = TA ? frag_t(Aimg, m0, ks, lane) : frag_n(Aimg, m0, ks, lane);
        const bf16x8 bv = TB ? frag_t(Bimg, n0, ks, lane) : frag_n(Bimg, n0, ks, lane);
        acc = __builtin_amdgcn_mfma_f32_32x32x16_bf16(av, bv, acc, 0, 0, 0);
    }
    return acc;
}
__device__ __forceinline__ f32x16 init_rc(const LAS unsigned char* X, int m0, int n0, int lane) {
    const LAS unsigned char* a0 = X + (m0 + 4 * (lane >> 5) + ((lane & 15) >> 2)) * 144 + (n0 + 16 * ((lane >> 4) & 1) + 4 * (lane & 3)) * 2;
    f32x16 acc;
#pragma unroll
    for (int g = 0; g < 4; ++g) { const s16x4 w = __builtin_amdgcn_ds_read_tr16_b64_v4i16((LAS s16x4*)(a0 + g * 8 * 144));
#pragma unroll
        for (int e = 0; e < 4; ++e) acc[4 * g + e] = __builtin_bit_cast(float, ((unsigned)(unsigned short)w[e]) << 16); }
    return acc;
}
__device__ __forceinline__ void mask_tri(f32x16& acc, int m0, int n0, int lane, int sgn, int dmin, bool ident) {
    const int c = n0 + (lane & 31), h = lane >> 5;
#pragma unroll
    for (int r = 0; r < 16; ++r) { const int row = m0 + (r & 3) + 8 * (r >> 2) + 4 * h; if ((c - row) * sgn < dmin) acc[r] = 0.f; if (ident && row == c) acc[r] += 1.0f; }
}

__device__ __forceinline__ void p_rwkv_A(const Args& a, LAS unsigned char* lds, int bid, int nb, int stage) {
    LAS unsigned char* raw = lds;
    LAS float* cws = (LAS float*)(lds + 8 * SLB);
    LAS unsigned char* w2t = (LAS unsigned char*)(cws + 27 * 64);
    LAS unsigned char* a2t = w2t + 5120;
    LAS unsigned char* twl = a2t + 5120;
    LAS unsigned char* adl = twl + 5120;
    LAS float* cum = (LAS float*)(adl + 5120);
    LAS bf16_t* avl = (LAS bf16_t*)(cum + 4096);
    LAS float* seg = (LAS float*)(avl + 4096);
    LAS float* lamC = (LAS float*)(lds + 14 * SLB);
    static_assert(8 * SLB + 6912 + 4 * 5120 + 16384 + 8192 + 2048 <= 14 * SLB, "prep temporaries");
    static_assert(14 * SLB + 256 <= 131072 && 192 * 384 == 8 * SLB, "rwkv LDS");
    const bf16_t* Z = (const bf16_t*)(a.ws + WS_Z);
    const bf16_t* W2T = (const bf16_t*)(a.ws + WS_W2T);
    float* BON = (float*)(a.ws + WS_BON);
    bf16_t* RACT = (bf16_t*)(a.ws + WS_RACT); bf16_t* RRPT = (bf16_t*)(a.ws + WS_RRPT); bf16_t* RSL = (bf16_t*)(a.ws + WS_RSL); bf16_t* RYL = (bf16_t*)(a.ws + WS_RYL);
    const int tid0 = threadIdx.x;
    const int vcu = (nb % 8 == 0) ? (bid % 8) * (nb / 8) + bid / 8 : bid;
    const int nstg = stage ? RSTG1 : RSTG0, cs0 = stage ? RSTG0 : 0;
    u32x4 rq[9], wq, xq;
#define RWA_ISSUE(jn_) do { const int tq_ = opaque_tid(); const int chain_ = (jn_) / nstg, cs_ = cs0 + (jn_) % nstg, d_ = chain_ >> 5, b_ = (chain_ >> 3) & 3, h_ = chain_ & 7; \
        const bool ctx_ = cs_ < CTXL / RC; const int cidx_ = ctx_ ? cs_ : cs_ - CTXL / RC, gi_ = d_ ? ((ctx_ ? CTXL / RC : SEQ / RC) - 1 - cidx_) : cidx_; \
        _Pragma("unroll") for (int it = 0; it < 9; ++it) { const int pc = it * 512 + tq_, slot = pc / 24, q = pc - slot * 24, X = q >> 3, c8 = q & 7; int tok; \
            if (ctx_) { const int t = min(max(64 * (gi_ - 1) + slot, 0), CTXL - 1); tok = NTL + b_ * CTXL + t; } \
            else { const int rr_ = min(max(gi_ - 1 + (slot >> 6), 0), 63); tok = b_ * SEQ + rr_ * 64 + (slot & 63); } \
            rq[it] = *(const u32x4*)(Z + ((unsigned)tok * ZLD + X * 512 + h_ * 64 + c8 * 8)); } \
        { const int rw = tq_ >> 3, pq = tq_ & 7, which = pq >> 2, p4 = pq & 3; \
          wq = *(const u32x4*)(W2T + ((size_t)((which * 2 + d_) * 512 + h_ * 64 + rw)) * 32 + p4 * 8); \
          const int pj = d_ ? 63 - rw : rw; const int tokrow = ctx_ ? (NTL + b_ * CTXL + gi_ * 64 + pj) : (b_ * SEQ + gi_ * 64 + pj); \
          xq = *(const u32x4*)(Z + ((unsigned)tokrow * ZLD + (which ? COL_AD : COL_WD) + d_ * 32 + p4 * 8)); } } while (0)
    if (vcu < 64 * nstg) RWA_ISSUE(vcu);
    for (int jl = vcu; jl < 64 * nstg; jl += nb) {
        int tid_ = tid0; asm volatile("" : "+v"(tid_));
        const int tid = tid_, lane = tid & 63, wave = __builtin_amdgcn_readfirstlane(tid >> 6);
        const int chain = jl / nstg, cs = cs0 + jl % nstg;
        const int d = chain >> 5, b = (chain >> 3) & 3, h = chain & 7;
        float* BONd = BON + (size_t)d * NTL * 8;
        const bool isctx = cs < CTXL / RC;
        const int cidx = isctx ? cs : cs - CTXL / RC;
        const int gi = d ? ((isctx ? CTXL / RC : SEQ / RC) - 1 - cidx) : cidx;
#pragma unroll 1
        for (int rp_ = 0; rp_ <= ((PROBE_RPT >> 18) & 1); ++rp_) {
        __syncthreads();
#pragma unroll
        for (int it = 0; it < 9; ++it) *(LAS u32x4*)(raw + (it * 512 + tid) * 16) = rq[it];
        {
            const int rw = tid >> 3, pq = tid & 7, which = pq >> 2, p4 = pq & 3;
            *(LAS u32x4*)((which ? a2t : w2t) + rw * 80 + p4 * 16) = wq;
            u32x4 xv = xq;
            if (!which) { xv.x = pk2(tanh_fast(bflo(xv.x)), tanh_fast(bfhi(xv.x))); xv.y = pk2(tanh_fast(bflo(xv.y)), tanh_fast(bfhi(xv.y)));
                          xv.z = pk2(tanh_fast(bflo(xv.z)), tanh_fast(bfhi(xv.z))); xv.w = pk2(tanh_fast(bflo(xv.w)), tanh_fast(bfhi(xv.w))); }
            *(LAS u32x4*)((which ? adl : twl) + rw * 80 + p4 * 16) = xv;
        }
        f32x4 cw9[9];
#pragma unroll
        for (int tap = 0; tap < 9; ++tap) cw9[tap] = *(const f32x4*)(a.in[10] + tap * 1536 + min(tid >> 7, 2) * 512 + h * 64 + 4 * (tid & 15));
        __syncthreads();
        {
            const int which = wave >> 2, m0 = ((wave >> 1) & 1) * 32, n0 = (wave & 1) * 32, r31 = lane & 31, hh = lane >> 5;
            const LAS unsigned char* ap = (which ? adl : twl) + (m0 + r31) * 80 + hh * 16;
            const LAS unsigned char* bp = (which ? a2t : w2t) + (n0 + r31) * 80 + hh * 16;
            f32x16 acc = zero16();
#pragma unroll
            for (int ks = 0; ks < 2; ++ks) acc = __builtin_amdgcn_mfma_f32_32x32x16_bf16(*(const LAS bf16x8*)(ap + ks * 32), *(const LAS bf16x8*)(bp + ks * 32), acc, 0, 0, 0);
            const int c = n0 + r31;
            const float bias = a.in[which ? 13 : 11][d * 512 + h * 64 + c];
#pragma unroll
            for (int r = 0; r < 16; ++r) {
                const int srow = m0 + (r & 3) + 8 * (r >> 2) + 4 * hh; const float x = acc[r] + bias;
                if (which) avl[srow * 64 + c] = (bf16_t)f2bf(sigmoidf_(x));
                else { const float sp = fmaxf(-x, 0.f) + __logf(1.0f + __expf(-fabsf(x))); cum[srow * 64 + c] = -__expf(-sp - 0.5f); }
            }
        }
        const int tt = tid >> 4, cg = tid & 15, ch = h * 64 + 4 * cg;
        const f32x4 kkw = *(const f32x4*)(a.in[16] + ch), kaw = *(const f32x4*)(a.in[17] + ch), rkw = *(const f32x4*)(a.in[18] + ch);
        f32x4 kkn_[2], bv_[2], kd_[2], rr_[2], vv_[2];
        f32x4 cvr[2], cvk[2];
        {
            const int X = tid >> 7, cgc = tid & 15, tb = (tid >> 4) & 7;
            f32x4 oacc[8];
#pragma unroll
            for (int j = 0; j < 8; ++j) oacc[j] = (f32x4){0.f, 0.f, 0.f, 0.f};
            if (X < 3) {
#pragma unroll 1
                for (int aa = 0; aa < 3; ++aa) {
                    const bool rowok = isctx ? (aa == 1) : ((unsigned)(gi - 1 + aa) < 64u);
                    if (!rowok) continue;
                    f32x4 w[3];
#pragma unroll
                    for (int bb2 = 0; bb2 < 3; ++bb2) w[bb2] = aa == 0 ? cw9[bb2] : (aa == 1 ? cw9[3 + bb2] : cw9[6 + bb2]);
                    u32x2 q[10];
#pragma unroll
                    for (int e = 0; e < 10; ++e) {
                        const int jj = 8 * tb + e - 1;
                        int slot; bool ok;
                        if (isctx) { slot = 64 + jj; ok = (unsigned)(64 * gi + jj) < (unsigned)CTXL; }
                        else { slot = aa * 64 + min(max(jj, 0), 63); ok = (unsigned)jj < 64u; }
                        q[e] = *(const LAS u32x2*)(raw + slot * 384 + X * 128 + cgc * 8);
                        if (!ok) { q[e].x = 0u; q[e].y = 0u; }
                    }
#pragma unroll
                    for (int j = 0; j < 8; ++j)
#pragma unroll
                        for (int bb2 = 0; bb2 < 3; ++bb2) { const u32x2 v = q[j + bb2];
                            oacc[j][0] += bflo(v.x) * w[bb2][0]; oacc[j][1] += bfhi(v.x) * w[bb2][1]; oacc[j][2] += bflo(v.y) * w[bb2][2]; oacc[j][3] += bfhi(v.y) * w[bb2][3]; }
                }
            }
            __syncthreads();
            if (X < 3) {
                LAS float* cvo = (LAS float*)raw;
#pragma unroll
                for (int j = 0; j < 8; ++j) { const int pj = 8 * tb + j, sidx = d ? 63 - pj : pj; *(LAS f32x4*)(cvo + (sidx * 3 + X) * 64 + 4 * cgc) = oacc[j]; }
            }
        }
        __syncthreads();
#pragma unroll
        for (int half = 0; half < 2; ++half) { const LAS float* cvo = (const LAS float*)raw + ((half * 32 + tt) * 3) * 64 + 4 * cg;
            cvr[half] = *(const LAS f32x4*)(cvo); cvk[half] = *(const LAS f32x4*)(cvo + 64); vv_[half] = *(const LAS f32x4*)(cvo + 128); }
#pragma unroll
        for (int half = 0; half < 2; ++half) {
            const int s = half * 32 + tt, pj = d ? 63 - s : s;
            const int tokrow = b * SEQ + gi * 64 + pj;
            const f32x4 rr = cvr[half], kv = cvk[half];
            f32x4 kkn = kv * kkw;
            const float ss = row16_sum(kkn[0] * kkn[0] + kkn[1] * kkn[1] + kkn[2] * kkn[2] + kkn[3] * kkn[3]);
            kkn = kkn * (1.0f / sqrtf(fmaxf(ss, 1e-12f)));
            const u32x2 aq = *(const LAS u32x2*)(avl + s * 64 + 4 * cg);
            const f32x4 av = {bflo(aq.x), bfhi(aq.x), bflo(aq.y), bfhi(aq.y)};
            f32x4 kd, bv;
#pragma unroll
            for (int j = 0; j < 4; ++j) { kd[j] = kv[j] * (1.0f + (av[j] - 1.0f) * kaw[j]); bv[j] = kkn[j] * av[j]; }
            const float bon = row16_sum(rr[0] * kd[0] * rkw[0] + rr[1] * kd[1] * rkw[1] + rr[2] * kd[2] * rkw[2] + rr[3] * kd[3] * rkw[3]);
            if (!isctx && cg == 0) BONd[(size_t)tokrow * 8 + h] = bon;
            kkn_[half] = kkn; bv_[half] = bv; kd_[half] = kd; rr_[half] = rr;
        }
        {
            const int k = tid & 63, sg = tid >> 6;
            float run = 0.f;
#pragma unroll
            for (int j = 0; j < 8; ++j) { run += cum[(8 * sg + j) * 64 + k]; cum[(8 * sg + j) * 64 + k] = run; }
            seg[sg * 64 + k] = run;
            __syncthreads();
            float pre = 0.f;
            for (int q = 0; q < sg; ++q) pre += seg[q * 64 + k];
#pragma unroll
            for (int j = 0; j < 8; ++j) cum[(8 * sg + j) * 64 + k] += pre;
            __syncthreads();
        }
        const f32x4 LC = *(LAS f32x4*)(cum + 63 * 64 + 4 * cg);
#pragma unroll 1
        for (int re_ = 0; re_ <= ((PROBE_RPT >> 21) & 1); ++re_)
#pragma unroll
        for (int half = 0; half < 2; ++half) {
            const int s = half * 32 + tt;
            const f32x4 L = *(LAS f32x4*)(cum + s * 64 + 4 * cg);
            f32x4 Lp = {0.f, 0.f, 0.f, 0.f}; if (s > 0) Lp = *(LAS f32x4*)(cum + (s - 1) * 64 + 4 * cg);
            f32x4 bh, kh, at, rt, bb2, kb2;
#pragma unroll
            for (int j = 0; j < 4; ++j) {
                const float em = __expf(-L[j]), ep = __expf(L[j]), epv = __expf(Lp[j]), ec = __expf(LC[j] - L[j]);
                bh[j] = bv_[half][j] * em; kh[j] = kd_[half][j] * em; at[j] = -kkn_[half][j] * epv; rt[j] = rr_[half][j] * ep;
                bb2[j] = bv_[half][j] * ec; kb2[j] = kd_[half][j] * ec;
            }
            const int so = s * 144 + 8 * cg; u32x2 w;
            w.x = pk2(bh[0], bh[1]); w.y = pk2(bh[2], bh[3]); *(LAS u32x2*)(RSLOT(0) + so) = w;
            w.x = pk2(kh[0], kh[1]); w.y = pk2(kh[2], kh[3]); *(LAS u32x2*)(RSLOT(1) + so) = w;
            w.x = pk2(at[0], at[1]); w.y = pk2(at[2], at[3]); *(LAS u32x2*)(RSLOT(2) + so) = w;
            w.x = pk2(rt[0], rt[1]); w.y = pk2(rt[2], rt[3]); *(LAS u32x2*)(RSLOT(3) + so) = w;
            w.x = pk2(bb2[0], bb2[1]); w.y = pk2(bb2[2], bb2[3]); *(LAS u32x2*)(RSLOT(4) + so) = w;
            w.x = pk2(kb2[0], kb2[1]); w.y = pk2(kb2[2], kb2[3]); *(LAS u32x2*)(RSLOT(5) + so) = w;
            w.x = pk2(vv_[half][0], vv_[half][1]); w.y = pk2(vv_[half][2], vv_[half][3]); *(LAS u32x2*)(RSLOT(6) + so) = w;
            if (s == 63) { lamC[4 * cg] = __expf(LC[0]); lamC[4 * cg + 1] = __expf(LC[1]); lamC[4 * cg + 2] = __expf(LC[2]); lamC[4 * cg + 3] = __expf(LC[3]); }
        }
        __syncthreads();
        }
        if (jl + nb < 64 * nstg) RWA_ISSUE(jl + nb);
#pragma unroll 1
        for (int T = wave; T < 20; T += 8) {
            const int prod = T % 5, tq = T / 5; const bool ti = (prod == 1 || prod == 2);
            const int mt = (tq == 2 || (tq == 1 && ti) || (tq == 3 && !ti)) ? 32 : 0, nt = (tq == 2 || (tq == 1 && !ti) || (tq == 3 && ti)) ? 32 : 0;
            f32x16 acc = zero16();
            if (tq < 3) {
                const int ia = prod == 0 ? 0 : (prod == 3 ? 0 : (prod == 4 ? 1 : 2)), ib = prod == 0 ? 2 : (prod == 1 ? 0 : (prod == 2 ? 1 : 3));
                acc = tile_mmx<false, false>(RSLOT(ia), RSLOT(ib), mt, nt, 0, 4, acc, lane);
                mask_tri(acc, mt, nt, lane, ti ? -1 : 1, prod >= 3 ? 0 : 1, prod == 1);
            }
            store_cr(RSLOT(7 + prod), acc, mt, nt, lane);
        }
        LSYNC();
        if (wave < 4) { const int mt = (wave >> 1) * 32, nt = (wave & 1) * 32; f32x16 acc = zero16();
            if (wave != 2) acc = tile_mmx<true, false>(RSLOT(7), RSLOT(7), mt, nt, wave == 3 ? 2 : 0, wave == 0 ? 2 : 4, acc, lane);
            store_cr(RSLOT(0), acc, mt, nt, lane); }
        LSYNC();
#pragma unroll
        for (int lv = 1; lv <= 4; ++lv) {
            const int pc_in = (lv & 1) ? 0 : 7, pc_out = (lv & 1) ? 7 : 0, tr_in = (lv & 1) ? 8 : 1, tr_out = (lv & 1) ? 1 : 8;
            const int w4 = wave & 3, mt = (w4 >> 1) * 32, nt = (w4 & 1) * 32;
            if (wave < 4) {
                if (w4 != 2) { f32x16 acc = tile_mmx<true, false>(RSLOT(pc_in), RSLOT(pc_in), mt, nt, w4 == 3 ? 2 : 0, w4 == 0 ? 2 : 4, zero16(), lane);
                    if (lv == 4) mask_tri(acc, mt, nt, lane, 1, -64, true);
                    store_cr(RSLOT(pc_out), acc, mt, nt, lane); }
            } else {
                if (w4 != 1) { f32x16 acc = init_cr(RSLOT(tr_in), mt, nt, lane);
                    acc = tile_mmx<false, false>(RSLOT(pc_in), RSLOT(tr_in), mt, nt, w4 == 3 ? 2 : 0, w4 == 0 ? 2 : 4, acc, lane);
                    store_cr(RSLOT(tr_out), acc, mt, nt, lane); }
                else if (lv == 1) store_cr(RSLOT(tr_out), zero16(), mt, nt, lane);
            }
            LSYNC();
        }
        if (wave < 4) { const int mt = (wave >> 1) * 32, nt = (wave & 1) * 32; f32x16 acc = zero16();
            if (wave != 2) acc = tile_mmx<false, false>(RSLOT(8), RSLOT(0), mt, nt, wave == 3 ? 2 : 0, wave == 0 ? 2 : 4, acc, lane);
            store_cr(RSLOT(1), acc, mt, nt, lane); }
        LSYNC();
        { const int w4 = wave & 3, mt = (w4 >> 1) * 32, nt = (w4 & 1) * 32; f32x16 acc = zero16();
            if (wave < 4) { acc = tile_mmx<false, true>(RSLOT(1), RSLOT(2), mt, nt, 0, mt ? 4 : 2, acc, lane); store_cr(RSLOT(7), acc, mt, nt, lane); }
            else { if (w4 != 1) acc = tile_mmx<false, false>(RSLOT(1), RSLOT(9), mt, nt, w4 == 3 ? 2 : 0, w4 == 0 ? 2 : 4, acc, lane); store_cr(RSLOT(0), acc, mt, nt, lane); } }
        LSYNC();
#pragma unroll 1
        for (int rl_ = 0; rl_ <= ((PROBE_RPT >> 22) & 1); ++rl_)
        {
            const int prod = wave >> 1, mt = (wave & 1) * 32;
            bf16_t* actj = RACT + (size_t)jl * 4096; bf16_t* rptj = RRPT + (size_t)jl * 4096;
#pragma unroll
            for (int nt2 = 0; nt2 < 2; ++nt2) {
                const int nt = nt2 * 32;
                if (prod == 0) { f32x16 acc = init_cr(RSLOT(3), mt, nt, lane); acc = tile_mmx<false, false>(RSLOT(7), RSLOT(10), mt, nt, 0, nt ? 4 : 2, acc, lane); store_g_perm(rptj, acc, mt, nt, lane); }
                else if (prod == 1) { f32x16 acc = zero16();
                    if (!(mt && !nt)) { acc = init_cr(RSLOT(11), mt, nt, lane); acc = tile_mmx<false, false>(RSLOT(0), RSLOT(10), mt, nt, mt ? 2 : 0, nt ? 4 : 2, acc, lane); }
                    store_cr(RSLOT(8), acc, mt, nt, lane); }
                else if (prod == 2) { f32x16 acc = tile_mmx<false, true>(RSLOT(7), RSLOT(4), mt, nt, 0, 4, zero16(), lane);
                    { const int c = nt + (lane & 31), hh = lane >> 5;
#pragma unroll
                      for (int r = 0; r < 16; ++r) { const int row = mt + (r & 3) + 8 * (r >> 2) + 4 * hh; if (row == c) acc[r] += lamC[row]; } }
                    store_g_perm(actj, acc, mt, nt, lane); }
                else { f32x16 acc = init_rc(RSLOT(5), mt, nt, lane); acc = tile_mmx<false, true>(RSLOT(0), RSLOT(4), mt, nt, mt ? 2 : 0, 4, acc, lane); store_cr(RSLOT(9), acc, mt, nt, lane); }
            }
        }
        LSYNC();
#pragma unroll 1
        for (int rl_ = 0; rl_ <= ((PROBE_RPT >> 22) & 1); ++rl_)
        { const int mt = ((wave >> 1) & 1) * 32, nt = (wave & 1) * 32;
            const f32x16 acc = tile_mmx<false, true>(RSLOT(wave < 4 ? 9 : 8), RSLOT(6), mt, nt, 0, (wave >= 4 && !mt) ? 2 : 4, zero16(), lane);
            store_g_cr((wave < 4 ? RSL : RYL) + (size_t)jl * 4096, acc, mt, nt, lane); }
    }
#undef RWA_ISSUE
    LSYNC();
}

__device__ __forceinline__ void p_rwkv_S(const Args& a, LAS unsigned char* lds, int bid, int nb, int stage) {
    const int tid = opaque_tid(), lane = tid & 63, wave = __builtin_amdgcn_readfirstlane(tid >> 6), vl = lane & 15, g = lane >> 4;
    const int role = wave >> 2, mt = wave & 3;
    const bf16_t* OPB = (const bf16_t*)(a.ws + (role ? WS_RRPT : WS_RACT)); const bf16_t* INB = (const bf16_t*)(a.ws + (role ? WS_RYL : WS_RSL));
    float* RST = (float*)(a.ws + WS_RST); bf16_t* YOUT = (bf16_t*)(a.ws + WS_YOUT);
    LAS unsigned char* bfr = lds;
    const int vcu = (nb % 8 == 0) ? (bid % 8) * (nb / 8) + bid / 8 : bid;
    const int nstg = stage ? RSTG1 : RSTG0, cs0 = stage ? RSTG0 : 0;
    for (int u = vcu; u < 256; u += nb) {
        const int chain = u >> 2, vq = u & 3, d = chain >> 5, b = (chain >> 3) & 3, h = chain & 7;
        f32x4 S = {0.f, 0.f, 0.f, 0.f};
        float* rst = RST + ((size_t)u * 64 + lane) * 16 + 4 * mt;
        if (stage != 0 && role == 0) S = *(const f32x4*)rst;
        __syncthreads();
        if (role == 0) { u32x2 w; w.x = pk2(S[0], S[1]); w.y = pk2(S[2], S[3]); *(LAS u32x2*)(bfr + ((mt >> 1) * 64 + lane) * 16 + (mt & 1) * 8) = w; }
        __syncthreads();
        bf16_t* Yd = YOUT + (size_t)d * NTL * 512 + h * 64 + vq * 16 + vl;
        const bf16_t* opp = OPB + (size_t)chain * nstg * 4096 + (16 * mt + vl) * 64 + 8 * g;
        const bf16_t* inp = INB + (size_t)chain * nstg * 4096 + (vq * 16 + vl) * 64 + 16 * mt + 4 * g;
        bf16x8 fa[8][2]; u32x2 ini[8];
#define RW_LOAD(q, c_) do { fa[q][0] = *(const bf16x8*)(opp + (size_t)(c_) * 4096); fa[q][1] = *(const bf16x8*)(opp + (size_t)(c_) * 4096 + 32); ini[q] = *(const u32x2*)(inp + (size_t)(c_) * 4096); } while (0)
#define RW_STEP(q, c_) do { \
            const LAS unsigned char* bp = bfr + ((c_) & 1) * 2048 + lane * 16; \
            const bf16x8 b0 = *(const LAS bf16x8*)(bp), b1 = *(const LAS bf16x8*)(bp + 1024); \
            f32x4 acc = {bflo(ini[q].x), bfhi(ini[q].x), bflo(ini[q].y), bfhi(ini[q].y)}; \
            acc = __builtin_amdgcn_mfma_f32_16x16x32_bf16(fa[q][0], b0, acc, 0, 0, 0); acc = __builtin_amdgcn_mfma_f32_16x16x32_bf16(fa[q][1], b1, acc, 0, 0, 0); \
            if (role == 0) { S = acc; u32x2 w; w.x = pk2(acc[0], acc[1]); w.y = pk2(acc[2], acc[3]); *(LAS u32x2*)(bfr + (((c_) + 1) & 1) * 2048 + ((mt >> 1) * 64 + lane) * 16 + (mt & 1) * 8) = w; } \
            else { const int cs_ = cs0 + (c_); \
                if (cs_ >= CTXL / RC) { _Pragma("unroll") for (int r = 0; r < 4; ++r) { const int i_ = cs_ * RC + 16 * mt + 4 * g + r - CTXL; const int pos_ = d ? (SEQ - 1 - i_) : i_; \
                    Yd[(size_t)(b * SEQ + pos_) * 512] = (bf16_t)f2bf(acc[r]); } } } \
            asm volatile("s_waitcnt lgkmcnt(0)" ::: "memory"); __builtin_amdgcn_s_barrier(); asm volatile("" ::: "memory"); } while (0)
        RW_LOAD(0, 0); RW_LOAD(1, 1); RW_LOAD(2, 2); RW_LOAD(3, 3); RW_LOAD(4, 4); RW_LOAD(5, 5); RW_LOAD(6, 6);
        static_assert(RSTG0 % 8 == 0 && RSTG1 % 8 == 4, "the prefetch ring below: full groups of 8 chunks, then 4");
#define RW_PAIR(q) do { if (c + (q) + 7 < nstg) RW_LOAD(((q) + 7) & 7, c + (q) + 7); RW_STEP(q, c + (q)); } while (0)
        int c = 0;
#pragma unroll 1
        for (; c + 8 <= nstg; c += 8) {
            RW_PAIR(0); RW_PAIR(1); RW_PAIR(2); RW_PAIR(3); RW_PAIR(4); RW_PAIR(5); RW_PAIR(6); RW_PAIR(7);
        }
        if (c < nstg) { RW_STEP(0, c); RW_STEP(1, c + 1); RW_STEP(2, c + 2); RW_STEP(3, c + 3); }
#undef RW_PAIR
#undef RW_LOAD
#undef RW_STEP
        if (stage == 0 && role == 0) *(f32x4*)rst = S;
    }
    __syncthreads();
}

__device__ __forceinline__ float grp8_sum(float v) { v += dppf<0xB1>(v); v += dppf<0x4E>(v); v += dppf<0x141>(v); return v; }
__device__ __forceinline__ void p_rwkv_readout(const Args& a, int bid, int nb) {
    const int tid = opaque_tid(), lane = tid & 63, wave = tid >> 6, c0 = lane * 8, h = lane >> 3;
    const bf16_t* Z = (const bf16_t*)(a.ws + WS_Z); const bf16_t* Y = (const bf16_t*)(a.ws + WS_YOUT); const float* BON = (const float*)(a.ws + WS_BON);
    const bf16_t* GATE = (const bf16_t*)(a.ws + WS_GATE); bf16_t* MIX = (bf16_t*)(a.ws + WS_MIX);
    float lnw[8], lnb[8];
#pragma unroll
    for (int j = 0; j < 8; ++j) { lnw[j] = a.in[19][c0 + j]; lnb[j] = a.in[20][c0 + j]; }
    for (int tok = bid * 8 + wave; tok < NTL; tok += nb * 8) {
        const int b = tok >> 12, pos = tok & 4095, ti = pos >> 6, tj = pos & 63;
        const u32x4 yf = *(const u32x4*)(Y + (size_t)tok * 512 + c0), yb = *(const u32x4*)(Y + (size_t)(NTL + tok) * 512 + c0);
        const u32x4 gt = *(const u32x4*)(GATE + (size_t)tok * 512 + c0);
        const float bonus = BON[(size_t)tok * 8 + h] + BON[(size_t)(NTL + tok) * 8 + h];
        float y[8] = {bflo(yf.x) + bflo(yb.x), bfhi(yf.x) + bfhi(yb.x), bflo(yf.y) + bflo(yb.y), bfhi(yf.y) + bfhi(yb.y),
                      bflo(yf.z) + bflo(yb.z), bfhi(yf.z) + bfhi(yb.z), bflo(yf.w) + bflo(yb.w), bfhi(yf.w) + bfhi(yb.w)};
        float v[8] = {0.f, 0.f, 0.f, 0.f, 0.f, 0.f, 0.f, 0.f};
        {
            u32x4 q[9]; float vm[9];
#pragma unroll
            for (int aa = 0; aa < 3; ++aa)
#pragma unroll
                for (int bb2 = 0; bb2 < 3; ++bb2) { const int ii = ti + aa - 1, jj = tj + bb2 - 1;
                    vm[aa * 3 + bb2] = (ii >= 0 && ii < 64 && jj >= 0 && jj < 64) ? 1.0f : 0.0f;
                    q[aa * 3 + bb2] = *(const u32x4*)(Z + (size_t)(b * SEQ + min(max(ii, 0), 63) * 64 + min(max(jj, 0), 63)) * ZLD + COL_V + c0); }
#pragma unroll
            for (int tap = 0; tap < 9; ++tap) {
                const f32x4 w0 = *(const f32x4*)(a.in[10] + tap * 1536 + 1024 + c0) * vm[tap], w1 = *(const f32x4*)(a.in[10] + tap * 1536 + 1024 + c0 + 4) * vm[tap];
                v[0] += bflo(q[tap].x) * w0[0]; v[1] += bfhi(q[tap].x) * w0[1]; v[2] += bflo(q[tap].y) * w0[2]; v[3] += bfhi(q[tap].y) * w0[3];
                v[4] += bflo(q[tap].z) * w1[0]; v[5] += bfhi(q[tap].z) * w1[1]; v[6] += bflo(q[tap].w) * w1[2]; v[7] += bfhi(q[tap].w) * w1[3]; }
        }
        float s = 0.f;
#pragma unroll
        for (int j = 0; j < 8; ++j) s += y[j];
        const float mu = grp8_sum(s) * (1.f / 64.f);
        float q2 = 0.f;
#pragma unroll
        for (int j = 0; j < 8; ++j) { y[j] -= mu; q2 += y[j] * y[j]; }
        const float rstd = 1.0f / sqrtf(grp8_sum(q2) * (1.f / 64.f) + 64e-5f);
        const float gv[8] = {bflo(gt.x), bfhi(gt.x), bflo(gt.y), bfhi(gt.y), bflo(gt.z), bfhi(gt.z), bflo(gt.w), bfhi(gt.w)};
        float o[8];
#pragma unroll
        for (int j = 0; j < 8; ++j) o[j] = (y[j] * rstd * lnw[j] + lnb[j] + bonus * v[j]) * gv[j];
        u32x4 w; w.x = pk2(o[0], o[1]); w.y = pk2(o[2], o[3]); w.z = pk2(o[4], o[5]); w.w = pk2(o[6], o[7]);
        *(u32x4*)(MIX + (size_t)tok * DM + c0) = w;
    }
}

constexpr int NPH = 16;
__global__ void __launch_bounds__(NTHREADS, 2) mega(Args a) {
    __builtin_assume(__builtin_amdgcn_workitem_id_y() == 0); __builtin_assume(__builtin_amdgcn_workitem_id_z() == 0);
    extern __shared__ __attribute__((aligned(16))) unsigned char lds_raw[];
    LAS unsigned char* lds = (LAS unsigned char*)lds_raw;
    cg::grid_group grid = cg::this_grid();
    const int tid = threadIdx.x, bid = blockIdx.x, nb = gridDim.x;
    unsigned char* ws = a.ws;
    float* MOD = (float*)(ws + WS_MOD);
    const int lo = a.ph_lo, hi = a.ph_hi;
    volatile LAS unsigned* misc = (volatile LAS unsigned*)(lds + 131072);
    if (tid < 4) misc[tid] = 0u;
    __syncthreads();
    const XcdBarrier xbar = xcd_barrier_post((unsigned*)(ws + WS_CTL), misc);
#define IN(k) (lo <= (k) && (k) < hi)
#define SEAM(k) do { if (IN(k) && IN((k) + 1)) xcd_barrier(xbar); } while (0)
    if (lo < 0) grid.sync();
#define PHASE(k, ...) if (IN(k)) { __VA_ARGS__ if ((PROBE_RPT >> (k)) & 1) { xcd_barrier(xbar); __VA_ARGS__ } } SEAM(k);
    PHASE(0, {
        p0_mod(a, lds, bid, nb);
        __syncthreads();
        p0_weights(a, lds, bid, nb, 0);
        __syncthreads();
        p0_s5(a, lds, bid, nb);
    })
    PHASE(1, {
        p1_s5(a, lds, bid, nb);
        bf16_t* HM = (bf16_t*)(ws + WS_HMOD); const int t_ = opaque_tid(), lane = t_ & 63, wave = t_ >> 6;
        for (int row = bid * 8 + wave; row < NTOK; row += nb * 16) {
            const int rowB = row + nb * 8; const bool hasB = rowB < NTOK;
            const RowV ra = row_load(row < NTL ? a.in[0] + (size_t)row * DM : a.in[2] + (size_t)(row - NTL) * DM, lane);
            RowV rb = ra; if (hasB) rb = row_load(rowB < NTL ? a.in[0] + (size_t)rowB * DM : a.in[2] + (size_t)(rowB - NTL) * DM, lane);
            { const int mb = row < NTL ? (row >> 12) : 4; norm_mod_finish(ra, a.in[6], MOD + mb * 6144, MOD + mb * 6144 + 1024, HM + (size_t)row * DM, lane); }
            if (hasB) { const int mb = rowB < NTL ? (rowB >> 12) : 4; norm_mod_finish(rb, a.in[6], MOD + mb * 6144, MOD + mb * 6144 + 1024, HM + (size_t)rowB * DM, lane); }
        }
    })
    PHASE(2, {
        pg8::Gemm g{(const bf16_t*)(ws + WS_HMOD), (const bf16_t*)(ws + WS_WTIN), DM, DM, DM};
        pg8::StaticOrder S; S.init(NTOK, DINP, nb, bid);
        pg8::EpiZ E{(bf16_t*)(ws + WS_Z), (bf16_t*)(ws + WS_AALL), (bf16_t*)(ws + WS_SIG)};
        pg8::gemm_phase(lds, g, S, E);
    })
    PHASE(3, {
        pg8::Gemm g{(const bf16_t*)(ws + WS_AALL), (const bf16_t*)(ws + WS_BT2), S5K1, 512, 512};
        pg8::S5Order2 S{nb, bid};
        pg8::EpiE E{(float*)(ws + WS_E)};
        pg8::gemm_phase(lds, g, S, E);
    })
    PHASE(4, { p_s5_carry(a, bid, nb); __syncthreads(); p0_weights(a, lds, bid, nb, 1); if ((PROBE_RPT >> 23) & 1) { for (int q_ = 0; q_ < 10; ++q_) xcd_barrier(xbar); } })
    PHASE(5, {
        if (bid < nb / 2) {
            pg8::Gemm g{(const bf16_t*)(ws + WS_AALL), (const bf16_t*)(ws + WS_BT1), S5K1, S5K1, S5K1};
            pg8::S5Order1 S{nb / 2, bid};
            pg8::EpiY E{(const bf16_t*)(ws + WS_AALL), a.in[28], (bf16_t*)(ws + WS_ZG)};
            pg8::gemm_phase(lds, g, S, E);
        } else {
            pg8::Gemm g2{(const bf16_t*)(ws + WS_SIG), (const bf16_t*)(ws + WS_G2T), 256, 256, 256};
            pg8::StaticOrder S2; S2.init(NTL, 512, nb - nb / 2, bid - nb / 2);
            pg8::EpiG E2{(bf16_t*)(ws + WS_GATE)};
            pg8::gemm_phase(lds, g2, S2, E2);
        }
    })
#pragma unroll 1
    for (int rep6 = 0; rep6 <= ((PROBE_RPT >> 6) & 1); ++rep6) {
        if (rep6) xcd_barrier(xbar);
#pragma unroll 1
        for (int st = 0; st < 2; ++st) {
            if (IN(6 + 2 * st)) { p_rwkv_A(a, lds, bid, nb, st); if ((PROBE_RPT >> 16) & 1) { xcd_barrier(xbar); p_rwkv_A(a, lds, bid, nb, st); } }
            if (IN(6 + 2 * st) && IN(7 + 2 * st)) xcd_barrier(xbar);
            if (IN(7 + 2 * st)) { p_rwkv_S(a, lds, bid, nb, st); if ((PROBE_RPT >> 17) & 1) { xcd_barrier(xbar); p_rwkv_S(a, lds, bid, nb, st); } }
            if (st == 0 && IN(7) && IN(8)) xcd_barrier(xbar);
        }
    }
    SEAM(9);
    PHASE(10, {
        p_rwkv_readout(a, bid, nb);
        __syncthreads();
        pg8::Gemm g{(const bf16_t*)(ws + WS_ZG), (const bf16_t*)(ws + WS_WTGLU), 512, 512, 512};
        pg8::StaticOrder S; S.init(NTL, 512, nb, bid);
        pg8::EpiGLU E{(const bf16_t*)(ws + WS_ZG), a.in[30], (bf16_t*)(ws + WS_MIX)};
        pg8::gemm_phase(lds, g, S, E);
    })
    PHASE(11, {
        pg8::Gemm g{(const bf16_t*)(ws + WS_MIX), (const bf16_t*)(ws + WS_WTOUT), DM, DM, DM};
        pg8::StaticOrder S; S.init(NTL, DM, nb, bid);
        pg8::PanelSumsq st{(float*)(ws + WS_XBUF), (unsigned*)(ws + WS_CTL + 16384)};
        pg8::EpiWoutNorm E{a.in[0], a.out, MOD, a.in[7], (bf16_t*)(ws + WS_HMOD), st};
        pg8::gemm_phase(lds, g, S, E);
    })
    PHASE(13, {
        pg8::Gemm g{(const bf16_t*)(ws + WS_HMOD), (const bf16_t*)(ws + WS_WT13), DM, DM, DM};
        pg8::StaticOrder S; S.init(NTL, 2 * DFF, nb, bid);
        pg8::EpiUp E{(bf16_t*)(ws + WS_ACT)};
        pg8::gemm_phase(lds, g, S, E);
    })
    if (IN(14)) {
        pg8::Gemm g{(const bf16_t*)(ws + WS_ACT), (const bf16_t*)(ws + WS_WT2), DFF, DFF, DFF};
        pg8::StaticOrder S; S.init(NTL, DM, nb, bid);
        pg8::PanelSumsq st{(float*)(ws + WS_XBUF) + 64 * 256 * 4, (unsigned*)(ws + WS_CTL + 32768)};
        pg8::EpiDownNorm E{a.out, MOD, a.in[34], st};
        pg8::gemm_phase(lds, g, S, E);
    }
#undef PHASE
#undef IN
#undef SEAM
}

extern "C" void kernel_launch(void* const* d_in, const int* in_sizes, int n_in, void* d_out, int out_size, void* d_ws, size_t ws_size, hipStream_t stream) {
    static int grid_blocks = 0;
    if (!grid_blocks) {
        int dev = 0, cus = 0, per_cu = 0;
        (void)hipGetDevice(&dev);
        (void)hipDeviceGetAttribute(&cus, hipDeviceAttributeMultiprocessorCount, dev);
        if (hipFuncSetAttribute((const void*)mega, hipFuncAttributeMaxDynamicSharedMemorySize, LDS_BYTES) != hipSuccess) fprintf(stderr, "hipFuncSetAttribute failed\n");
        (void)hipOccupancyMaxActiveBlocksPerMultiprocessor(&per_cu, (const void*)mega, NTHREADS, LDS_BYTES);
        if (ws_size < WS_END || n_in != 35) { fprintf(stderr, "kernel_launch: need %zu bytes of workspace (have %zu), 35 inputs (have %d)\n", (size_t)WS_END, ws_size, n_in); grid_blocks = -1; return; }
        if (per_cu < 1) { fprintf(stderr, "kernel_launch: occupancy query says %d blocks per CU\n", per_cu); per_cu = 1; }
        grid_blocks = cus;
        if (cus != 256) fprintf(stderr, "kernel_launch: built for a 256-CU device (the fused-norm GEMM epilogues need exactly one 256x256 unit per workgroup); got %d CUs\n", cus);
    }
    if (grid_blocks < 0) return;
    Args a{};
    for (int i = 0; i < 35; ++i) a.in[i] = (const float*)d_in[i];
    a.out = (float*)d_out; a.ws = (unsigned char*)d_ws; a.ph_lo = 0; a.ph_hi = NPH;
    (void)hipMemsetAsync((char*)d_ws + WS_CTL, 0, CTL_BYTES, stream);
    void* args[] = {&a};
    hipError_t e = hipLaunchCooperativeKernel((const void*)mega, dim3(grid_blocks), dim3(NTHREADS), args, LDS_BYTES, stream);
    if (e != hipSuccess) fprintf(stderr, "cooperative launch failed: %s (grid %d)\n", hipGetErrorString(e), grid_blocks);
}
```

```cpp
#include <hip/hip_runtime.h>
#include <hip/hip_cooperative_groups.h>
#include <cstdio>
namespace cg = cooperative_groups;

#define LAS __attribute__((address_space(3)))
typedef unsigned short bf16_t;
typedef short bf16x8 __attribute__((ext_vector_type(8)));
typedef float f32x4 __attribute__((ext_vector_type(4)));
typedef float f32x2 __attribute__((ext_vector_type(2)));
typedef unsigned u32x4 __attribute__((ext_vector_type(4)));
typedef unsigned u32x2 __attribute__((ext_vector_type(2)));

constexpr int NTHREADS = 512;
constexpr int LDS_BYTES = 131072 + 4096;
constexpr int DM = 1024, BATCH = 4, SEQ = 4096, CTXL = 256;
constexpr int NTL = BATCH * SEQ, NTC = BATCH * CTXL, NTOK = NTL + NTC;
constexpr int DIN = 2272, DINP = 2304, ZLD = 1792;
constexpr int COL_K = 512, COL_V = 1024, COL_WD = 1536, COL_AD = 1600, COL_GD = 1664, COL_U = 1760;
constexpr int DFF = 2816;
constexpr int S5C = 32;
constexpr int S5ROWS = 768;
constexpr int S5EROWS = 544;
constexpr int S5K1 = 768;

constexpr size_t al256(size_t x) { return (x + 255) & ~(size_t)255; }
constexpr size_t WS_CTL   = 0;
constexpr size_t CTL_BYTES = 65536;
constexpr size_t WS_MOD   = CTL_BYTES;
constexpr size_t WS_WTIN  = al256(WS_MOD + (size_t)5 * 6144 * 4);
constexpr size_t WS_WTOUT = al256(WS_WTIN + (size_t)DINP * DM * 2);
constexpr size_t WS_WT13  = al256(WS_WTOUT + (size_t)DM * DM * 2);
constexpr size_t WS_WT2   = al256(WS_WT13 + (size_t)2 * DFF * DM * 2);
constexpr size_t WS_WTGLU = al256(WS_WT2 + (size_t)DM * DFF * 2);
constexpr size_t WS_S5TAB = al256(WS_WTGLU + (size_t)512 * 512 * 2);
constexpr size_t WS_KT    = al256(WS_S5TAB + (size_t)2 * 32 * 64 * 2 * 4);
constexpr size_t WS_W2T   = al256(WS_KT + (size_t)32 * 16384 * 4);
constexpr size_t WS_BON   = al256(WS_W2T + (size_t)2 * 2 * 512 * 32 * 2);
constexpr size_t WS_ZG    = al256(WS_BON + (size_t)2 * NTL * 8 * 4);
constexpr size_t WS_HMOD  = al256(WS_ZG + (size_t)NTL * 512 * 2);
constexpr size_t WS_Z     = al256(WS_HMOD + (size_t)NTOK * DM * 2);
constexpr size_t WS_AALL  = al256(WS_Z + (size_t)NTOK * ZLD * 2);
constexpr size_t WS_BT1   = al256(WS_AALL + (size_t)32 * S5ROWS * S5K1 * 2);
constexpr size_t WS_BT2   = al256(WS_BT1 + (size_t)32 * 512 * S5K1 * 2);
constexpr size_t WS_E     = al256(WS_BT2 + (size_t)32 * 256 * 512 * 2);
constexpr size_t WS_S5END = al256(WS_E + (size_t)32 * S5EROWS * 256 * 4);
constexpr size_t WS_SIG   = WS_S5END;
constexpr size_t WS_G2T   = al256(WS_SIG + (size_t)NTL * 256 * 2);
constexpr size_t WS_GATE  = al256(WS_G2T + (size_t)512 * 256 * 2);
constexpr size_t WS_XBUF  = al256(WS_GATE + (size_t)NTL * 512 * 2);
constexpr size_t WS_END2  = al256(WS_XBUF + (size_t)2 * 64 * 256 * 4 * 4);
constexpr size_t WS_ACT   = WS_Z;

constexpr size_t WS_END = WS_END2;
static_assert(WS_ACT + (size_t)NTL * DFF * 2 <= WS_S5END, "ACT alias");

#ifndef PROBE_RPT
#define PROBE_RPT 0
#endif
struct Args { const float* in[35]; float* out; unsigned char* ws; int ph_lo, ph_hi; };

typedef __bf16 bf16x2_t __attribute__((ext_vector_type(2)));
__device__ __forceinline__ unsigned pk2(float lo, float hi) { const f32x2 v = {lo, hi}; return __builtin_bit_cast(unsigned, __builtin_convertvector(v, bf16x2_t)); }
__device__ __forceinline__ unsigned f2bf(float f) { return pk2(f, f) & 0xffffu; }
__device__ __forceinline__ float bflo(unsigned w) { return __builtin_bit_cast(float, w << 16); }
__device__ __forceinline__ float bfhi(unsigned w) { return __builtin_bit_cast(float, w & 0xffff0000u); }
__device__ __forceinline__ float bf2f(bf16_t b) { return __builtin_bit_cast(float, ((unsigned)b) << 16); }
__device__ __forceinline__ float wave_sum(float v) {
#pragma unroll
    for (int o = 1; o < 64; o <<= 1) v += __shfl_xor(v, o);
    return v;
}
template <int CTRL> __device__ __forceinline__ float dppf(float v) { return __builtin_bit_cast(float, __builtin_amdgcn_update_dpp(0, __builtin_bit_cast(int, v), CTRL, 0xf, 0xf, false)); }
__device__ __forceinline__ float row16_sum(float v) { v += dppf<0x128>(v); v += dppf<0x124>(v); v += dppf<0x122>(v); v += dppf<0x121>(v); return v; }
__device__ __forceinline__ int opaque_tid() { int t = threadIdx.x; asm volatile("" : "+v"(t)); return t; }
__device__ __forceinline__ float fexp(float x) { return __builtin_amdgcn_exp2f(x * 1.4426950408889634f); }
__device__ __forceinline__ float flog(float x) { return __builtin_amdgcn_logf(x) * 0.6931471805599453f; }
__device__ __forceinline__ float sigmoidf_(float x) { return __builtin_amdgcn_rcpf(1.0f + fexp(-x)); }
__device__ __forceinline__ float siluf_(float x) { return x * __builtin_amdgcn_rcpf(1.0f + fexp(-x)); }
__device__ __forceinline__ float tanh_fast(float x) { return 1.0f - 2.0f * __builtin_amdgcn_rcpf(1.0f + fexp(2.0f * x)); }
__device__ __forceinline__ float gelu_tanh(float x) { const float u = 0.7978845608028654f * (x + 0.044715f * x * x * x); return x - x * __builtin_amdgcn_rcpf(1.0f + fexp(2.0f * u)); }

#define XB_TMO      128
#define XB_XCNT(j)  (256  + 64 * (j))
#define XB_XSUB(j)  (1280 + 64 * (j))
#define XB_XGEN(j)  (2304 + 64 * (j))
#define XB_TOP      3328
#define XB_TOPGEN   3392
#define XCD_BAR_WORDS 3456
#define XB_SPIN_CAP (1u << 20)
static_assert(XCD_BAR_WORDS * 4 <= CTL_BYTES, "ctl");
__device__ __forceinline__ unsigned xb_ld(unsigned* p)              { return __hip_atomic_load(p, __ATOMIC_RELAXED, __HIP_MEMORY_SCOPE_AGENT); }
__device__ __forceinline__ unsigned xb_add(unsigned* p, unsigned v) { return __hip_atomic_fetch_add(p, v, __ATOMIC_RELAXED, __HIP_MEMORY_SCOPE_AGENT); }
__device__ __forceinline__ unsigned xb_xcc_id() { return (unsigned)__builtin_amdgcn_s_getreg((3 << 11) | 20) & 0xFu; }
#define XB_SPIN(cond, bar) do { unsigned _sp = 0; while (cond) { __builtin_amdgcn_s_sleep(1); \
    if ((++_sp & 255u) == 0u) { if (xb_ld(&(bar)[XB_TMO])) break; if (_sp > XB_SPIN_CAP) { atomicAdd(&(bar)[XB_TMO], 1u); break; } } } } while (0)
struct XcdBarrier { unsigned* bar; unsigned x; volatile LAS unsigned* st; };
__device__ __forceinline__ XcdBarrier xcd_barrier_post(unsigned* bar, volatile LAS unsigned* st) {
    XcdBarrier b; b.bar = bar; b.x = xb_xcc_id(); b.st = st;
    if (threadIdx.x == 0) (void)xb_add(&bar[XB_XCNT(b.x)], 1u);
    return b;
}
__device__ __forceinline__ void xcd_barrier_complete(unsigned* bar, unsigned x, unsigned& nloc, unsigned& nx) {
    const unsigned G = gridDim.x * gridDim.y * gridDim.z;
    unsigned sum, cnt, mine, sp = 0u;
    for (;;) {
        sum = 0u; cnt = 0u; mine = 0u;
#pragma unroll
        for (unsigned j = 0; j < 16; ++j) { const unsigned c = xb_ld(&bar[XB_XCNT(j)]); sum += c; cnt += (c > 0u) ? 1u : 0u; mine = (j == x) ? c : mine; }
        if (sum == G) break;
        __builtin_amdgcn_s_sleep(1);
        if ((++sp & 255u) == 0u) { if (xb_ld(&bar[XB_TMO])) break; if (sp > XB_SPIN_CAP) { atomicAdd(&bar[XB_TMO], 1u); break; } }
    }
    nloc = mine > 0u ? mine : 1u; nx = cnt > 0u ? cnt : 1u;
}
__device__ __forceinline__ void xcd_barrier(const XcdBarrier& b) {
    asm volatile("s_waitcnt vmcnt(0)" ::: "memory");
    __syncthreads();
    if (threadIdx.x == 0) {
        unsigned* bar = b.bar;
        __builtin_amdgcn_s_waitcnt(0);
        unsigned nloc = b.st[0], nx = b.st[1];
        if (nloc == 0u) { xcd_barrier_complete(bar, b.x, nloc, nx); b.st[0] = nloc; b.st[1] = nx; }
        const unsigned old = xb_add(&bar[XB_XSUB(b.x)], 1u);
        const unsigned gen = old / nloc;
        if (old + 1u == (gen + 1u) * nloc) {
            __builtin_amdgcn_fence(__ATOMIC_RELEASE, "agent");
            asm volatile("s_waitcnt vmcnt(0)" ::: "memory");
            const unsigned og = xb_add(&bar[XB_TOP], 1u);
            const unsigned tg = og / nx;
            if (og + 1u == (tg + 1u) * nx) xb_add(&bar[XB_TOPGEN], 1u);
            else XB_SPIN(xb_ld(&bar[XB_TOPGEN]) == tg, bar);
            __builtin_amdgcn_fence(__ATOMIC_ACQUIRE, "agent");
            xb_add(&bar[XB_XGEN(b.x)], 1u);
            asm volatile("s_waitcnt vmcnt(0)" ::: "memory");
        } else {
            XB_SPIN(xb_ld(&bar[XB_XGEN(b.x)]) == gen, bar);
            __builtin_amdgcn_fence(__ATOMIC_ACQUIRE, "agent");
            asm volatile("s_waitcnt vmcnt(0)" ::: "memory");
        }
    }
    __syncthreads();
}

namespace pg8 {
constexpr int BM = 256, BK = 64, HALF = 128, HTB = HALF * BK * 2, STAGE_BYTES = 8 * HTB, NXCD = 8, WGM = 8;
__host__ __device__ __forceinline__ int lds_byte(int r, int c) { const int st = (r >> 4) * 2 + (c >> 5), rr = r & 15, cc = c & 31, ob = rr * 64 + cc * 2; return st * 1024 + (ob ^ (((ob >> 9) & 1) << 5)); }
__host__ __device__ __forceinline__ void stage_rc(int b, int& R, int& C) { const int st = b / 1024, sb = b % 1024, swz = sb ^ (((sb >> 9) & 1) << 5); R = (st >> 1) * 16 + swz / 64; C = (st & 1) * 32 + (swz % 64) / 2; }
__host__ __device__ __forceinline__ int perm32(int rho) { const int n = rho >> 4, i = rho & 15; return 8 * (i >> 2) + 4 * n + (i & 3); }
struct Unit { int pm, pn; };
struct Gemm { const bf16_t* A; const bf16_t* Bt; int lda, ldb, K; };
struct StaticOrder {
    int nM, nN, nwg, G, c;
    __device__ void init(int M, int N, int G_, int c_) { nM = M / BM; nN = N / BM; nwg = nM * nN; G = G_; c = c_; }
    __device__ bool next(int i, Unit& u) const {
        const long L = (long)i * G + c; if (L >= nwg) return false;
        int wgid = (int)L; { const int q = nwg / NXCD, r = nwg % NXCD, xcd = wgid % NXCD, off = wgid / NXCD; wgid = (xcd < r ? xcd * (q + 1) : r * (q + 1) + (xcd - r) * q) + off; }
        const int nig = WGM * nN, gid = wgid / nig, fm = gid * WGM, gsz = (nM - fm) < WGM ? (nM - fm) : WGM;
        u.pm = fm + ((wgid % nig) % gsz); u.pn = (wgid % nig) / gsz; return true;
    }
};
struct S5Order2 { int G, c; __device__ bool next(int i, Unit& u) const { const int L = i * G + c; if (L >= 96) return false; const int g = L / 3; u.pm = g * 3 + L % 3; u.pn = g; return true; } };
struct S5Order1 { int G, c; __device__ bool next(int i, Unit& u) const { const int L = i * G + c; if (L >= 128) return false; const int g = L >> 2; u.pm = g * 3 + ((L >> 1) & 1); u.pn = g * 2 + (L & 1); return true; } };

template <class Epi, class Sched>
__device__ __forceinline__ void gemm_phase(LAS unsigned char* lds, const Gemm g, const Sched& S, const Epi& E) {
    int tid_ = threadIdx.x; asm volatile("" : "+v"(tid_));
    const int tid = tid_, wid = __builtin_amdgcn_readfirstlane(tid >> 6), lane = tid & 63, wr = wid >> 2, wc = wid & 3, fr = lane & 15, fq = lane >> 4;
    const int K = g.K, nt = K / BK;
    unsigned voffA[2], voffB[2];
#pragma unroll
    for (int i = 0; i < 2; ++i) { int R, C; stage_rc(tid * 16 + i * 8192, R, C); const int Rb = Epi::PERM ? ((R & ~31) + perm32(R & 31)) : R;
        voffA[i] = (unsigned)(R * g.lda + C) * 2u; voffB[i] = (unsigned)(Rb * g.ldb + C) * 2u; }
    const size_t kstep = (size_t)(BK * 2);
    const size_t hstepA = (size_t)HALF * g.lda * 2, hstepB = (size_t)HALF * g.ldb * 2;
    const size_t tstepA = 2 * hstepA, tstepB = 2 * hstepB;
    const unsigned ldsw = (unsigned)wid * 1024u;
    const int aoff = lds_byte(wr * 64 + fr, fq * 8), boff = lds_byte(wc * 32 + fr, fq * 8);
#define PG8_SA(b, h) (((b) * 2 + (h)) * HTB)
#define PG8_SB(b, h) ((4 + (b) * 2 + (h)) * HTB)
#define PG8_STAGE(bufoff, gbase, voff) do { _Pragma("unroll") for (int _i = 0; _i < 2; ++_i) \
        __builtin_amdgcn_global_load_lds((const unsigned*)((const char*)(gbase) + (voff)[_i]), (LAS unsigned*)(lds + (bufoff) + ldsw + _i * 8192), 16, 0, 0); } while (0)
#define PG8_LDA(dst, b, h) do { _Pragma("unroll") for (int m = 0; m < 4; ++m) _Pragma("unroll") for (int k = 0; k < 2; ++k) dst[m][k] = *(const LAS bf16x8*)(lds + PG8_SA(b, h) + aoff + m * 2048 + k * 1024); } while (0)
#define PG8_LDB(dst, b, h) do { _Pragma("unroll") for (int n = 0; n < 2; ++n) _Pragma("unroll") for (int k = 0; k < 2; ++k) dst[n][k] = *(const LAS bf16x8*)(lds + PG8_SB(b, h) + boff + n * 2048 + k * 1024); } while (0)
#define PG8_MMA(ai, bj, At, Bt) do { __builtin_amdgcn_s_setprio(1); _Pragma("unroll") for (int m = 0; m < 4; ++m) _Pragma("unroll") for (int n = 0; n < 2; ++n) _Pragma("unroll") for (int k = 0; k < 2; ++k) \
        acc[ai][bj][m][n] = __builtin_amdgcn_mfma_f32_16x16x32_bf16(Bt[n][k], At[m][k], acc[ai][bj][m][n], 0, 0, 0); __builtin_amdgcn_s_setprio(0); } while (0)
#define PG8_WAIT_V(n) asm volatile("s_waitcnt vmcnt(" #n ")" ::: "memory")
#define PG8_WAIT_L(n) asm volatile("s_waitcnt lgkmcnt(" #n ")" ::: "memory")
#define PG8_BAR __builtin_amdgcn_s_barrier()
#define PG8_SCHED __builtin_amdgcn_sched_barrier(0)
    Unit cur, nxt; int ui = 0;
    if (!S.next(0, cur)) return;
    f32x4 acc[2][2][4][2];
#pragma unroll
    for (int a = 0; a < 2; ++a)
#pragma unroll
        for (int b = 0; b < 2; ++b)
#pragma unroll
            for (int m = 0; m < 4; ++m)
#pragma unroll
                for (int n = 0; n < 2; ++n) acc[a][b][m][n] = (f32x4){0.f, 0.f, 0.f, 0.f};
    bf16x8 At[4][2], B0[2][2], B1[2][2];
    const char* cA = (const char*)g.A + (size_t)cur.pm * tstepA; const char* cB = (const char*)g.Bt + (size_t)cur.pn * tstepB;
    PG8_STAGE(PG8_SB(0, 0), cB, voffB); PG8_STAGE(PG8_SA(0, 0), cA, voffA); PG8_STAGE(PG8_SB(0, 1), cB + hstepB, voffB); PG8_STAGE(PG8_SA(0, 1), cA + hstepA, voffA);
    if (wr == 1) PG8_BAR;
    PG8_WAIT_V(4); PG8_BAR;
    PG8_STAGE(PG8_SB(1, 0), cB + kstep, voffB); PG8_STAGE(PG8_SA(1, 0), cA + kstep, voffA); PG8_STAGE(PG8_SB(1, 1), cB + hstepB + kstep, voffB);
    PG8_WAIT_V(6); PG8_BAR;
    for (;;) {
        const bool has_next = S.next(ui + 1, nxt);
        const char* nA = has_next ? (const char*)g.A + (size_t)nxt.pm * tstepA : cA; const char* nB = has_next ? (const char*)g.Bt + (size_t)nxt.pn * tstepB : cB;
        for (int t = 0; t < nt; t += 2) {
            const bool last = (t == nt - 2);
            const char* a1 = cA + (size_t)(t + 1) * kstep;
            const char* a2 = last ? nA : cA + (size_t)(t + 2) * kstep; const char* b2 = last ? nB : cB + (size_t)(t + 2) * kstep;
            const char* a3 = a2 + kstep; const char* b3 = b2 + kstep;
            PG8_LDB(B0, 0, 0); PG8_SCHED; PG8_LDA(At, 0, 0); PG8_STAGE(PG8_SA(1, 1), a1 + hstepA, voffA);
            PG8_WAIT_L(8); PG8_BAR; PG8_WAIT_L(0); PG8_MMA(0, 0, At, B0); PG8_BAR; PG8_SCHED;
            PG8_LDB(B1, 0, 1); PG8_STAGE(PG8_SB(0, 0), b2, voffB);
            PG8_BAR; PG8_WAIT_L(0); PG8_MMA(0, 1, At, B1); PG8_BAR;
            PG8_LDA(At, 0, 1); PG8_STAGE(PG8_SA(0, 0), a2, voffA);
            PG8_BAR; PG8_WAIT_L(0); PG8_MMA(1, 0, At, B0); PG8_BAR; PG8_SCHED;
            PG8_STAGE(PG8_SB(0, 1), b2 + hstepB, voffB);
            PG8_WAIT_V(6); PG8_BAR; PG8_MMA(1, 1, At, B1); PG8_BAR;
            PG8_LDB(B0, 1, 0); PG8_SCHED; PG8_LDA(At, 1, 0); PG8_STAGE(PG8_SA(0, 1), a2 + hstepA, voffA);
            PG8_WAIT_L(8); PG8_BAR; PG8_WAIT_L(0); PG8_MMA(0, 0, At, B0); PG8_BAR; PG8_SCHED;
            PG8_LDB(B1, 1, 1); PG8_STAGE(PG8_SB(1, 0), b3, voffB);
            PG8_BAR; PG8_WAIT_L(0); PG8_MMA(0, 1, At, B1); PG8_BAR;
            PG8_LDA(At, 1, 1); PG8_STAGE(PG8_SA(1, 0), a3, voffA);
            PG8_BAR; PG8_WAIT_L(0); PG8_MMA(1, 0, At, B0); PG8_BAR; PG8_SCHED;
            PG8_STAGE(PG8_SB(1, 1), b3 + hstepB, voffB);
            PG8_WAIT_V(6); PG8_BAR; PG8_MMA(1, 1, At, B1); PG8_BAR;
        }
        if constexpr (!Epi::AFTER_DRAIN) E(acc, cur, wr, wc, fr, fq);
        if (!has_next) break;
#pragma unroll
        for (int a = 0; a < 2; ++a)
#pragma unroll
            for (int b = 0; b < 2; ++b)
#pragma unroll
                for (int m = 0; m < 4; ++m)
#pragma unroll
                    for (int n = 0; n < 2; ++n) acc[a][b][m][n] = (f32x4){0.f, 0.f, 0.f, 0.f};
        cur = nxt; cA = nA; cB = nB; ++ui;
    }
    PG8_WAIT_V(0);
    if (wr == 0) PG8_BAR;
    PG8_BAR;
    if constexpr (Epi::AFTER_DRAIN) E.fused(acc, cur, wr, wc, fr, fq, lds, wid, lane);
#undef PG8_SA
#undef PG8_SB
#undef PG8_STAGE
#undef PG8_LDA
#undef PG8_LDB
#undef PG8_MMA
#undef PG8_WAIT_V
#undef PG8_WAIT_L
#undef PG8_BAR
#undef PG8_SCHED
}
typedef f32x4 Acc[2][2][4][2];

__device__ __forceinline__ u32x4 pack8(const f32x4 v0, const f32x4 v1) { u32x4 w; w.x = pk2(v0[0], v0[1]); w.y = pk2(v0[2], v0[3]); w.z = pk2(v1[0], v1[1]); w.w = pk2(v1[2], v1[3]); return w; }

struct EpiZ {
    static constexpr bool PERM = true, AFTER_DRAIN = false;
    bf16_t* Z; bf16_t* Aall; bf16_t* SIG;
    __device__ __forceinline__ void operator()(const Acc& acc, const Unit& u, int wr, int wc, int fr, int fq) const {
#pragma unroll
        for (int ai = 0; ai < 2; ++ai)
#pragma unroll
            for (int m = 0; m < 4; ++m) {
                const int row = u.pm * BM + ai * HALF + wr * 64 + m * 16 + fr;
                int cr, s; if (row < NTL) { cr = row >> 5; s = row & 31; } else { const int rc = row - NTL; cr = 512 + (rc >> 5); s = rc & 31; }
#pragma unroll
                for (int bj = 0; bj < 2; ++bj) {
                    const int col = u.pn * BM + bj * HALF + wc * 32 + 8 * fq;
                    const u32x4 w = pack8(acc[ai][bj][m][0], acc[ai][bj][m][1]);
                    if (col >= COL_GD && col < COL_U) { if (row < NTL) { f32x4 s0, s1;
#pragma unroll
                            for (int j = 0; j < 4; ++j) { s0[j] = sigmoidf_(acc[ai][bj][m][0][j]); s1[j] = sigmoidf_(acc[ai][bj][m][1][j]); }
                            *(u32x4*)(SIG + (size_t)row * 256 + (col - COL_GD)) = pack8(s0, s1); } }
                    else if (col < COL_U) *(u32x4*)(Z + (size_t)row * ZLD + col) = w;
                    else if (col < DIN) { const int g = (col - COL_U) >> 4, h0 = (col - COL_U) & 15; *(u32x4*)(Aall + ((size_t)(g * S5ROWS + cr)) * S5K1 + s * 16 + h0) = w; }
                }
            }
    }
};
struct EpiE {
    static constexpr bool PERM = false, AFTER_DRAIN = false;
    float* E;
    __device__ __forceinline__ void operator()(const Acc& acc, const Unit& u, int wr, int wc, int fr, int fq) const {
        const int g = u.pn;
#pragma unroll
        for (int ai = 0; ai < 2; ++ai)
#pragma unroll
            for (int m = 0; m < 4; ++m) {
                const int cr = (u.pm - g * 3) * BM + ai * HALF + wr * 64 + m * 16 + fr;
                if (cr < S5EROWS) {
                    float* rowp = E + ((size_t)(g * S5EROWS + cr)) * 256 + wc * 32 + 4 * fq;
#pragma unroll
                    for (int bj = 0; bj < 2; ++bj)
#pragma unroll
                        for (int n = 0; n < 2; ++n) *(f32x4*)(rowp + bj * HALF + n * 16) = acc[ai][bj][m][n];
                }
            }
    }
};
struct EpiY {
    static constexpr bool PERM = true, AFTER_DRAIN = false;
    const bf16_t* Aall; const float* dskip; bf16_t* ZG;
    __device__ __forceinline__ void operator()(const Acc& acc, const Unit& u, int wr, int wc, int fr, int fq) const {
        const int g = u.pn >> 1, pnn = u.pn & 1;
#pragma unroll
        for (int ai = 0; ai < 2; ++ai)
#pragma unroll
            for (int m = 0; m < 4; ++m) {
                const int cr = (u.pm - g * 3) * BM + ai * HALF + wr * 64 + m * 16 + fr;
#pragma unroll
                for (int bj = 0; bj < 2; ++bj) {
                    const int n0 = pnn * BM + bj * HALF + wc * 32 + 8 * fq;
                    const int t = n0 >> 4, h0 = n0 & 15;
                    const int tok = cr * 32 + t;
                    const u32x4 uu = *(const u32x4*)(Aall + ((size_t)(g * S5ROWS + cr)) * S5K1 + n0);
                    const f32x4 d0 = *(const f32x4*)(dskip + g * 16 + h0), d1 = *(const f32x4*)(dskip + g * 16 + h0 + 4);
                    f32x4 y0 = acc[ai][bj][m][0], y1 = acc[ai][bj][m][1];
                    y0[0] += d0[0] * bflo(uu.x); y0[1] += d0[1] * bfhi(uu.x); y0[2] += d0[2] * bflo(uu.y); y0[3] += d0[3] * bfhi(uu.y);
                    y1[0] += d1[0] * bflo(uu.z); y1[1] += d1[1] * bfhi(uu.z); y1[2] += d1[2] * bflo(uu.w); y1[3] += d1[3] * bfhi(uu.w);
#pragma unroll
                    for (int j = 0; j < 4; ++j) { y0[j] = gelu_tanh(y0[j]); y1[j] = gelu_tanh(y1[j]); }
                    *(u32x4*)(ZG + (size_t)tok * 512 + g * 16 + h0) = pack8(y0, y1);
                }
            }
    }
};
struct EpiG {
    static constexpr bool PERM = true, AFTER_DRAIN = false;
    bf16_t* G;
    __device__ __forceinline__ void operator()(const Acc& acc, const Unit& u, int wr, int wc, int fr, int fq) const {
#pragma unroll
        for (int ai = 0; ai < 2; ++ai)
#pragma unroll
            for (int m = 0; m < 4; ++m) {
                const int row = u.pm * BM + ai * HALF + wr * 64 + m * 16 + fr;
#pragma unroll
                for (int bj = 0; bj < 2; ++bj) { const int col = u.pn * BM + bj * HALF + wc * 32 + 8 * fq; *(u32x4*)(G + (size_t)row * 512 + col) = pack8(acc[ai][bj][m][0], acc[ai][bj][m][1]); }
            }
    }
};
struct EpiGLU {
    static constexpr bool PERM = true, AFTER_DRAIN = false;
    const bf16_t* ZG; const float* bias; bf16_t* MIX;
    __device__ __forceinline__ void operator()(const Acc& acc, const Unit& u, int wr, int wc, int fr, int fq) const {
#pragma unroll
        for (int ai = 0; ai < 2; ++ai)
#pragma unroll
            for (int m = 0; m < 4; ++m) {
                const int row = u.pm * BM + ai * HALF + wr * 64 + m * 16 + fr;
#pragma unroll
                for (int bj = 0; bj < 2; ++bj) {
                    const int col = u.pn * BM + bj * HALF + wc * 32 + 8 * fq;
                    const u32x4 zz = *(const u32x4*)(ZG + (size_t)row * 512 + col);
                    const f32x4 b0 = *(const f32x4*)(bias + col), b1 = *(const f32x4*)(bias + col + 4);
                    f32x4 y0 = acc[ai][bj][m][0] + b0, y1 = acc[ai][bj][m][1] + b1;
                    y0[0] = bflo(zz.x) * sigmoidf_(y0[0]); y0[1] = bfhi(zz.x) * sigmoidf_(y0[1]); y0[2] = bflo(zz.y) * sigmoidf_(y0[2]); y0[3] = bfhi(zz.y) * sigmoidf_(y0[3]);
                    y1[0] = bflo(zz.z) * sigmoidf_(y1[0]); y1[1] = bfhi(zz.z) * sigmoidf_(y1[1]); y1[2] = bflo(zz.w) * sigmoidf_(y1[2]); y1[3] = bfhi(zz.w) * sigmoidf_(y1[3]);
                    *(u32x4*)(MIX + (size_t)row * DM + 512 + col) = pack8(y0, y1);
                }
            }
    }
};
struct EpiRes {
    static constexpr bool PERM = false, AFTER_DRAIN = false;
    const float* base; float* out; const float* gate;
    __device__ __forceinline__ void operator()(const Acc& acc, const Unit& u, int wr, int wc, int fr, int fq) const {
        const int b = u.pm >> 4;
        const int col0 = u.pn * BM + wc * 32 + 4 * fq;
        f32x4 gv[2][2];
#pragma unroll
        for (int bj = 0; bj < 2; ++bj)
#pragma unroll
            for (int n = 0; n < 2; ++n) gv[bj][n] = *(const f32x4*)(gate + (size_t)b * 6144 + col0 + bj * HALF + n * 16);
#pragma unroll
        for (int ai = 0; ai < 2; ++ai)
#pragma unroll
            for (int m = 0; m < 4; ++m) {
                const size_t off = (size_t)(u.pm * BM + ai * HALF + wr * 64 + m * 16 + fr) * DM + col0;
#pragma unroll
                for (int bj = 0; bj < 2; ++bj)
#pragma unroll
                    for (int n = 0; n < 2; ++n) { const f32x4 bs = *(const f32x4*)(base + off + bj * HALF + n * 16); *(f32x4*)(out + off + bj * HALF + n * 16) = bs + gv[bj][n] * acc[ai][bj][m][n]; }
            }
    }
};
struct EpiUp {
    static constexpr bool PERM = true, AFTER_DRAIN = false;
    bf16_t* ACT;
    __device__ __forceinline__ void operator()(const Acc& acc, const Unit& u, int wr, int wc, int fr, int fq) const {
#pragma unroll
        for (int ai = 0; ai < 2; ++ai)
#pragma unroll
            for (int m = 0; m < 4; ++m) {
                const int row = u.pm * BM + ai * HALF + wr * 64 + m * 16 + fr;
                const int col = u.pn * HALF + wc * 32 + 8 * fq;
                f32x4 y0, y1;
#pragma unroll
                for (int j = 0; j < 4; ++j) { y0[j] = siluf_(acc[ai][0][m][0][j]) * acc[ai][1][m][0][j]; y1[j] = siluf_(acc[ai][0][m][1][j]) * acc[ai][1][m][1][j]; }
                *(u32x4*)(ACT + (size_t)row * DFF + col) = pack8(y0, y1);
            }
    }
};
struct PanelSumsq {
    float* xbuf; unsigned* cnt;
    __device__ __forceinline__ void run(const Acc& v, const Unit& u, int wr, int wc, int fr, int fq, LAS unsigned char* lds, int wid, int lane) const {
        LAS float* P = (LAS float*)lds; LAS float* S = (LAS float*)(lds + 8192);
#pragma unroll
        for (int ai = 0; ai < 2; ++ai)
#pragma unroll
            for (int m = 0; m < 4; ++m) {
                float s = 0.f;
#pragma unroll
                for (int bj = 0; bj < 2; ++bj)
#pragma unroll
                    for (int n = 0; n < 2; ++n) { const f32x4 x = v[ai][bj][m][n]; s += (x[0] * x[0] + x[1] * x[1]) + (x[2] * x[2] + x[3] * x[3]); }
                s += __shfl_xor(s, 16); s += __shfl_xor(s, 32);
                if (fq == 0) P[(ai * HALF + wr * 64 + m * 16 + fr) * 4 + wc] = s;
            }
        asm volatile("s_waitcnt lgkmcnt(0)" ::: "memory"); __builtin_amdgcn_s_barrier(); asm volatile("" ::: "memory");
        const int row = wid * 32 + (lane & 31);
        if (lane < 32) { const f32x4 p = *(const LAS f32x4*)(P + row * 4);
            __hip_atomic_store(xbuf + ((size_t)(u.pm * BM + row)) * 4 + u.pn, (p[0] + p[1]) + (p[2] + p[3]), __ATOMIC_RELAXED, __HIP_MEMORY_SCOPE_AGENT); }
        asm volatile("s_waitcnt vmcnt(0)" ::: "memory");
        if (lane == 0) __hip_atomic_fetch_add(cnt + 64 * u.pm, 1u, __ATOMIC_RELAXED, __HIP_MEMORY_SCOPE_AGENT);
        if (wid == 0) {
            unsigned sp = 0;
            while ((unsigned)__builtin_amdgcn_readfirstlane(__hip_atomic_load(cnt + 64 * u.pm, __ATOMIC_RELAXED, __HIP_MEMORY_SCOPE_AGENT)) < 32u) { __builtin_amdgcn_s_sleep(2); if (++sp > (1u << 22)) break; }
            __builtin_amdgcn_fence(__ATOMIC_ACQUIRE, "agent");
        }
        asm volatile("s_waitcnt vmcnt(0) lgkmcnt(0)" ::: "memory"); __builtin_amdgcn_s_barrier(); asm volatile("" ::: "memory");
        if (lane < 32) { const float* slot = xbuf + ((size_t)(u.pm * BM + row)) * 4; float t = 0.f;
#pragma unroll
            for (int q = 0; q < 4; ++q) t += __hip_atomic_load(slot + q, __ATOMIC_RELAXED, __HIP_MEMORY_SCOPE_AGENT);
            S[row] = t; }
        asm volatile("s_waitcnt vmcnt(0) lgkmcnt(0)" ::: "memory"); __builtin_amdgcn_s_barrier(); asm volatile("" ::: "memory");
    }
};
struct EpiWoutNorm {
    static constexpr bool PERM = false, AFTER_DRAIN = true;
    const float* base; float* out; const float* mod; const float* g2; bf16_t* H2; PanelSumsq st;
    __device__ __forceinline__ void fused(Acc& acc, const Unit& u, int wr, int wc, int fr, int fq, LAS unsigned char* lds, int wid, int lane) const {
        const int b = u.pm >> 4, col0 = u.pn * BM + wc * 32 + 4 * fq;
        const float* mb = mod + (size_t)b * 6144;
#pragma unroll
        for (int ai = 0; ai < 2; ++ai)
#pragma unroll
            for (int m = 0; m < 4; ++m) { const size_t off = (size_t)(u.pm * BM + ai * HALF + wr * 64 + m * 16 + fr) * DM + col0;
#pragma unroll
                for (int bj = 0; bj < 2; ++bj)
#pragma unroll
                    for (int n = 0; n < 2; ++n) { const int co = bj * HALF + n * 16; const f32x4 bs = *(const f32x4*)(base + off + co), gv = *(const f32x4*)(mb + 2 * 1024 + col0 + co);
                        const f32x4 x1 = bs + gv * acc[ai][bj][m][n]; acc[ai][bj][m][n] = x1; *(f32x4*)(out + off + co) = x1; }
                asm volatile("" : "+v"(acc[ai][0][m][0]), "+v"(acc[ai][0][m][1]), "+v"(acc[ai][1][m][0]), "+v"(acc[ai][1][m][1]));
                if (m & 1) asm volatile("" ::: "memory"); }
        st.run(acc, u, wr, wc, fr, fq, lds, wid, lane);
        const LAS float* S = (const LAS float*)(lds + 8192);
#pragma unroll
        for (int ai = 0; ai < 2; ++ai)
#pragma unroll
            for (int m = 0; m < 4; ++m) { const int r = ai * HALF + wr * 64 + m * 16 + fr; const float rstd = 1.0f / sqrtf(S[r] * (1.f / DM) + 1e-6f); const size_t off = (size_t)(u.pm * BM + r) * DM + col0;
#pragma unroll
                for (int bj = 0; bj < 2; ++bj)
#pragma unroll
                    for (int n = 0; n < 2; ++n) { const int co = bj * HALF + n * 16;
                        const f32x4 gg = *(const f32x4*)(g2 + col0 + co), sh = *(const f32x4*)(mb + 3 * 1024 + col0 + co), sc = *(const f32x4*)(mb + 4 * 1024 + col0 + co);
                        const f32x4 y = acc[ai][bj][m][n] * rstd * gg * (sc + 1.0f) + sh;
                        u32x2 w; w.x = pk2(y[0], y[1]); w.y = pk2(y[2], y[3]); *(u32x2*)(H2 + off + co) = w; }
                asm volatile("" ::: "memory"); }
    }
};
struct EpiDownNorm {
    static constexpr bool PERM = false, AFTER_DRAIN = true;
    float* out; const float* mod; const float* fg; PanelSumsq st;
    __device__ __forceinline__ void fused(Acc& acc, const Unit& u, int wr, int wc, int fr, int fq, LAS unsigned char* lds, int wid, int lane) const {
        const int b = u.pm >> 4, col0 = u.pn * BM + wc * 32 + 4 * fq;
        const float* mb = mod + (size_t)b * 6144;
#pragma unroll
        for (int ai = 0; ai < 2; ++ai)
#pragma unroll
            for (int m = 0; m < 4; ++m) { const size_t off = (size_t)(u.pm * BM + ai * HALF + wr * 64 + m * 16 + fr) * DM + col0;
#pragma unroll
                for (int bj = 0; bj < 2; ++bj)
#pragma unroll
                    for (int n = 0; n < 2; ++n) { const int co = bj * HALF + n * 16; const f32x4 bs = *(const f32x4*)(out + off + co), gv = *(const f32x4*)(mb + 5 * 1024 + col0 + co);
                        acc[ai][bj][m][n] = bs + gv * acc[ai][bj][m][n]; }
                asm volatile("" : "+v"(acc[ai][0][m][0]), "+v"(acc[ai][0][m][1]), "+v"(acc[ai][1][m][0]), "+v"(acc[ai][1][m][1]));
                if (m & 1) asm volatile("" ::: "memory"); }
        st.run(acc, u, wr, wc, fr, fq, lds, wid, lane);
        const LAS float* S = (const LAS float*)(lds + 8192);
#pragma unroll
        for (int ai = 0; ai < 2; ++ai)
#pragma unroll
            for (int m = 0; m < 4; ++m) { const int r = ai * HALF + wr * 64 + m * 16 + fr; const float rstd = 1.0f / sqrtf(S[r] * (1.f / DM) + 1e-6f); const size_t off = (size_t)(u.pm * BM + r) * DM + col0;
#pragma unroll
                for (int bj = 0; bj < 2; ++bj)
#pragma unroll
                    for (int n = 0; n < 2; ++n) { const int co = bj * HALF + n * 16; *(f32x4*)(out + off + co) = acc[ai][bj][m][n] * rstd * *(const f32x4*)(fg + col0 + co); }
                asm volatile("" ::: "memory"); }
    }
};
}


__device__ __forceinline__ void transpose_item(const float* W, int K, int N, bf16_t* WT, int ldt, int k0, int n0, int drow0, LAS float* scr, int lane) {
#pragma unroll 8
    for (int i = 0; i < 32; ++i) { const int kk = 2 * i + (lane >> 5); scr[kk * 33 + (lane & 31)] = W[(size_t)(k0 + kk) * N + n0 + (lane & 31)]; }
    asm volatile("s_waitcnt lgkmcnt(0)" ::: "memory");
    const int c = lane & 7;
#pragma unroll
    for (int j = 0; j < 4; ++j) { const int n = (lane >> 3) + 8 * j; const LAS float* s = scr + (8 * c) * 33 + n;
        u32x4 o; o.x = pk2(s[0 * 33], s[1 * 33]); o.y = pk2(s[2 * 33], s[3 * 33]); o.z = pk2(s[4 * 33], s[5 * 33]); o.w = pk2(s[6 * 33], s[7 * 33]);
        *(u32x4*)(WT + (size_t)(drow0 + n) * ldt + k0 + 8 * c) = o; }
    asm volatile("s_waitcnt lgkmcnt(0)" ::: "memory");
}

__device__ __forceinline__ void p0_weights(const Args& a, LAS unsigned char* lds, int bid, int nb, int part) {
    const int tid = opaque_tid(), lane = tid & 63, wave = tid >> 6;
    LAS float* scr = (LAS float*)(lds + wave * 8704);
    bf16_t* WTIN = (bf16_t*)(a.ws + WS_WTIN); bf16_t* WTOUT = (bf16_t*)(a.ws + WS_WTOUT); bf16_t* WT13 = (bf16_t*)(a.ws + WS_WT13);
    bf16_t* WT2 = (bf16_t*)(a.ws + WS_WT2); bf16_t* WTGLU = (bf16_t*)(a.ws + WS_WTGLU);
    constexpr int I_IN = 16 * 71, I_OUT = 16 * 32, I_1 = 16 * 88, I_2 = 44 * 32, I_GLU = 8 * 16;
    constexpr int NIT = I_IN + I_OUT + 2 * I_1 + I_2 + I_GLU;
    const int gw = bid * 8 + wave, NGW = nb * 8;
    for (int it = (part ? I_IN : 0) + gw; it < (part ? NIT : I_IN); it += NGW) {
        int r = it;
        if (r < I_IN) { const int kb = r / 71, nbk = r % 71; transpose_item(a.in[8], 1024, DIN, WTIN, 1024, kb * 64, nbk * 32, nbk * 32, scr, lane); continue; } r -= I_IN;
        if (r < I_OUT) { const int kb = r / 32, nbk = r % 32; transpose_item(a.in[9], 1024, 1024, WTOUT, 1024, kb * 64, nbk * 32, nbk * 32, scr, lane); continue; } r -= I_OUT;
        if (r < 2 * I_1) { const int sel = r / I_1; r -= sel * I_1; const int kb = r / 88, nbk = r % 88, n0 = nbk * 32;
            transpose_item(a.in[sel ? 32 : 31], 1024, DFF, WT13, 1024, kb * 64, n0, (n0 >> 7) * 256 + (n0 & 127) + sel * 128, scr, lane); continue; } r -= 2 * I_1;
        if (r < I_2) { const int kb = r / 32, nbk = r % 32; transpose_item(a.in[33], DFF, 1024, WT2, DFF, kb * 64, nbk * 32, nbk * 32, scr, lane); continue; } r -= I_2;
        { const int kb = r / 16, nbk = r % 16; transpose_item(a.in[29], 512, 512, WTGLU, 512, kb * 64, nbk * 32, nbk * 32, scr, lane); }
    }
    if (part) return;
    bf16_t* W2T = (bf16_t*)(a.ws + WS_W2T);
    for (int i = bid * NTHREADS + tid; i < 2 * 2 * 512 * 32; i += nb * NTHREADS) { const int j = i & 31, c = (i >> 5) & 511, d = (i >> 14) & 1, which = i >> 15; W2T[i] = (bf16_t)f2bf(a.in[which ? 14 : 12][(d * 32 + j) * 512 + c]); }
    bf16_t* G2T = (bf16_t*)(a.ws + WS_G2T); bf16_t* SIG = (bf16_t*)(a.ws + WS_SIG);
    for (int i = bid * NTHREADS + tid; i < 512 * 256; i += nb * NTHREADS) { const int n = i >> 8, k = i & 255; G2T[i] = k < 96 ? (bf16_t)f2bf(a.in[15][k * 512 + n]) : (bf16_t)0; }
    for (int i = bid * NTHREADS + tid; i < NTL * 20; i += nb * NTHREADS) { const int row = i / 20, q = i % 20; *(u32x4*)(SIG + (size_t)row * 256 + 96 + q * 8) = (u32x4){0u, 0u, 0u, 0u}; }
}

__device__ __forceinline__ void p0_mod(const Args& a, LAS unsigned char* lds, int bid, int nb) {
    const int tid = opaque_tid();
    LAS float* sc = (LAS float*)lds;
    LAS float* red = sc + 5 * 1024;
    float* MOD = (float*)(a.ws + WS_MOD);
    bool filled = false;
    for (int cb = bid; cb < 192; cb += nb) {
        if (!filled) {
            for (int i = tid; i < 5 * 1024; i += NTHREADS) { const float v = (i < 4096) ? a.in[1][i] : a.in[3][i - 4096]; sc[i] = siluf_(v); }
            filled = true; __syncthreads();
        }
        const int col = cb * 32 + (tid & 31), kp = tid >> 5;
        float acc[5] = {0.f, 0.f, 0.f, 0.f, 0.f};
        const float* wp = a.in[4] + (size_t)(kp * 64) * 6144 + col;
#pragma unroll 8
        for (int k = 0; k < 64; ++k) { const float w = wp[(size_t)k * 6144];
#pragma unroll
            for (int r = 0; r < 5; ++r) acc[r] += sc[r * 1024 + kp * 64 + k] * w; }
#pragma unroll
        for (int r = 0; r < 5; ++r) red[(kp * 5 + r) * 32 + (tid & 31)] = acc[r];
        __syncthreads();
        if (tid < 160) { const int r = tid >> 5, c = tid & 31; float s = 0.f;
#pragma unroll
            for (int k = 0; k < 16; ++k) s += red[(k * 5 + r) * 32 + c];
            MOD[r * 6144 + cb * 32 + c] = s + a.in[5][cb * 32 + c]; }
        __syncthreads();
    }
}

__device__ __forceinline__ void p0_s5(const Args& a, LAS unsigned char* lds, int bid, int nb) {
    const int tid = opaque_tid();
    LAS float* pw  = (LAS float*)lds;
    LAS float* bb  = pw + 2 * 33 * 64 * 2;
    LAS float* cc  = bb + 2 * 64 * 16 * 2;
    bf16_t* BT1 = (bf16_t*)(a.ws + WS_BT1); bf16_t* BT2 = (bf16_t*)(a.ws + WS_BT2); float* TAB = (float*)(a.ws + WS_S5TAB); float* KT = (float*)(a.ws + WS_KT);
    const float* lam_re = a.in[21]; const float* lam_im = a.in[22]; const float* log_step = a.in[23];
    const float* b_re = a.in[24]; const float* b_im = a.in[25]; const float* c_re = a.in[26]; const float* c_im = a.in[27];
    for (int item = bid; item < 256; item += nb) {
        const int g = item >> 3, part = item & 7;
        __syncthreads();
        for (int i = tid; i < 2 * 33 * 64; i += NTHREADS) {
            const int p = i & 63, n = (i >> 6) % 33, d = i / (33 * 64);
            const float step = fexp(log_step[d * 32 + g]);
            const float lr = lam_re[(d * 32 + g) * 64 + p] * step, li = lam_im[(d * 32 + g) * 64 + p] * step;
            const float mag = expf((float)n * lr); float sn, cs; sincosf((float)n * li, &sn, &cs);
            pw[i * 2] = mag * cs; pw[i * 2 + 1] = mag * sn;
        }
        for (int i = tid; i < 2 * 64 * 16; i += NTHREADS) {
            const int h = i & 15, p = (i >> 4) & 63, d = i >> 10;
            const float step = fexp(log_step[d * 32 + g]);
            const float lr = lam_re[(d * 32 + g) * 64 + p], li = lam_im[(d * 32 + g) * 64 + p];
            const float mag = expf(lr * step); float sn, cs; sincosf(li * step, &sn, &cs);
            const float lbr = mag * cs, lbi = mag * sn, den = lr * lr + li * li, nr = lbr - 1.f;
            const float qr = (nr * lr + lbi * li) / den, qi = (lbi * lr - nr * li) / den;
            const float br = b_re[(g * 64 + p) * 16 + h], bi = b_im[(g * 64 + p) * 16 + h];
            bb[i * 2] = qr * br - qi * bi; bb[i * 2 + 1] = qr * bi + qi * br;
        }
        for (int i = tid; i < 16 * 64; i += NTHREADS) { cc[i * 2] = c_re[g * 1024 + i]; cc[i * 2 + 1] = c_im[g * 1024 + i]; }
        __syncthreads();
        if (part == 0 && tid < 128) { const int d = tid >> 6, p = tid & 63; TAB[((d * 32 + g) * 64 + p) * 2] = pw[((d * 33 + 32) * 64 + p) * 2]; TAB[((d * 32 + g) * 64 + p) * 2 + 1] = pw[((d * 33 + 32) * 64 + p) * 2 + 1]; }
        {
            const int hq = tid & 3, h = (tid >> 2) & 15, q = part * 8 + (tid >> 6), d = q >> 5, tau = q & 31;
            f32x4 s = {0.f, 0.f, 0.f, 0.f};
#pragma unroll 4
            for (int p = 0; p < 64; ++p) {
                const f32x2 c2 = *(LAS f32x2*)(cc + (h * 64 + p) * 2), p2 = *(LAS f32x2*)(pw + ((d * 33 + tau) * 64 + p) * 2);
                const float xr = c2.x * p2.x - c2.y * p2.y, xi = c2.x * p2.y + c2.y * p2.x;
                const f32x4 b0 = *(LAS f32x4*)(bb + ((d * 64 + p) * 16 + 4 * hq) * 2), b1 = *(LAS f32x4*)(bb + ((d * 64 + p) * 16 + 4 * hq) * 2 + 4);
                s[0] += xr * b0[0] - xi * b0[1]; s[1] += xr * b0[2] - xi * b0[3]; s[2] += xr * b1[0] - xi * b1[1]; s[3] += xr * b1[2] - xi * b1[3];
            }
            *(f32x4*)(KT + ((size_t)(g * 64 + q) * 16 + h) * 16 + 4 * hq) = s;
        }
        for (int i = tid; i < 64 * 128; i += NTHREADS) {
            const int rl = i >> 7, kp = (i & 127) * 2;
            const int n = part * 64 + rl, t = n >> 4, h = n & 15;
            const int d = kp >> 7, p = (kp >> 1) & 63;
            const int np = d ? (32 - t) : (t + 1);
            const float ar = pw[((d * 33 + np) * 64 + p) * 2], ai = pw[((d * 33 + np) * 64 + p) * 2 + 1];
            const float cr = cc[(h * 64 + p) * 2], ci = cc[(h * 64 + p) * 2 + 1];
            *(unsigned*)(BT1 + ((size_t)(g * 512 + n)) * S5K1 + 512 + kp) = pk2(cr * ar - ci * ai, -cr * ai - ci * ar);
        }
        for (int i = tid; i < 32 * 256; i += NTHREADS) {
            const int rl = i >> 8, kp = (i & 255) * 2;
            const int n = part * 32 + rl, d = n >> 7, p = (n >> 1) & 63, ri = n & 1;
            float v[2];
#pragma unroll
            for (int e = 0; e < 2; ++e) {
                const int k = kp + e, s = k >> 4, hp = k & 15;
                const int np = d ? s : (31 - s);
                const float ar = pw[((d * 33 + np) * 64 + p) * 2], ai = pw[((d * 33 + np) * 64 + p) * 2 + 1];
                const float br = bb[((d * 64 + p) * 16 + hp) * 2], bi = bb[((d * 64 + p) * 16 + hp) * 2 + 1];
                v[e] = ri ? (ar * bi + ai * br) : (ar * br - ai * bi);
            }
            *(unsigned*)(BT2 + ((size_t)(g * 256 + n)) * 512 + kp) = pk2(v[0], v[1]);
        }
    }
    __syncthreads();
}
__device__ __forceinline__ void p1_s5(const Args& a, LAS unsigned char* lds, int bid, int nb) {
    const int tid = opaque_tid();
    LAS float* kt = (LAS float*)lds;
    bf16_t* BT1 = (bf16_t*)(a.ws + WS_BT1); const float* KT = (const float*)(a.ws + WS_KT);
    for (int item = bid; item < 256; item += nb) {
        const int g = item >> 3, part = item & 7;
        __syncthreads();
        for (int i = tid; i < 4096; i += NTHREADS) *(LAS f32x4*)(kt + 4 * i) = *(const f32x4*)(KT + (size_t)g * 16384 + 4 * i);
        __syncthreads();
        for (int i = tid; i < 64 * 256; i += NTHREADS) {
            const int rl = i >> 8, kp = (i & 255) * 2;
            const int n = part * 64 + rl, t = n >> 4, h = n & 15, s = kp >> 4, hp = kp & 15;
            float v0, v1;
            if (t > s) { const LAS float* q = kt + ((0 * 32 + (t - s)) * 16 + h) * 16 + hp; v0 = q[0]; v1 = q[1]; }
            else if (s > t) { const LAS float* q = kt + ((1 * 32 + (s - t)) * 16 + h) * 16 + hp; v0 = q[0]; v1 = q[1]; }
            else { const LAS float* q0 = kt + (h * 16) + hp; const LAS float* q1 = kt + ((32 * 16 + h) * 16) + hp; v0 = q0[0] + q1[0]; v1 = q0[1] + q1[1]; }
            *(unsigned*)(BT1 + ((size_t)(g * 512 + n)) * S5K1 + kp) = pk2(v0, v1);
        }
    }
    __syncthreads();
}

struct RowV { f32x4 v[4]; };
__device__ __forceinline__ RowV row_load(const float* xrow, int lane) { RowV r; const f32x4* xr = (const f32x4*)xrow + lane;
#pragma unroll
    for (int j = 0; j < 4; ++j) r.v[j] = xr[64 * j];
    return r; }
__device__ __forceinline__ float row_rstd(const RowV& r) { float s = 0.f;
#pragma unroll
    for (int j = 0; j < 4; ++j) s += (r.v[j].x * r.v[j].x + r.v[j].y * r.v[j].y) + (r.v[j].z * r.v[j].z + r.v[j].w * r.v[j].w);
    return 1.0f / sqrtf(wave_sum(s) * (1.f / DM) + 1e-6f); }
__device__ __forceinline__ void norm_mod_finish(const RowV& r, const float* g, const float* shift, const float* scale, bf16_t* orow, int lane) {
    const float rstd = row_rstd(r);
    u32x2* o8 = (u32x2*)orow + lane;
#pragma unroll
    for (int j = 0; j < 4; ++j) {
        const f32x4 gg = ((const f32x4*)g)[lane + 64 * j], sh = ((const f32x4*)shift)[lane + 64 * j], sc = ((const f32x4*)scale)[lane + 64 * j];
        const f32x4 y = r.v[j] * rstd * gg * (sc + 1.0f) + sh;
        u32x2 w; w.x = pk2(y.x, y.y); w.y = pk2(y.z, y.w); o8[64 * j] = w;
    }
}

__device__ __forceinline__ void p_s5_carry(const Args& a, int bid, int nb) {
    const float* E = (const float*)(a.ws + WS_E); const float* TAB = (const float*)(a.ws + WS_S5TAB); bf16_t* Aall = (bf16_t*)(a.ws + WS_AALL);
    for (int gi = bid * NTHREADS + opaque_tid(); gi < BATCH * 32 * 2 * 64 * 8; gi += nb * NTHREADS) {
        const int seg = gi & 7, p = (gi >> 3) & 63, d = (gi >> 9) & 1, g = (gi >> 10) & 31, b = gi >> 15;
        const float lr = TAB[((d * 32 + g) * 64 + p) * 2], li = TAB[((d * 32 + g) * 64 + p) * 2 + 1];
        const size_t ecol = (size_t)d * 128 + p * 2;
        float hr = 0.f, hi = 0.f;
        if (seg == 0) {
            f32x2 e[8];
#pragma unroll
            for (int c = 0; c < 8; ++c) { const int cc = d ? 7 - c : c; e[c] = *(const f32x2*)(E + ((size_t)(g * S5EROWS + 512 + b * 8 + cc)) * 256 + ecol); }
#pragma unroll
            for (int c = 0; c < 8; ++c) { const float nr = lr * hr - li * hi + e[c].x, ni = lr * hi + li * hr + e[c].y; hr = nr; hi = ni; }
        }
        const float h0r = hr, h0i = hi;
        f32x2 e[16];
#pragma unroll
        for (int j = 0; j < 16; ++j) { const int jj = seg * 16 + j, cc = d ? 127 - jj : jj; e[j] = *(const f32x2*)(E + ((size_t)(g * S5EROWS + b * 128 + cc)) * 256 + ecol); }
#pragma unroll
        for (int j = 0; j < 16; ++j) { const float nr = lr * hr - li * hi + e[j].x, ni = lr * hi + li * hr + e[j].y; hr = nr; hi = ni; }
        float ar = lr, ai = li;
#pragma unroll
        for (int q = 0; q < 4; ++q) { const float nr = ar * ar - ai * ai, ni = 2.f * ar * ai; ar = nr; ai = ni; }
        float fr = hr, fi = hi;
#pragma unroll
        for (int st = 1; st < 8; ++st) {
            const float pr = __shfl_up(fr, 1, 8), pi = __shfl_up(fi, 1, 8);
            if (seg == st) { fr = ar * pr - ai * pi + hr; fi = ar * pi + ai * pr + hi; }
        }
        const float cr_ = __shfl_up(fr, 1, 8), ci_ = __shfl_up(fi, 1, 8);
        hr = seg ? cr_ : h0r; hi = seg ? ci_ : h0i;
#pragma unroll
        for (int j = 0; j < 16; ++j) { const int jj = seg * 16 + j, cc = d ? 127 - jj : jj;
            *(unsigned*)(Aall + ((size_t)(g * S5ROWS + b * 128 + cc)) * S5K1 + 512 + ecol) = pk2(hr, hi);
            const float nr = lr * hr - li * hi + e[j].x, ni = lr * hi + li * hr + e[j].y; hr = nr; hi = ni; }
    }
}

constexpr int RC = 64, RNCH = (CTXL + SEQ) / RC, RSTG0 = 32, RSTG1 = RNCH - RSTG0, RSTGM = RSTG1, RJOBS = 64 * RSTGM;
constexpr size_t WS_RACT = WS_AALL;
constexpr size_t WS_RRPT = WS_RACT + (size_t)RJOBS * 8192;
constexpr size_t WS_RSL  = WS_RRPT + (size_t)RJOBS * 8192;
constexpr size_t WS_RYL  = WS_RSL + (size_t)RJOBS * 8192;
constexpr size_t WS_RST  = WS_RYL + (size_t)RJOBS * 8192;
static_assert(WS_RST + (size_t)256 * 64 * 16 * 4 <= WS_S5END, "rwkv staging must fit the S5 region");
constexpr size_t WS_YOUT = WS_HMOD;
constexpr size_t WS_MIX  = WS_AALL;
static_assert((size_t)2 * NTL * 512 * 2 <= (size_t)NTOK * DM * 2, "YOUT fits HMOD region");

#define LSYNC() do { __syncthreads(); if ((PROBE_RPT >> 19) & 1) { __syncthreads(); __syncthreads(); __syncthreads(); } } while (0)
constexpr int SLB = 64 * 72 * 2;
typedef float f32x16 __attribute__((ext_vector_type(16)));
#define RSLOT(i) (lds + (i) * SLB)

__device__ __forceinline__ f32x16 tile_mm(const LAS unsigned char* Aop, const LAS unsigned char* Bop, int m0, int n0, f32x16 acc, int lane) {
    const int r = lane & 31, h = lane >> 5;
    const LAS unsigned char* ap = Aop + (m0 + r) * 144 + h * 16;
    const LAS unsigned char* bp = Bop + (n0 + r) * 144 + h * 16;
#pragma unroll
    for (int ks = 0; ks < 4; ++ks) {
        const bf16x8 av = *(const LAS bf16x8*)(ap + ks * 32), bv = *(const LAS bf16x8*)(bp + ks * 32);
        acc = __builtin_amdgcn_mfma_f32_32x32x16_bf16(av, bv, acc, 0, 0, 0);
    }
    return acc;
}
__device__ __forceinline__ f32x16 zero16() { f32x16 z;
#pragma unroll
    for (int i = 0; i < 16; ++i) z[i] = 0.f; return z; }
__device__ __forceinline__ void store_cr(LAS unsigned char* X, const f32x16& acc, int m0, int n0, int lane) {
    LAS unsigned char* p = X + (n0 + (lane & 31)) * 144 + (m0 + 4 * (lane >> 5)) * 2;
#pragma unroll
    for (int g = 0; g < 4; ++g) { u32x2 w; w.x = pk2(acc[4 * g], acc[4 * g + 1]); w.y = pk2(acc[4 * g + 2], acc[4 * g + 3]); *(LAS u32x2*)(p + g * 16) = w; }
}
__device__ __forceinline__ void store_rc(LAS unsigned char* X, const f32x16& acc, int m0, int n0, int lane, bool ident) {
    const int c = n0 + (lane & 31), h = lane >> 5;
#pragma unroll
    for (int r = 0; r < 16; ++r) { const int row = m0 + (r & 3) + 8 * (r >> 2) + 4 * h; float v = acc[r]; if (ident && row == c) v += 1.0f;
        *(LAS bf16_t*)(X + row * 144 + c * 2) = (bf16_t)f2bf(v); }
}
__device__ __forceinline__ f32x16 init_cr(const LAS unsigned char* X, int m0, int n0, int lane) {
    const LAS unsigned char* p = X + (n0 + (lane & 31)) * 144 + (m0 + 4 * (lane >> 5)) * 2;
    f32x16 acc;
#pragma unroll
    for (int g = 0; g < 4; ++g) { const u32x2 w = *(const LAS u32x2*)(p + g * 16); acc[4 * g] = bflo(w.x); acc[4 * g + 1] = bfhi(w.x); acc[4 * g + 2] = bflo(w.y); acc[4 * g + 3] = bfhi(w.y); }
    return acc;
}
__device__ __forceinline__ void mask_ge(f32x16& acc, int m0, int n0, int lane, int dmin) {
    const int c = n0 + (lane & 31), h = lane >> 5;
#pragma unroll
    for (int r = 0; r < 16; ++r) { const int row = m0 + (r & 3) + 8 * (r >> 2) + 4 * h; if (c - row < dmin) acc[r] = 0.f; }
}
__device__ __forceinline__ void store_g_perm(bf16_t* OUT, const f32x16& acc, int m0, int n0, int lane) {
    const int h = lane >> 5; bf16_t* rowp = OUT + (size_t)(n0 + (lane & 31)) * 64 + m0;
#pragma unroll
    for (int g4 = 0; g4 < 4; ++g4) { u32x2 w; w.x = pk2(acc[4 * g4], acc[4 * g4 + 1]); w.y = pk2(acc[4 * g4 + 2], acc[4 * g4 + 3]);
        *(u32x2*)(rowp + 8 * (2 * (g4 & 1) + h) + 4 * (g4 >> 1)) = w; }
}
__device__ __forceinline__ void store_g_cr(bf16_t* OUT, const f32x16& acc, int m0, int n0, int lane) {
    bf16_t* rowp = OUT + (size_t)(n0 + (lane & 31)) * 64 + m0 + 4 * (lane >> 5);
#pragma unroll
    for (int g = 0; g < 4; ++g) { u32x2 w; w.x = pk2(acc[4 * g], acc[4 * g + 1]); w.y = pk2(acc[4 * g + 2], acc[4 * g + 3]); *(u32x2*)(rowp + 8 * g) = w; }
}

typedef short s16x4 __attribute__((ext_vector_type(4)));
__device__ __forceinline__ bf16x8 frag_t(const LAS unsigned char* img, int m0, int ks, int lane) {
    const LAS unsigned char* a0 = img + (16 * ks + 8 * (lane >> 5) + ((lane & 15) >> 2)) * 144 + (m0 + 16 * ((lane >> 4) & 1) + 4 * (lane & 3)) * 2;
    const s16x4 lo = __builtin_amdgcn_ds_read_tr16_b64_v4i16((LAS s16x4*)a0), hi = __builtin_amdgcn_ds_read_tr16_b64_v4i16((LAS s16x4*)(a0 + 4 * 144));
    return (bf16x8){lo[0], lo[1], lo[2], lo[3], hi[0], hi[1], hi[2], hi[3]};
}
__device__ __forceinline__ bf16x8 frag_n(const LAS unsigned char* img, int m0, int ks, int lane) { return *(const LAS bf16x8*)(img + (m0 + (lane & 31)) * 144 + (lane >> 5) * 16 + ks * 32); }
template <bool TA, bool TB>
__device__ __forceinline__ f32x16 tile_mmx(const LAS unsigned char* Aimg, const LAS unsigned char* Bimg, int m0, int n0, int ks0, int ks1, f32x16 acc, int lane) {
#pragma unroll
    for (int ks = 0; ks < 4; ++ks) if (ks >= ks0 && ks < ks1) {
        const bf16x8 av = TA ? frag_t(Aimg, m0, ks, lane) : frag_n(Aimg, m0, ks, lane);
        const bf16x8 bv = TB ? frag_t(Bimg, n0, ks, lane) : frag_n(Bimg, n0, ks, lane);
        acc = __builtin_amdgcn_mfma_f32_32x32x16_bf16(av, bv, acc, 0, 0, 0);
    }
    return acc;
}
__device__ __forceinline__ f32x16 init_rc(const LAS unsigned char* X, int m0, int n0, int lane) {
    const LAS unsigned char* a0 = X + (m0 + 4 * (lane >> 5) + ((lane & 15) >> 2)) * 144 + (n0 + 16 * ((lane >> 4) & 1) + 4 * (lane & 3)) * 2;
    f32x16 acc;
#pragma unroll
    for (int g = 0; g < 4; ++g) { const s16x4 w = __builtin_amdgcn_ds_read_tr16_b64_v4i16((LAS s16x4*)(a0 + g * 8 * 144));
#pragma unroll
        for (int e = 0; e < 4; ++e) acc[4 * g + e] = __builtin_bit_cast(float, ((unsigned)(unsigned short)w[e]) << 16); }
    return acc;
}
__device__ __forceinline__ void mask_tri(f32x16& acc, int m0, int n0, int lane, int sgn, int dmin, bool ident) {
    const int c = n0 + (lane & 31), h = lane >> 5;
#pragma unroll
    for (int r = 0; r < 16; ++r) { const int row = m0 + (r & 3) + 8 * (r >> 2) + 4 * h; if ((c - row) * sgn < dmin) acc[r] = 0.f; if (ident && row == c) acc[r] += 1.0f; }
}

__device__ __forceinline__ void p_rwkv_A(const Args& a, LAS unsigned char* lds, int bid, int nb, int stage) {
    LAS unsigned char* raw = lds;
    LAS float* cws = (LAS float*)(lds + 8 * SLB);
    LAS unsigned char* w2t = (LAS unsigned char*)(cws + 27 * 64);
    LAS unsigned char* a2t = w2t + 5120;
    LAS unsigned char* twl = a2t + 5120;
    LAS unsigned char* adl = twl + 5120;
    LAS float* cum = (LAS float*)(adl + 5120);
    LAS bf16_t* avl = (LAS bf16_t*)(cum + 4096);
    LAS float* seg = (LAS float*)(avl + 4096);
    LAS float* lamC = (LAS float*)(lds + 14 * SLB);
    static_assert(8 * SLB + 6912 + 4 * 5120 + 16384 + 8192 + 2048 <= 14 * SLB, "prep temporaries");
    static_assert(14 * SLB + 256 <= 131072 && 192 * 384 == 8 * SLB, "rwkv LDS");
    const bf16_t* Z = (const bf16_t*)(a.ws + WS_Z);
    const bf16_t* W2T = (const bf16_t*)(a.ws + WS_W2T);
    float* BON = (float*)(a.ws + WS_BON);
    bf16_t* RACT = (bf16_t*)(a.ws + WS_RACT); bf16_t* RRPT = (bf16_t*)(a.ws + WS_RRPT); bf16_t* RSL = (bf16_t*)(a.ws + WS_RSL); bf16_t* RYL = (bf16_t*)(a.ws + WS_RYL);
    const int tid0 = threadIdx.x;
    const int vcu = (nb % 8 == 0) ? (bid % 8) * (nb / 8) + bid / 8 : bid;
    const int nstg = stage ? RSTG1 : RSTG0, cs0 = stage ? RSTG0 : 0;
    u32x4 rq[9], wq, xq;
#define RWA_ISSUE(jn_) do { const int tq_ = opaque_tid(); const int chain_ = (jn_) / nstg, cs_ = cs0 + (jn_) % nstg, d_ = chain_ >> 5, b_ = (chain_ >> 3) & 3, h_ = chain_ & 7; \
        const bool ctx_ = cs_ < CTXL / RC; const int cidx_ = ctx_ ? cs_ : cs_ - CTXL / RC, gi_ = d_ ? ((ctx_ ? CTXL / RC : SEQ / RC) - 1 - cidx_) : cidx_; \
        _Pragma("unroll") for (int it = 0; it < 9; ++it) { const int pc = it * 512 + tq_, slot = pc / 24, q = pc - slot * 24, X = q >> 3, c8 = q & 7; int tok; \
            if (ctx_) { const int t = min(max(64 * (gi_ - 1) + slot, 0), CTXL - 1); tok = NTL + b_ * CTXL + t; } \
            else { const int rr_ = min(max(gi_ - 1 + (slot >> 6), 0), 63); tok = b_ * SEQ + rr_ * 64 + (slot & 63); } \
            rq[it] = *(const u32x4*)(Z + ((unsigned)tok * ZLD + X * 512 + h_ * 64 + c8 * 8)); } \
        { const int rw = tq_ >> 3, pq = tq_ & 7, which = pq >> 2, p4 = pq & 3; \
          wq = *(const u32x4*)(W2T + ((size_t)((which * 2 + d_) * 512 + h_ * 64 + rw)) * 32 + p4 * 8); \
          const int pj = d_ ? 63 - rw : rw; const int tokrow = ctx_ ? (NTL + b_ * CTXL + gi_ * 64 + pj) : (b_ * SEQ + gi_ * 64 + pj); \
          xq = *(const u32x4*)(Z + ((unsigned)tokrow * ZLD + (which ? COL_AD : COL_WD) + d_ * 32 + p4 * 8)); } } while (0)
    if (vcu < 64 * nstg) RWA_ISSUE(vcu);
    for (int jl = vcu; jl < 64 * nstg; jl += nb) {
        int tid_ = tid0; asm volatile("" : "+v"(tid_));
        const int tid = tid_, lane = tid & 63, wave = __builtin_amdgcn_readfirstlane(tid >> 6);
        const int chain = jl / nstg, cs = cs0 + jl % nstg;
        const int d = chain >> 5, b = (chain >> 3) & 3, h = chain & 7;
        float* BONd = BON + (size_t)d * NTL * 8;
        const bool isctx = cs < CTXL / RC;
        const int cidx = isctx ? cs : cs - CTXL / RC;
        const int gi = d ? ((isctx ? CTXL / RC : SEQ / RC) - 1 - cidx) : cidx;
#pragma unroll 1
        for (int rp_ = 0; rp_ <= ((PROBE_RPT >> 18) & 1); ++rp_) {
        __syncthreads();
#pragma unroll
        for (int it = 0; it < 9; ++it) *(LAS u32x4*)(raw + (it * 512 + tid) * 16) = rq[it];
        {
            const int rw = tid >> 3, pq = tid & 7, which = pq >> 2, p4 = pq & 3;
            *(LAS u32x4*)((which ? a2t : w2t) + rw * 80 + p4 * 16) = wq;
            u32x4 xv = xq;
            if (!which) { xv.x = pk2(tanh_fast(bflo(xv.x)), tanh_fast(bfhi(xv.x))); xv.y = pk2(tanh_fast(bflo(xv.y)), tanh_fast(bfhi(xv.y)));
                          xv.z = pk2(tanh_fast(bflo(xv.z)), tanh_fast(bfhi(xv.z))); xv.w = pk2(tanh_fast(bflo(xv.w)), tanh_fast(bfhi(xv.w))); }
            *(LAS u32x4*)((which ? adl : twl) + rw * 80 + p4 * 16) = xv;
        }
        f32x4 cw9[9];
#pragma unroll
        for (int tap = 0; tap < 9; ++tap) cw9[tap] = *(const f32x4*)(a.in[10] + tap * 1536 + min(tid >> 7, 2) * 512 + h * 64 + 4 * (tid & 15));
        __syncthreads();
        {
            const int which = wave >> 2, m0 = ((wave >> 1) & 1) * 32, n0 = (wave & 1) * 32, r31 = lane & 31, hh = lane >> 5;
            const LAS unsigned char* ap = (which ? adl : twl) + (m0 + r31) * 80 + hh * 16;
            const LAS unsigned char* bp = (which ? a2t : w2t) + (n0 + r31) * 80 + hh * 16;
            f32x16 acc = zero16();
#pragma unroll
            for (int ks = 0; ks < 2; ++ks) acc = __builtin_amdgcn_mfma_f32_32x32x16_bf16(*(const LAS bf16x8*)(ap + ks * 32), *(const LAS bf16x8*)(bp + ks * 32), acc, 0, 0, 0);
            const int c = n0 + r31;
            const float bias = a.in[which ? 13 : 11][d * 512 + h * 64 + c];
#pragma unroll
            for (int r = 0; r < 16; ++r) {
                const int srow = m0 + (r & 3) + 8 * (r >> 2) + 4 * hh; const float x = acc[r] + bias;
                if (which) avl[srow * 64 + c] = (bf16_t)f2bf(sigmoidf_(x));
                else { const float sp = fmaxf(-x, 0.f) + flog(1.0f + fexp(-fabsf(x))); cum[srow * 64 + c] = -fexp(-sp - 0.5f); }
            }
        }
        const int tt = tid >> 4, cg = tid & 15, ch = h * 64 + 4 * cg;
        const f32x4 kkw = *(const f32x4*)(a.in[16] + ch), kaw = *(const f32x4*)(a.in[17] + ch), rkw = *(const f32x4*)(a.in[18] + ch);
        f32x4 kkn_[2], bv_[2], kd_[2], rr_[2], vv_[2];
        f32x4 cvr[2], cvk[2];
        {
            const int X = tid >> 7, cgc = tid & 15, tb = (tid >> 4) & 7;
            f32x4 oacc[8];
#pragma unroll
            for (int j = 0; j < 8; ++j) oacc[j] = (f32x4){0.f, 0.f, 0.f, 0.f};
            if (X < 3) {
#pragma unroll 1
                for (int aa = 0; aa < 3; ++aa) {
                    const bool rowok = isctx ? (aa == 1) : ((unsigned)(gi - 1 + aa) < 64u);
                    if (!rowok) continue;
                    f32x4 w[3];
#pragma unroll
                    for (int bb2 = 0; bb2 < 3; ++bb2) w[bb2] = aa == 0 ? cw9[bb2] : (aa == 1 ? cw9[3 + bb2] : cw9[6 + bb2]);
                    u32x2 q[10];
#pragma unroll
                    for (int e = 0; e < 10; ++e) {
                        const int jj = 8 * tb + e - 1;
                        int slot; bool ok;
                        if (isctx) { slot = 64 + jj; ok = (unsigned)(64 * gi + jj) < (unsigned)CTXL; }
                        else { slot = aa * 64 + min(max(jj, 0), 63); ok = (unsigned)jj < 64u; }
                        q[e] = *(const LAS u32x2*)(raw + slot * 384 + X * 128 + cgc * 8);
                        if (!ok) { q[e].x = 0u; q[e].y = 0u; }
                    }
#pragma unroll
                    for (int j = 0; j < 8; ++j)
#pragma unroll
                        for (int bb2 = 0; bb2 < 3; ++bb2) { const u32x2 v = q[j + bb2];
                            oacc[j][0] += bflo(v.x) * w[bb2][0]; oacc[j][1] += bfhi(v.x) * w[bb2][1]; oacc[j][2] += bflo(v.y) * w[bb2][2]; oacc[j][3] += bfhi(v.y) * w[bb2][3]; }
                }
            }
            __syncthreads();
            if (X < 3) {
                LAS float* cvo = (LAS float*)raw;
#pragma unroll
                for (int j = 0; j < 8; ++j) { const int pj = 8 * tb + j, sidx = d ? 63 - pj : pj; *(LAS f32x4*)(cvo + (sidx * 3 + X) * 64 + 4 * cgc) = oacc[j]; }
            }
        }
        __syncthreads();
#pragma unroll
        for (int half = 0; half < 2; ++half) { const LAS float* cvo = (const LAS float*)raw + ((half * 32 + tt) * 3) * 64 + 4 * cg;
            cvr[half] = *(const LAS f32x4*)(cvo); cvk[half] = *(const LAS f32x4*)(cvo + 64); vv_[half] = *(const LAS f32x4*)(cvo + 128); }
#pragma unroll
        for (int half = 0; half < 2; ++half) {
            const int s = half * 32 + tt, pj = d ? 63 - s : s;
            const int tokrow = b * SEQ + gi * 64 + pj;
            const f32x4 rr = cvr[half], kv = cvk[half];
            f32x4 kkn = kv * kkw;
            const float ss = row16_sum(kkn[0] * kkn[0] + kkn[1] * kkn[1] + kkn[2] * kkn[2] + kkn[3] * kkn[3]);
            kkn = kkn * __builtin_amdgcn_rsqf(fmaxf(ss, 1e-12f));
            const u32x2 aq = *(const LAS u32x2*)(avl + s * 64 + 4 * cg);
            const f32x4 av = {bflo(aq.x), bfhi(aq.x), bflo(aq.y), bfhi(aq.y)};
            f32x4 kd, bv;
#pragma unroll
            for (int j = 0; j < 4; ++j) { kd[j] = kv[j] * (1.0f + (av[j] - 1.0f) * kaw[j]); bv[j] = kkn[j] * av[j]; }
            const float bon = row16_sum(rr[0] * kd[0] * rkw[0] + rr[1] * kd[1] * rkw[1] + rr[2] * kd[2] * rkw[2] + rr[3] * kd[3] * rkw[3]);
            if (!isctx && cg == 0) BONd[(size_t)tokrow * 8 + h] = bon;
            kkn_[half] = kkn; bv_[half] = bv; kd_[half] = kd; rr_[half] = rr;
        }
        {
            const int k = tid & 63, sg = tid >> 6;
            float run = 0.f;
#pragma unroll
            for (int j = 0; j < 8; ++j) { run += cum[(8 * sg + j) * 64 + k]; cum[(8 * sg + j) * 64 + k] = run; }
            seg[sg * 64 + k] = run;
            __syncthreads();
            float pre = 0.f;
            for (int q = 0; q < sg; ++q) pre += seg[q * 64 + k];
#pragma unroll
            for (int j = 0; j < 8; ++j) cum[(8 * sg + j) * 64 + k] += pre;
            __syncthreads();
        }
        const f32x4 LC = *(LAS f32x4*)(cum + 63 * 64 + 4 * cg);
        const f32x4 eLC = {fexp(LC[0]), fexp(LC[1]), fexp(LC[2]), fexp(LC[3])};
#pragma unroll 1
        for (int re_ = 0; re_ <= ((PROBE_RPT >> 21) & 1); ++re_)
#pragma unroll
        for (int half = 0; half < 2; ++half) {
            const int s = half * 32 + tt;
            const f32x4 L = *(LAS f32x4*)(cum + s * 64 + 4 * cg);
            f32x4 Lp = {0.f, 0.f, 0.f, 0.f}; if (s > 0) Lp = *(LAS f32x4*)(cum + (s - 1) * 64 + 4 * cg);
            f32x4 bh, kh, at, rt, bb2, kb2;
#pragma unroll
            for (int j = 0; j < 4; ++j) {
                const float em = fexp(-L[j]), ep = __builtin_amdgcn_rcpf(em), epv = fexp(Lp[j]), ec = eLC[j] * em;
                bh[j] = bv_[half][j] * em; kh[j] = kd_[half][j] * em; at[j] = -kkn_[half][j] * epv; rt[j] = rr_[half][j] * ep;
                bb2[j] = bv_[half][j] * ec; kb2[j] = kd_[half][j] * ec;
            }
            const int so = s * 144 + 8 * cg; u32x2 w;
            w.x = pk2(bh[0], bh[1]); w.y = pk2(bh[2], bh[3]); *(LAS u32x2*)(RSLOT(0) + so) = w;
            w.x = pk2(kh[0], kh[1]); w.y = pk2(kh[2], kh[3]); *(LAS u32x2*)(RSLOT(1) + so) = w;
            w.x = pk2(at[0], at[1]); w.y = pk2(at[2], at[3]); *(LAS u32x2*)(RSLOT(2) + so) = w;
            w.x = pk2(rt[0], rt[1]); w.y = pk2(rt[2], rt[3]); *(LAS u32x2*)(RSLOT(3) + so) = w;
            w.x = pk2(bb2[0], bb2[1]); w.y = pk2(bb2[2], bb2[3]); *(LAS u32x2*)(RSLOT(4) + so) = w;
            w.x = pk2(kb2[0], kb2[1]); w.y = pk2(kb2[2], kb2[3]); *(LAS u32x2*)(RSLOT(5) + so) = w;
            w.x = pk2(vv_[half][0], vv_[half][1]); w.y = pk2(vv_[half][2], vv_[half][3]); *(LAS u32x2*)(RSLOT(6) + so) = w;
            if (s == 63) *(LAS f32x4*)(lamC + 4 * cg) = eLC;
        }
        __syncthreads();
        }
        if (jl + nb < 64 * nstg) RWA_ISSUE(jl + nb);
#pragma unroll 1
        for (int T = wave; T < 20; T += 8) {
            const int prod = T % 5, tq = T / 5; const bool ti = (prod == 1 || prod == 2);
            const int mt = (tq == 2 || (tq == 1 && ti) || (tq == 3 && !ti)) ? 32 : 0, nt = (tq == 2 || (tq == 1 && !ti) || (tq == 3 && ti)) ? 32 : 0;
            f32x16 acc = zero16();
            if (tq < 3) {
                const int ia = prod == 0 ? 0 : (prod == 3 ? 0 : (prod == 4 ? 1 : 2)), ib = prod == 0 ? 2 : (prod == 1 ? 0 : (prod == 2 ? 1 : 3));
                acc = tile_mmx<false, false>(RSLOT(ia), RSLOT(ib), mt, nt, 0, 4, acc, lane);
                mask_tri(acc, mt, nt, lane, ti ? -1 : 1, prod >= 3 ? 0 : 1, prod == 1);
            }
            store_cr(RSLOT(7 + prod), acc, mt, nt, lane);
        }
        LSYNC();
        if (wave < 4) { const int mt = (wave >> 1) * 32, nt = (wave & 1) * 32; f32x16 acc = zero16();
            if (wave != 2) acc = tile_mmx<true, false>(RSLOT(7), RSLOT(7), mt, nt, wave == 3 ? 2 : 0, wave == 0 ? 2 : 4, acc, lane);
            store_cr(RSLOT(0), acc, mt, nt, lane); }
        LSYNC();
#pragma unroll
        for (int lv = 1; lv <= 4; ++lv) {
            const int pc_in = (lv & 1) ? 0 : 7, pc_out = (lv & 1) ? 7 : 0, tr_in = (lv & 1) ? 8 : 1, tr_out = (lv & 1) ? 1 : 8;
            const int w4 = wave & 3, mt = (w4 >> 1) * 32, nt = (w4 & 1) * 32;
            if (wave < 4) {
                if (w4 != 2) { f32x16 acc = tile_mmx<true, false>(RSLOT(pc_in), RSLOT(pc_in), mt, nt, w4 == 3 ? 2 : 0, w4 == 0 ? 2 : 4, zero16(), lane);
                    if (lv == 4) mask_tri(acc, mt, nt, lane, 1, -64, true);
                    store_cr(RSLOT(pc_out), acc, mt, nt, lane); }
            } else {
                if (w4 != 1) { f32x16 acc = init_cr(RSLOT(tr_in), mt, nt, lane);
                    acc = tile_mmx<false, false>(RSLOT(pc_in), RSLOT(tr_in), mt, nt, w4 == 3 ? 2 : 0, w4 == 0 ? 2 : 4, acc, lane);
                    store_cr(RSLOT(tr_out), acc, mt, nt, lane); }
                else if (lv == 1) store_cr(RSLOT(tr_out), zero16(), mt, nt, lane);
            }
            LSYNC();
        }
        if (wave < 4) { const int mt = (wave >> 1) * 32, nt = (wave & 1) * 32; f32x16 acc = zero16();
            if (wave != 2) acc = tile_mmx<false, false>(RSLOT(8), RSLOT(0), mt, nt, wave == 3 ? 2 : 0, wave == 0 ? 2 : 4, acc, lane);
            store_cr(RSLOT(1), acc, mt, nt, lane); }
        LSYNC();
        { const int w4 = wave & 3, mt = (w4 >> 1) * 32, nt = (w4 & 1) * 32; f32x16 acc = zero16();
            if (wave < 4) { acc = tile_mmx<false, true>(RSLOT(1), RSLOT(2), mt, nt, 0, mt ? 4 : 2, acc, lane); store_cr(RSLOT(7), acc, mt, nt, lane); }
            else { if (w4 != 1) acc = tile_mmx<false, false>(RSLOT(1), RSLOT(9), mt, nt, w4 == 3 ? 2 : 0, w4 == 0 ? 2 : 4, acc, lane); store_cr(RSLOT(0), acc, mt, nt, lane); } }
        LSYNC();
#pragma unroll 1
        for (int rl_ = 0; rl_ <= ((PROBE_RPT >> 22) & 1); ++rl_)
        {
            const int prod = wave >> 1, mt = (wave & 1) * 32;
            bf16_t* actj = RACT + (size_t)jl * 4096; bf16_t* rptj = RRPT + (size_t)jl * 4096;
#pragma unroll
            for (int nt2 = 0; nt2 < 2; ++nt2) {
                const int nt = nt2 * 32;
                if (prod == 0) { f32x16 acc = init_cr(RSLOT(3), mt, nt, lane); acc = tile_mmx<false, false>(RSLOT(7), RSLOT(10), mt, nt, 0, nt ? 4 : 2, acc, lane); store_g_perm(rptj, acc, mt, nt, lane); }
                else if (prod == 1) { f32x16 acc = zero16();
                    if (!(mt && !nt)) { acc = init_cr(RSLOT(11), mt, nt, lane); acc = tile_mmx<false, false>(RSLOT(0), RSLOT(10), mt, nt, mt ? 2 : 0, nt ? 4 : 2, acc, lane); }
                    store_cr(RSLOT(8), acc, mt, nt, lane); }
                else if (prod == 2) { f32x16 acc = tile_mmx<false, true>(RSLOT(7), RSLOT(4), mt, nt, 0, 4, zero16(), lane);
                    { const int c = nt + (lane & 31), hh = lane >> 5;
#pragma unroll
                      for (int r = 0; r < 16; ++r) { const int row = mt + (r & 3) + 8 * (r >> 2) + 4 * hh; if (row == c) acc[r] += lamC[row]; } }
                    store_g_perm(actj, acc, mt, nt, lane); }
                else { f32x16 acc = init_rc(RSLOT(5), mt, nt, lane); acc = tile_mmx<false, true>(RSLOT(0), RSLOT(4), mt, nt, mt ? 2 : 0, 4, acc, lane); store_cr(RSLOT(9), acc, mt, nt, lane); }
            }
        }
        LSYNC();
#pragma unroll 1
        for (int rl_ = 0; rl_ <= ((PROBE_RPT >> 22) & 1); ++rl_)
        { const int mt = ((wave >> 1) & 1) * 32, nt = (wave & 1) * 32;
            const f32x16 acc = tile_mmx<false, true>(RSLOT(wave < 4 ? 9 : 8), RSLOT(6), mt, nt, 0, (wave >= 4 && !mt) ? 2 : 4, zero16(), lane);
            store_g_cr((wave < 4 ? RSL : RYL) + (size_t)jl * 4096, acc, mt, nt, lane); }
    }
#undef RWA_ISSUE
    LSYNC();
}

__device__ __forceinline__ void p_rwkv_S(const Args& a, LAS unsigned char* lds, int bid, int nb, int stage) {
    const int tid = opaque_tid(), lane = tid & 63, wave = __builtin_amdgcn_readfirstlane(tid >> 6), vl = lane & 15, g = lane >> 4;
    const int role = wave >> 2, mt = wave & 3;
    const bf16_t* OPB = (const bf16_t*)(a.ws + (role ? WS_RRPT : WS_RACT)); const bf16_t* INB = (const bf16_t*)(a.ws + (role ? WS_RYL : WS_RSL));
    float* RST = (float*)(a.ws + WS_RST); bf16_t* YOUT = (bf16_t*)(a.ws + WS_YOUT);
    LAS unsigned char* bfr = lds;
    const int vcu = (nb % 8 == 0) ? (bid % 8) * (nb / 8) + bid / 8 : bid;
    const int nstg = stage ? RSTG1 : RSTG0, cs0 = stage ? RSTG0 : 0;
    for (int u = vcu; u < 256; u += nb) {
        const int chain = u >> 2, vq = u & 3, d = chain >> 5, b = (chain >> 3) & 3, h = chain & 7;
        f32x4 S = {0.f, 0.f, 0.f, 0.f};
        float* rst = RST + ((size_t)u * 64 + lane) * 16 + 4 * mt;
        if (stage != 0 && role == 0) S = *(const f32x4*)rst;
        __syncthreads();
        if (role == 0) { u32x2 w; w.x = pk2(S[0], S[1]); w.y = pk2(S[2], S[3]); *(LAS u32x2*)(bfr + ((mt >> 1) * 64 + lane) * 16 + (mt & 1) * 8) = w; }
        __syncthreads();
        bf16_t* Yd = YOUT + (size_t)d * NTL * 512 + h * 64 + vq * 16 + vl;
        const bf16_t* opp = OPB + (size_t)chain * nstg * 4096 + (16 * mt + vl) * 64 + 8 * g;
        const bf16_t* inp = INB + (size_t)chain * nstg * 4096 + (vq * 16 + vl) * 64 + 16 * mt + 4 * g;
        bf16x8 fa[8][2]; u32x2 ini[8];
#define RW_LOAD(q, c_) do { fa[q][0] = *(const bf16x8*)(opp + (size_t)(c_) * 4096); fa[q][1] = *(const bf16x8*)(opp + (size_t)(c_) * 4096 + 32); ini[q] = *(const u32x2*)(inp + (size_t)(c_) * 4096); } while (0)
#define RW_STEP(q, c_) do { \
            const LAS unsigned char* bp = bfr + ((c_) & 1) * 2048 + lane * 16; \
            const bf16x8 b0 = *(const LAS bf16x8*)(bp), b1 = *(const LAS bf16x8*)(bp + 1024); \
            f32x4 acc = {bflo(ini[q].x), bfhi(ini[q].x), bflo(ini[q].y), bfhi(ini[q].y)}; \
            acc = __builtin_amdgcn_mfma_f32_16x16x32_bf16(fa[q][0], b0, acc, 0, 0, 0); acc = __builtin_amdgcn_mfma_f32_16x16x32_bf16(fa[q][1], b1, acc, 0, 0, 0); \
            if (role == 0) { S = acc; u32x2 w; w.x = pk2(acc[0], acc[1]); w.y = pk2(acc[2], acc[3]); *(LAS u32x2*)(bfr + (((c_) + 1) & 1) * 2048 + ((mt >> 1) * 64 + lane) * 16 + (mt & 1) * 8) = w; } \
            else { const int cs_ = cs0 + (c_); \
                if (cs_ >= CTXL / RC) { _Pragma("unroll") for (int r = 0; r < 4; ++r) { const int i_ = cs_ * RC + 16 * mt + 4 * g + r - CTXL; const int pos_ = d ? (SEQ - 1 - i_) : i_; \
                    Yd[(size_t)(b * SEQ + pos_) * 512] = (bf16_t)f2bf(acc[r]); } } } \
            asm volatile("s_waitcnt lgkmcnt(0)" ::: "memory"); __builtin_amdgcn_s_barrier(); asm volatile("" ::: "memory"); } while (0)
        RW_LOAD(0, 0); RW_LOAD(1, 1); RW_LOAD(2, 2); RW_LOAD(3, 3); RW_LOAD(4, 4); RW_LOAD(5, 5); RW_LOAD(6, 6);
        static_assert(RSTG0 % 8 == 0 && RSTG1 % 8 == 4, "the prefetch ring below: full groups of 8 chunks, then 4");
#define RW_PAIR(q) do { if (c + (q) + 7 < nstg) RW_LOAD(((q) + 7) & 7, c + (q) + 7); RW_STEP(q, c + (q)); } while (0)
        int c = 0;
#pragma unroll 1
        for (; c + 8 <= nstg; c += 8) {
            RW_PAIR(0); RW_PAIR(1); RW_PAIR(2); RW_PAIR(3); RW_PAIR(4); RW_PAIR(5); RW_PAIR(6); RW_PAIR(7);
        }
        if (c < nstg) { RW_STEP(0, c); RW_STEP(1, c + 1); RW_STEP(2, c + 2); RW_STEP(3, c + 3); }
#undef RW_PAIR
#undef RW_LOAD
#undef RW_STEP
        if (stage == 0 && role == 0) *(f32x4*)rst = S;
    }
    __syncthreads();
}

__device__ __forceinline__ float grp8_sum(float v) { v += dppf<0xB1>(v); v += dppf<0x4E>(v); v += dppf<0x141>(v); return v; }
__device__ __forceinline__ void p_rwkv_readout(const Args& a, int bid, int nb) {
    const int tid = opaque_tid(), lane = tid & 63, wave = tid >> 6, c0 = lane * 8, h = lane >> 3;
    const bf16_t* Z = (const bf16_t*)(a.ws + WS_Z); const bf16_t* Y = (const bf16_t*)(a.ws + WS_YOUT); const float* BON = (const float*)(a.ws + WS_BON);
    const bf16_t* GATE = (const bf16_t*)(a.ws + WS_GATE); bf16_t* MIX = (bf16_t*)(a.ws + WS_MIX);
    float lnw[8], lnb[8];
#pragma unroll
    for (int j = 0; j < 8; ++j) { lnw[j] = a.in[19][c0 + j]; lnb[j] = a.in[20][c0 + j]; }
    for (int tok = bid * 8 + wave; tok < NTL; tok += nb * 8) {
        const int b = tok >> 12, pos = tok & 4095, ti = pos >> 6, tj = pos & 63;
        const u32x4 yf = *(const u32x4*)(Y + (size_t)tok * 512 + c0), yb = *(const u32x4*)(Y + (size_t)(NTL + tok) * 512 + c0);
        const u32x4 gt = *(const u32x4*)(GATE + (size_t)tok * 512 + c0);
        const float bonus = BON[(size_t)tok * 8 + h] + BON[(size_t)(NTL + tok) * 8 + h];
        float y[8] = {bflo(yf.x) + bflo(yb.x), bfhi(yf.x) + bfhi(yb.x), bflo(yf.y) + bflo(yb.y), bfhi(yf.y) + bfhi(yb.y),
                      bflo(yf.z) + bflo(yb.z), bfhi(yf.z) + bfhi(yb.z), bflo(yf.w) + bflo(yb.w), bfhi(yf.w) + bfhi(yb.w)};
        float v[8] = {0.f, 0.f, 0.f, 0.f, 0.f, 0.f, 0.f, 0.f};
        {
            u32x4 q[9]; float vm[9];
#pragma unroll
            for (int aa = 0; aa < 3; ++aa)
#pragma unroll
                for (int bb2 = 0; bb2 < 3; ++bb2) { const int ii = ti + aa - 1, jj = tj + bb2 - 1;
                    vm[aa * 3 + bb2] = (ii >= 0 && ii < 64 && jj >= 0 && jj < 64) ? 1.0f : 0.0f;
                    q[aa * 3 + bb2] = *(const u32x4*)(Z + (size_t)(b * SEQ + min(max(ii, 0), 63) * 64 + min(max(jj, 0), 63)) * ZLD + COL_V + c0); }
#pragma unroll
            for (int tap = 0; tap < 9; ++tap) {
                const f32x4 w0 = *(const f32x4*)(a.in[10] + tap * 1536 + 1024 + c0) * vm[tap], w1 = *(const f32x4*)(a.in[10] + tap * 1536 + 1024 + c0 + 4) * vm[tap];
                v[0] += bflo(q[tap].x) * w0[0]; v[1] += bfhi(q[tap].x) * w0[1]; v[2] += bflo(q[tap].y) * w0[2]; v[3] += bfhi(q[tap].y) * w0[3];
                v[4] += bflo(q[tap].z) * w1[0]; v[5] += bfhi(q[tap].z) * w1[1]; v[6] += bflo(q[tap].w) * w1[2]; v[7] += bfhi(q[tap].w) * w1[3]; }
        }
        float s = 0.f;
#pragma unroll
        for (int j = 0; j < 8; ++j) s += y[j];
        const float mu = grp8_sum(s) * (1.f / 64.f);
        float q2 = 0.f;
#pragma unroll
        for (int j = 0; j < 8; ++j) { y[j] -= mu; q2 += y[j] * y[j]; }
        const float rstd = 1.0f / sqrtf(grp8_sum(q2) * (1.f / 64.f) + 64e-5f);
        const float gv[8] = {bflo(gt.x), bfhi(gt.x), bflo(gt.y), bfhi(gt.y), bflo(gt.z), bfhi(gt.z), bflo(gt.w), bfhi(gt.w)};
        float o[8];
#pragma unroll
        for (int j = 0; j < 8; ++j) o[j] = (y[j] * rstd * lnw[j] + lnb[j] + bonus * v[j]) * gv[j];
        u32x4 w; w.x = pk2(o[0], o[1]); w.y = pk2(o[2], o[3]); w.z = pk2(o[4], o[5]); w.w = pk2(o[6], o[7]);
        *(u32x4*)(MIX + (size_t)tok * DM + c0) = w;
    }
}

constexpr int NPH = 16;
__global__ void __launch_bounds__(NTHREADS, 2) mega(Args a) {
    __builtin_assume(__builtin_amdgcn_workitem_id_y() == 0); __builtin_assume(__builtin_amdgcn_workitem_id_z() == 0);
    extern __shared__ __attribute__((aligned(16))) unsigned char lds_raw[];
    LAS unsigned char* lds = (LAS unsigned char*)lds_raw;
    cg::grid_group grid = cg::this_grid();
    const int tid = threadIdx.x, bid = blockIdx.x, nb = gridDim.x;
    unsigned char* ws = a.ws;
    float* MOD = (float*)(ws + WS_MOD);
    const int lo = a.ph_lo, hi = a.ph_hi;
    volatile LAS unsigned* misc = (volatile LAS unsigned*)(lds + 131072);
    if (tid < 4) misc[tid] = 0u;
    __syncthreads();
    const XcdBarrier xbar = xcd_barrier_post((unsigned*)(ws + WS_CTL), misc);
#define IN(k) (lo <= (k) && (k) < hi)
#define SEAM(k) do { if (IN(k) && IN((k) + 1)) xcd_barrier(xbar); } while (0)
    if (lo < 0) grid.sync();
#define PHASE(k, ...) if (IN(k)) { __VA_ARGS__ if ((PROBE_RPT >> (k)) & 1) { xcd_barrier(xbar); __VA_ARGS__ } } SEAM(k);
    PHASE(0, {
        p0_mod(a, lds, bid, nb);
        __syncthreads();
        p0_weights(a, lds, bid, nb, 0);
        __syncthreads();
        p0_s5(a, lds, bid, nb);
    })
    PHASE(1, {
        p1_s5(a, lds, bid, nb);
        bf16_t* HM = (bf16_t*)(ws + WS_HMOD); const int t_ = opaque_tid(), lane = t_ & 63, wave = t_ >> 6;
        for (int row = bid * 8 + wave; row < NTOK; row += nb * 16) {
            const int rowB = row + nb * 8; const bool hasB = rowB < NTOK;
            const RowV ra = row_load(row < NTL ? a.in[0] + (size_t)row * DM : a.in[2] + (size_t)(row - NTL) * DM, lane);
            RowV rb = ra; if (hasB) rb = row_load(rowB < NTL ? a.in[0] + (size_t)rowB * DM : a.in[2] + (size_t)(rowB - NTL) * DM, lane);
            { const int mb = row < NTL ? (row >> 12) : 4; norm_mod_finish(ra, a.in[6], MOD + mb * 6144, MOD + mb * 6144 + 1024, HM + (size_t)row * DM, lane); }
            if (hasB) { const int mb = rowB < NTL ? (rowB >> 12) : 4; norm_mod_finish(rb, a.in[6], MOD + mb * 6144, MOD + mb * 6144 + 1024, HM + (size_t)rowB * DM, lane); }
        }
    })
    PHASE(2, {
        pg8::Gemm g{(const bf16_t*)(ws + WS_HMOD), (const bf16_t*)(ws + WS_WTIN), DM, DM, DM};
        pg8::StaticOrder S; S.init(NTOK, DINP, nb, bid);
        pg8::EpiZ E{(bf16_t*)(ws + WS_Z), (bf16_t*)(ws + WS_AALL), (bf16_t*)(ws + WS_SIG)};
        pg8::gemm_phase(lds, g, S, E);
    })
    PHASE(3, {
        pg8::Gemm g{(const bf16_t*)(ws + WS_AALL), (const bf16_t*)(ws + WS_BT2), S5K1, 512, 512};
        pg8::S5Order2 S{nb, bid};
        pg8::EpiE E{(float*)(ws + WS_E)};
        pg8::gemm_phase(lds, g, S, E);
    })
    PHASE(4, { p_s5_carry(a, bid, nb); __syncthreads(); p0_weights(a, lds, bid, nb, 1); if ((PROBE_RPT >> 23) & 1) { for (int q_ = 0; q_ < 10; ++q_) xcd_barrier(xbar); } })
    PHASE(5, {
        if (bid < nb / 2) {
            pg8::Gemm g{(const bf16_t*)(ws + WS_AALL), (const bf16_t*)(ws + WS_BT1), S5K1, S5K1, S5K1};
            pg8::S5Order1 S{nb / 2, bid};
            pg8::EpiY E{(const bf16_t*)(ws + WS_AALL), a.in[28], (bf16_t*)(ws + WS_ZG)};
            pg8::gemm_phase(lds, g, S, E);
        } else {
            pg8::Gemm g2{(const bf16_t*)(ws + WS_SIG), (const bf16_t*)(ws + WS_G2T), 256, 256, 256};
            pg8::StaticOrder S2; S2.init(NTL, 512, nb - nb / 2, bid - nb / 2);
            pg8::EpiG E2{(bf16_t*)(ws + WS_GATE)};
            pg8::gemm_phase(lds, g2, S2, E2);
        }
    })
#pragma unroll 1
    for (int rep6 = 0; rep6 <= ((PROBE_RPT >> 6) & 1); ++rep6) {
        if (rep6) xcd_barrier(xbar);
#pragma unroll 1
        for (int st = 0; st < 2; ++st) {
            if (IN(6 + 2 * st)) { p_rwkv_A(a, lds, bid, nb, st); if ((PROBE_RPT >> 16) & 1) { xcd_barrier(xbar); p_rwkv_A(a, lds, bid, nb, st); } }
            if (IN(6 + 2 * st) && IN(7 + 2 * st)) xcd_barrier(xbar);
            if (IN(7 + 2 * st)) { p_rwkv_S(a, lds, bid, nb, st); if ((PROBE_RPT >> 17) & 1) { xcd_barrier(xbar); p_rwkv_S(a, lds, bid, nb, st); } }
            if (st == 0 && IN(7) && IN(8)) xcd_barrier(xbar);
        }
    }
    SEAM(9);
    PHASE(10, {
        p_rwkv_readout(a, bid, nb);
        __syncthreads();
        pg8::Gemm g{(const bf16_t*)(ws + WS_ZG), (const bf16_t*)(ws + WS_WTGLU), 512, 512, 512};
        pg8::StaticOrder S; S.init(NTL, 512, nb, bid);
        pg8::EpiGLU E{(const bf16_t*)(ws + WS_ZG), a.in[30], (bf16_t*)(ws + WS_MIX)};
        pg8::gemm_phase(lds, g, S, E);
    })
    PHASE(11, {
        pg8::Gemm g{(const bf16_t*)(ws + WS_MIX), (const bf16_t*)(ws + WS_WTOUT), DM, DM, DM};
        pg8::StaticOrder S; S.init(NTL, DM, nb, bid);
        pg8::PanelSumsq st{(float*)(ws + WS_XBUF), (unsigned*)(ws + WS_CTL + 16384)};
        pg8::EpiWoutNorm E{a.in[0], a.out, MOD, a.in[7], (bf16_t*)(ws + WS_HMOD), st};
        pg8::gemm_phase(lds, g, S, E);
    })
    PHASE(13, {
        pg8::Gemm g{(const bf16_t*)(ws + WS_HMOD), (const bf16_t*)(ws + WS_WT13), DM, DM, DM};
        pg8::StaticOrder S; S.init(NTL, 2 * DFF, nb, bid);
        pg8::EpiUp E{(bf16_t*)(ws + WS_ACT)};
        pg8::gemm_phase(lds, g, S, E);
    })
    if (IN(14)) {
        pg8::Gemm g{(const bf16_t*)(ws + WS_ACT), (const bf16_t*)(ws + WS_WT2), DFF, DFF, DFF};
        pg8::StaticOrder S; S.init(NTL, DM, nb, bid);
        pg8::PanelSumsq st{(float*)(ws + WS_XBUF) + 64 * 256 * 4, (unsigned*)(ws + WS_CTL + 32768)};
        pg8::EpiDownNorm E{a.out, MOD, a.in[34], st};
        pg8::gemm_phase(lds, g, S, E);
    }
#undef PHASE
#undef IN
#undef SEAM
}

extern "C" void kernel_launch(void* const* d_in, const int* in_sizes, int n_in, void* d_out, int out_size, void* d_ws, size_t ws_size, hipStream_t stream) {
    static int grid_blocks = 0;
    if (!grid_blocks) {
        int dev = 0, cus = 0, per_cu = 0;
        (void)hipGetDevice(&dev);
        (void)hipDeviceGetAttribute(&cus, hipDeviceAttributeMultiprocessorCount, dev);
        if (hipFuncSetAttribute((const void*)mega, hipFuncAttributeMaxDynamicSharedMemorySize, LDS_BYTES) != hipSuccess) fprintf(stderr, "hipFuncSetAttribute failed\n");
        (void)hipOccupancyMaxActiveBlocksPerMultiprocessor(&per_cu, (const void*)mega, NTHREADS, LDS_BYTES);
        if (ws_size < WS_END || n_in != 35) { fprintf(stderr, "kernel_launch: need %zu bytes of workspace (have %zu), 35 inputs (have %d)\n", (size_t)WS_END, ws_size, n_in); grid_blocks = -1; return; }
        if (per_cu < 1) { fprintf(stderr, "kernel_launch: occupancy query says %d blocks per CU\n", per_cu); per_cu = 1; }
        grid_blocks = cus;
        if (cus != 256) fprintf(stderr, "kernel_launch: built for a 256-CU device (the fused-norm GEMM epilogues need exactly one 256x256 unit per workgroup); got %d CUs\n", cus);
    }
    if (grid_blocks < 0) return;
    Args a{};
    for (int i = 0; i < 35; ++i) a.in[i] = (const float*)d_in[i];
    a.out = (float*)d_out; a.ws = (unsigned char*)d_ws; a.ph_lo = 0; a.ph_hi = NPH;
    (void)hipMemsetAsync((char*)d_ws + WS_CTL, 0, CTL_BYTES, stream);
    void* args[] = {&a};
    hipError_t e = hipLaunchCooperativeKernel((const void*)mega, dim3(grid_blocks), dim3(NTHREADS), args, LDS_BYTES, stream);
    if (e != hipSuccess) fprintf(stderr, "cooperative launch failed: %s (grid %d)\n", hipGetErrorString(e), grid_blocks);
}
```

```cpp
#include <hip/hip_runtime.h>
#include <hip/hip_cooperative_groups.h>
#include <cstdio>
namespace cg = cooperative_groups;

#define LAS __attribute__((address_space(3)))
typedef unsigned short bf16_t;
typedef short bf16x8 __attribute__((ext_vector_type(8)));
typedef float f32x4 __attribute__((ext_vector_type(4)));
typedef float f32x2 __attribute__((ext_vector_type(2)));
typedef unsigned u32x4 __attribute__((ext_vector_type(4)));
typedef unsigned u32x2 __attribute__((ext_vector_type(2)));

constexpr int NTHREADS = 512;
constexpr int LDS_BYTES = 131072 + 4096;
constexpr int DM = 1024, BATCH = 4, SEQ = 4096, CTXL = 256;
constexpr int NTL = BATCH * SEQ, NTC = BATCH * CTXL, NTOK = NTL + NTC;
constexpr int DIN = 2272, DINP = 2304, ZLD = 1792;
constexpr int COL_K = 512, COL_V = 1024, COL_WD = 1536, COL_AD = 1600, COL_GD = 1664, COL_U = 1760;
constexpr int DFF = 2816;
constexpr int S5C = 16;
constexpr int S5U = S5C * 16;
constexpr int S5LR = NTL / S5C, S5XR = NTC / S5C;
constexpr int S5EROWS = S5LR + S5XR;
constexpr int S5NRT = (S5EROWS + 255) / 256;
constexpr int S5ROWS = S5NRT * 256;
constexpr int S5K1 = S5U + 256;
constexpr int S5NRY = S5LR / 256, S5NCY = S5U / 256;
constexpr int S5NCH = SEQ / S5C, S5NCX = CTXL / S5C;

constexpr size_t al256(size_t x) { return (x + 255) & ~(size_t)255; }
constexpr size_t WS_CTL   = 0;
constexpr size_t CTL_BYTES = 65536;
constexpr size_t WS_MOD   = CTL_BYTES;
constexpr size_t WS_WTIN  = al256(WS_MOD + (size_t)5 * 6144 * 4);
constexpr size_t WS_WTOUT = al256(WS_WTIN + (size_t)DINP * DM * 2);
constexpr size_t WS_WT13  = al256(WS_WTOUT + (size_t)DM * DM * 2);
constexpr size_t WS_WT2   = al256(WS_WT13 + (size_t)2 * DFF * DM * 2);
constexpr size_t WS_WTGLU = al256(WS_WT2 + (size_t)DM * DFF * 2);
constexpr size_t WS_S5TAB = al256(WS_WTGLU + (size_t)512 * 512 * 2);
constexpr size_t WS_KT    = al256(WS_S5TAB + (size_t)2 * 32 * 64 * 2 * 4);
constexpr size_t WS_W2T   = al256(WS_KT + (size_t)32 * (2 * S5C * 256) * 4);
constexpr size_t WS_BON   = al256(WS_W2T + (size_t)2 * 2 * 512 * 32 * 2);
constexpr size_t WS_ZG    = al256(WS_BON + (size_t)2 * NTL * 8 * 4);
constexpr size_t WS_HMOD  = al256(WS_ZG + (size_t)NTL * 512 * 2);
constexpr size_t WS_Z     = al256(WS_HMOD + (size_t)NTOK * DM * 2);
constexpr size_t WS_AALL  = al256(WS_Z + (size_t)NTOK * ZLD * 2);
constexpr size_t WS_BT1   = al256(WS_AALL + (size_t)32 * S5ROWS * S5K1 * 2);
constexpr size_t WS_BT2   = al256(WS_BT1 + (size_t)32 * S5U * S5K1 * 2);
constexpr size_t WS_E     = al256(WS_BT2 + (size_t)32 * 256 * S5U * 2);
constexpr size_t WS_S5END = al256(WS_E + (size_t)32 * S5EROWS * 256 * 4);
constexpr size_t WS_SIG   = WS_S5END;
constexpr size_t WS_G2T   = al256(WS_SIG + (size_t)NTL * 256 * 2);
constexpr size_t WS_GATE  = al256(WS_G2T + (size_t)512 * 256 * 2);
constexpr size_t WS_XBUF  = al256(WS_GATE + (size_t)NTL * 512 * 2);
constexpr size_t WS_END2  = al256(WS_XBUF + (size_t)2 * 64 * 256 * 4 * 4);
constexpr size_t WS_ACT   = WS_Z;

constexpr size_t WS_END = WS_END2;
static_assert(WS_ACT + (size_t)NTL * DFF * 2 <= WS_S5END, "ACT alias");
static_assert(WS_END <= (size_t)256 * 1024 * 1024, "workspace");

#ifndef PROBE_RPT
#define PROBE_RPT 0
#endif
#ifndef PROBE_PHT
#define PROBE_PHT -1
#endif
#ifndef PROBE_SEC
#define PROBE_SEC 0
#endif
struct Args { const float* in[35]; float* out; unsigned char* ws; int ph_lo, ph_hi; };

typedef __bf16 bf16x2_t __attribute__((ext_vector_type(2)));
__device__ __forceinline__ unsigned pk2(float lo, float hi) { const f32x2 v = {lo, hi}; return __builtin_bit_cast(unsigned, __builtin_convertvector(v, bf16x2_t)); }
__device__ __forceinline__ unsigned f2bf(float f) { return pk2(f, f) & 0xffffu; }
__device__ __forceinline__ float bflo(unsigned w) { return __builtin_bit_cast(float, w << 16); }
__device__ __forceinline__ float bfhi(unsigned w) { return __builtin_bit_cast(float, w & 0xffff0000u); }
__device__ __forceinline__ float bf2f(bf16_t b) { return __builtin_bit_cast(float, ((unsigned)b) << 16); }
__device__ __forceinline__ float wave_sum(float v) {
#pragma unroll
    for (int o = 1; o < 64; o <<= 1) v += __shfl_xor(v, o);
    return v;
}
template <int CTRL> __device__ __forceinline__ float dppf(float v) { return __builtin_bit_cast(float, __builtin_amdgcn_update_dpp(0, __builtin_bit_cast(int, v), CTRL, 0xf, 0xf, false)); }
__device__ __forceinline__ float row16_sum(float v) { v += dppf<0x128>(v); v += dppf<0x124>(v); v += dppf<0x122>(v); v += dppf<0x121>(v); return v; }
__device__ __forceinline__ int opaque_tid() { int t = threadIdx.x; asm volatile("" : "+v"(t)); return t; }
__device__ __forceinline__ float fexp(float x) { return __builtin_amdgcn_exp2f(x * 1.4426950408889634f); }
__device__ __forceinline__ float flog(float x) { return __builtin_amdgcn_logf(x) * 0.6931471805599453f; }
__device__ __forceinline__ float sigmoidf_(float x) { return __builtin_amdgcn_rcpf(1.0f + fexp(-x)); }
__device__ __forceinline__ float siluf_(float x) { return x * __builtin_amdgcn_rcpf(1.0f + fexp(-x)); }
__device__ __forceinline__ float tanh_fast(float x) { return 1.0f - 2.0f * __builtin_amdgcn_rcpf(1.0f + fexp(2.0f * x)); }
__device__ __forceinline__ float gelu_tanh(float x) { const float u = 0.7978845608028654f * (x + 0.044715f * x * x * x); return x - x * __builtin_amdgcn_rcpf(1.0f + fexp(2.0f * u)); }

#define XB_TMO      128
#define XB_XCNT(j)  (256  + 64 * (j))
#define XB_XSUB(j)  (1280 + 64 * (j))
#define XB_XGEN(j)  (2304 + 64 * (j))
#define XB_TOP      3328
#define XB_TOPGEN   3392
#define XCD_BAR_WORDS 3456
#define XB_SPIN_CAP (1u << 20)
static_assert(XCD_BAR_WORDS * 4 <= CTL_BYTES, "ctl");
__device__ __forceinline__ unsigned xb_ld(unsigned* p)              { return __hip_atomic_load(p, __ATOMIC_RELAXED, __HIP_MEMORY_SCOPE_AGENT); }
__device__ __forceinline__ unsigned xb_add(unsigned* p, unsigned v) { return __hip_atomic_fetch_add(p, v, __ATOMIC_RELAXED, __HIP_MEMORY_SCOPE_AGENT); }
__device__ __forceinline__ unsigned xb_xcc_id() { return (unsigned)__builtin_amdgcn_s_getreg((3 << 11) | 20) & 0xFu; }
#define XB_SPIN(cond, bar) do { unsigned _sp = 0; while (cond) { __builtin_amdgcn_s_sleep(1); \
    if ((++_sp & 255u) == 0u) { if (xb_ld(&(bar)[XB_TMO])) break; if (_sp > XB_SPIN_CAP) { atomicAdd(&(bar)[XB_TMO], 1u); break; } } } } while (0)
struct XcdBarrier { unsigned* bar; unsigned x; volatile LAS unsigned* st; };
__device__ __forceinline__ XcdBarrier xcd_barrier_post(unsigned* bar, volatile LAS unsigned* st) {
    XcdBarrier b; b.bar = bar; b.x = xb_xcc_id(); b.st = st;
    if (threadIdx.x == 0) (void)xb_add(&bar[XB_XCNT(b.x)], 1u);
    return b;
}
__device__ __forceinline__ void xcd_barrier_complete(unsigned* bar, unsigned x, unsigned& nloc, unsigned& nx) {
    const unsigned G = gridDim.x * gridDim.y * gridDim.z;
    unsigned sum, cnt, mine, sp = 0u;
    for (;;) {
        sum = 0u; cnt = 0u; mine = 0u;
#pragma unroll
        for (unsigned j = 0; j < 16; ++j) { const unsigned c = xb_ld(&bar[XB_XCNT(j)]); sum += c; cnt += (c > 0u) ? 1u : 0u; mine = (j == x) ? c : mine; }
        if (sum == G) break;
        __builtin_amdgcn_s_sleep(1);
        if ((++sp & 255u) == 0u) { if (xb_ld(&bar[XB_TMO])) break; if (sp > XB_SPIN_CAP) { atomicAdd(&bar[XB_TMO], 1u); break; } }
    }
    nloc = mine > 0u ? mine : 1u; nx = cnt > 0u ? cnt : 1u;
}
__device__ __forceinline__ void xcd_barrier(const XcdBarrier& b) {
    asm volatile("s_waitcnt vmcnt(0)" ::: "memory");
    __syncthreads();
    if (threadIdx.x == 0) {
        unsigned* bar = b.bar;
        __builtin_amdgcn_s_waitcnt(0);
        unsigned nloc = b.st[0], nx = b.st[1];
        if (nloc == 0u) { xcd_barrier_complete(bar, b.x, nloc, nx); b.st[0] = nloc; b.st[1] = nx; }
        const unsigned old = xb_add(&bar[XB_XSUB(b.x)], 1u);
        const unsigned gen = old / nloc;
        if (old + 1u == (gen + 1u) * nloc) {
            __builtin_amdgcn_fence(__ATOMIC_RELEASE, "agent");
            asm volatile("s_waitcnt vmcnt(0)" ::: "memory");
            const unsigned og = xb_add(&bar[XB_TOP], 1u);
            const unsigned tg = og / nx;
            if (og + 1u == (tg + 1u) * nx) xb_add(&bar[XB_TOPGEN], 1u);
            else XB_SPIN(xb_ld(&bar[XB_TOPGEN]) == tg, bar);
            __builtin_amdgcn_fence(__ATOMIC_ACQUIRE, "agent");
            xb_add(&bar[XB_XGEN(b.x)], 1u);
            asm volatile("s_waitcnt vmcnt(0)" ::: "memory");
        } else {
            XB_SPIN(xb_ld(&bar[XB_XGEN(b.x)]) == gen, bar);
            __builtin_amdgcn_fence(__ATOMIC_ACQUIRE, "agent");
            asm volatile("s_waitcnt vmcnt(0)" ::: "memory");
        }
    }
    __syncthreads();
}

namespace pg8 {
constexpr int BM = 256, BK = 64, HALF = 128, HTB = HALF * BK * 2, STAGE_BYTES = 8 * HTB, NXCD = 8, WGM = 8;
__host__ __device__ __forceinline__ int lds_byte(int r, int c) { const int st = (r >> 4) * 2 + (c >> 5), rr = r & 15, cc = c & 31, ob = rr * 64 + cc * 2; return st * 1024 + (ob ^ (((ob >> 9) & 1) << 5)); }
__host__ __device__ __forceinline__ void stage_rc(int b, int& R, int& C) { const int st = b / 1024, sb = b % 1024, swz = sb ^ (((sb >> 9) & 1) << 5); R = (st >> 1) * 16 + swz / 64; C = (st & 1) * 32 + (swz % 64) / 2; }
__host__ __device__ __forceinline__ int perm32(int rho) { const int n = rho >> 4, i = rho & 15; return 8 * (i >> 2) + 4 * n + (i & 3); }
struct Unit { int pm, pn; };
struct Gemm { const bf16_t* A; const bf16_t* Bt; int lda, ldb, K; };
struct StaticOrder {
    int nM, nN, nwg, G, c;
    __device__ void init(int M, int N, int G_, int c_) { nM = M / BM; nN = N / BM; nwg = nM * nN; G = G_; c = c_; }
    __device__ bool next(int i, Unit& u) const {
        const long L = (long)i * G + c; if (L >= nwg) return false;
        int wgid = (int)L; { const int q = nwg / NXCD, r = nwg % NXCD, xcd = wgid % NXCD, off = wgid / NXCD; wgid = (xcd < r ? xcd * (q + 1) : r * (q + 1) + (xcd - r) * q) + off; }
        const int nig = WGM * nN, gid = wgid / nig, fm = gid * WGM, gsz = (nM - fm) < WGM ? (nM - fm) : WGM;
        u.pm = fm + ((wgid % nig) % gsz); u.pn = (wgid % nig) / gsz; return true;
    }
};
struct S5Order2 { int G, c; __device__ bool next(int i, Unit& u) const { const int L = i * G + c; if (L >= 32 * S5NRT) return false; const int g = L / S5NRT; u.pm = g * S5NRT + L % S5NRT; u.pn = g; return true; } };
struct S5Order1 { int G, c; __device__ bool next(int i, Unit& u) const { const int L = i * G + c; if (L >= 32 * S5NRY * S5NCY) return false; const int g = L / (S5NRY * S5NCY), q = L % (S5NRY * S5NCY); u.pm = g * S5NRT + q / S5NCY; u.pn = g * S5NCY + q % S5NCY; return true; } };

template <class Epi, class Sched>
__device__ __forceinline__ void gemm_phase(LAS unsigned char* lds, const Gemm g, const Sched& S, const Epi& E) {
    int tid_ = threadIdx.x; asm volatile("" : "+v"(tid_));
    const int tid = tid_, wid = __builtin_amdgcn_readfirstlane(tid >> 6), lane = tid & 63, wr = wid >> 2, wc = wid & 3, fr = lane & 15, fq = lane >> 4;
    const int K = g.K, nt = K / BK;
    unsigned voffA[2], voffB[2];
#pragma unroll
    for (int i = 0; i < 2; ++i) { int R, C; stage_rc(tid * 16 + i * 8192, R, C); const int Rb = Epi::PERM ? ((R & ~31) + perm32(R & 31)) : R;
        voffA[i] = (unsigned)(R * g.lda + C) * 2u; voffB[i] = (unsigned)(Rb * g.ldb + C) * 2u; }
    const size_t kstep = (size_t)(BK * 2);
    const size_t hstepA = (size_t)HALF * g.lda * 2, hstepB = (size_t)HALF * g.ldb * 2;
    const size_t tstepA = 2 * hstepA, tstepB = 2 * hstepB;
    const unsigned ldsw = (unsigned)wid * 1024u;
    const int aoff = lds_byte(wr * 64 + fr, fq * 8), boff = lds_byte(wc * 32 + fr, fq * 8);
#define PG8_SA(b, h) (((b) * 2 + (h)) * HTB)
#define PG8_SB(b, h) ((4 + (b) * 2 + (h)) * HTB)
#define PG8_STAGE(bufoff, gbase, voff) do { _Pragma("unroll") for (int _i = 0; _i < 2; ++_i) \
        __builtin_amdgcn_global_load_lds((const unsigned*)((const char*)(gbase) + (voff)[_i]), (LAS unsigned*)(lds + (bufoff) + ldsw + _i * 8192), 16, 0, 0); } while (0)
#define PG8_LDA(dst, b, h) do { _Pragma("unroll") for (int m = 0; m < 4; ++m) _Pragma("unroll") for (int k = 0; k < 2; ++k) dst[m][k] = *(const LAS bf16x8*)(lds + PG8_SA(b, h) + aoff + m * 2048 + k * 1024); } while (0)
#define PG8_LDB(dst, b, h) do { _Pragma("unroll") for (int n = 0; n < 2; ++n) _Pragma("unroll") for (int k = 0; k < 2; ++k) dst[n][k] = *(const LAS bf16x8*)(lds + PG8_SB(b, h) + boff + n * 2048 + k * 1024); } while (0)
#define PG8_MMA(ai, bj, At, Bt) do { __builtin_amdgcn_s_setprio(1); _Pragma("unroll") for (int m = 0; m < 4; ++m) _Pragma("unroll") for (int n = 0; n < 2; ++n) _Pragma("unroll") for (int k = 0; k < 2; ++k) \
        acc[ai][bj][m][n] = __builtin_amdgcn_mfma_f32_16x16x32_bf16(Bt[n][k], At[m][k], acc[ai][bj][m][n], 0, 0, 0); __builtin_amdgcn_s_setprio(0); } while (0)
#define PG8_WAIT_V(n) asm volatile("s_waitcnt vmcnt(" #n ")" ::: "memory")
#define PG8_WAIT_L(n) asm volatile("s_waitcnt lgkmcnt(" #n ")" ::: "memory")
#define PG8_BAR __builtin_amdgcn_s_barrier()
#define PG8_SCHED __builtin_amdgcn_sched_barrier(0)
    Unit cur, nxt; int ui = 0;
    if (!S.next(0, cur)) return;
    f32x4 acc[2][2][4][2];
#pragma unroll
    for (int a = 0; a < 2; ++a)
#pragma unroll
        for (int b = 0; b < 2; ++b)
#pragma unroll
            for (int m = 0; m < 4; ++m)
#pragma unroll
                for (int n = 0; n < 2; ++n) acc[a][b][m][n] = (f32x4){0.f, 0.f, 0.f, 0.f};
    bf16x8 At[4][2], B0[2][2], B1[2][2];
    const char* cA = (const char*)g.A + (size_t)cur.pm * tstepA; const char* cB = (const char*)g.Bt + (size_t)cur.pn * tstepB;
    PG8_STAGE(PG8_SB(0, 0), cB, voffB); PG8_STAGE(PG8_SA(0, 0), cA, voffA); PG8_STAGE(PG8_SB(0, 1), cB + hstepB, voffB); PG8_STAGE(PG8_SA(0, 1), cA + hstepA, voffA);
    if (wr == 1) PG8_BAR;
    PG8_WAIT_V(4); PG8_BAR;
    PG8_STAGE(PG8_SB(1, 0), cB + kstep, voffB); PG8_STAGE(PG8_SA(1, 0), cA + kstep, voffA); PG8_STAGE(PG8_SB(1, 1), cB + hstepB + kstep, voffB);
    PG8_WAIT_V(6); PG8_BAR;
    for (;;) {
        const bool has_next = S.next(ui + 1, nxt);
        const char* nA = has_next ? (const char*)g.A + (size_t)nxt.pm * tstepA : cA; const char* nB = has_next ? (const char*)g.Bt + (size_t)nxt.pn * tstepB : cB;
        for (int t = 0; t < nt; t += 2) {
            const bool last = (t == nt - 2);
            const char* a1 = cA + (size_t)(t + 1) * kstep;
            const char* a2 = last ? nA : cA + (size_t)(t + 2) * kstep; const char* b2 = last ? nB : cB + (size_t)(t + 2) * kstep;
            const char* a3 = a2 + kstep; const char* b3 = b2 + kstep;
            PG8_LDB(B0, 0, 0); PG8_SCHED; PG8_LDA(At, 0, 0); PG8_STAGE(PG8_SA(1, 1), a1 + hstepA, voffA);
            PG8_WAIT_L(8); PG8_BAR; PG8_WAIT_L(0); PG8_MMA(0, 0, At, B0); PG8_BAR; PG8_SCHED;
            PG8_LDB(B1, 0, 1); PG8_STAGE(PG8_SB(0, 0), b2, voffB);
            PG8_BAR; PG8_WAIT_L(0); PG8_MMA(0, 1, At, B1); PG8_BAR;
            PG8_LDA(At, 0, 1); PG8_STAGE(PG8_SA(0, 0), a2, voffA);
            PG8_BAR; PG8_WAIT_L(0); PG8_MMA(1, 0, At, B0); PG8_BAR; PG8_SCHED;
            PG8_STAGE(PG8_SB(0, 1), b2 + hstepB, voffB);
            PG8_WAIT_V(6); PG8_BAR; PG8_MMA(1, 1, At, B1); PG8_BAR;
            PG8_LDB(B0, 1, 0); PG8_SCHED; PG8_LDA(At, 1, 0); PG8_STAGE(PG8_SA(0, 1), a2 + hstepA, voffA);
            PG8_WAIT_L(8); PG8_BAR; PG8_WAIT_L(0); PG8_MMA(0, 0, At, B0); PG8_BAR; PG8_SCHED;
            PG8_LDB(B1, 1, 1); PG8_STAGE(PG8_SB(1, 0), b3, voffB);
            PG8_BAR; PG8_WAIT_L(0); PG8_MMA(0, 1, At, B1); PG8_BAR;
            PG8_LDA(At, 1, 1); PG8_STAGE(PG8_SA(1, 0), a3, voffA);
            PG8_BAR; PG8_WAIT_L(0); PG8_MMA(1, 0, At, B0); PG8_BAR; PG8_SCHED;
            PG8_STAGE(PG8_SB(1, 1), b3 + hstepB, voffB);
            PG8_WAIT_V(6); PG8_BAR; PG8_MMA(1, 1, At, B1); PG8_BAR;
        }
        if constexpr (!Epi::AFTER_DRAIN) E(acc, cur, wr, wc, fr, fq);
        if (!has_next) break;
#pragma unroll
        for (int a = 0; a < 2; ++a)
#pragma unroll
            for (int b = 0; b < 2; ++b)
#pragma unroll
                for (int m = 0; m < 4; ++m)
#pragma unroll
                    for (int n = 0; n < 2; ++n) acc[a][b][m][n] = (f32x4){0.f, 0.f, 0.f, 0.f};
        cur = nxt; cA = nA; cB = nB; ++ui;
    }
    PG8_WAIT_V(0);
    if (wr == 0) PG8_BAR;
    PG8_BAR;
    if constexpr (Epi::AFTER_DRAIN) E.fused(acc, cur, wr, wc, fr, fq, lds, wid, lane);
#undef PG8_SA
#undef PG8_SB
#undef PG8_STAGE
#undef PG8_LDA
#undef PG8_LDB
#undef PG8_MMA
#undef PG8_WAIT_V
#undef PG8_WAIT_L
#undef PG8_BAR
#undef PG8_SCHED
}
typedef f32x4 Acc[2][2][4][2];

__device__ __forceinline__ u32x4 pack8(const f32x4 v0, const f32x4 v1) { u32x4 w; w.x = pk2(v0[0], v0[1]); w.y = pk2(v0[2], v0[3]); w.z = pk2(v1[0], v1[1]); w.w = pk2(v1[2], v1[3]); return w; }

struct EpiZ {
    static constexpr bool PERM = true, AFTER_DRAIN = false;
    bf16_t* Z; bf16_t* Aall; bf16_t* SIG;
    __device__ __forceinline__ void operator()(const Acc& acc, const Unit& u, int wr, int wc, int fr, int fq) const {
#pragma unroll
        for (int ai = 0; ai < 2; ++ai)
#pragma unroll
            for (int m = 0; m < 4; ++m) {
                const int row = u.pm * BM + ai * HALF + wr * 64 + m * 16 + fr;
                int cr, s; if (row < NTL) { cr = (unsigned)row / S5C; s = (unsigned)row % S5C; } else { const unsigned rc = row - NTL; cr = S5LR + rc / S5C; s = rc % S5C; }
#pragma unroll
                for (int bj = 0; bj < 2; ++bj) {
                    const int col = u.pn * BM + bj * HALF + wc * 32 + 8 * fq;
                    const u32x4 w = pack8(acc[ai][bj][m][0], acc[ai][bj][m][1]);
                    if (col >= COL_GD && col < COL_U) { if (row < NTL) { f32x4 s0, s1;
#pragma unroll
                            for (int j = 0; j < 4; ++j) { s0[j] = sigmoidf_(acc[ai][bj][m][0][j]); s1[j] = sigmoidf_(acc[ai][bj][m][1][j]); }
                            *(u32x4*)(SIG + (size_t)row * 256 + (col - COL_GD)) = pack8(s0, s1); } }
                    else if (col < COL_U) *(u32x4*)(Z + (size_t)row * ZLD + col) = w;
                    else if (col < DIN) { const int g = (col - COL_U) >> 4, h0 = (col - COL_U) & 15; *(u32x4*)(Aall + ((size_t)(g * S5ROWS + cr)) * S5K1 + s * 16 + h0) = w; }
                }
            }
    }
};
struct EpiE {
    static constexpr bool PERM = false, AFTER_DRAIN = false;
    float* E;
    __device__ __forceinline__ void operator()(const Acc& acc, const Unit& u, int wr, int wc, int fr, int fq) const {
        const int g = u.pn;
#pragma unroll
        for (int ai = 0; ai < 2; ++ai)
#pragma unroll
            for (int m = 0; m < 4; ++m) {
                const int cr = (u.pm - g * S5NRT) * BM + ai * HALF + wr * 64 + m * 16 + fr;
                if (cr < S5EROWS) {
                    float* rowp = E + ((size_t)(g * S5EROWS + cr)) * 256 + wc * 32 + 4 * fq;
#pragma unroll
                    for (int bj = 0; bj < 2; ++bj)
#pragma unroll
                        for (int n = 0; n < 2; ++n) *(f32x4*)(rowp + bj * HALF + n * 16) = acc[ai][bj][m][n];
                }
            }
    }
};
struct EpiY {
    static constexpr bool PERM = true, AFTER_DRAIN = false;
    const bf16_t* Aall; const float* dskip; bf16_t* ZG;
    __device__ __forceinline__ void operator()(const Acc& acc, const Unit& u, int wr, int wc, int fr, int fq) const {
        const int g = u.pn / S5NCY, pnn = u.pn % S5NCY;
        const int h0 = (8 * fq) & 15;
        const f32x4 d0 = *(const f32x4*)(dskip + g * 16 + h0), d1 = *(const f32x4*)(dskip + g * 16 + h0 + 4);
        const int crb = (u.pm - g * S5NRT) * BM + wr * 64 + fr;
        const int nb0 = pnn * BM + wc * 32 + 8 * fq;
        u32x4 uu[2][4];
#pragma unroll
        for (int k = 0; k < 5; ++k) {
            if (k < 4) {
#pragma unroll
                for (int q = 0; q < 4; ++q) { const int ai = k >> 1, m = 2 * (k & 1) + (q >> 1), bj = q & 1;
                    uu[k & 1][q] = *(const u32x4*)(Aall + ((size_t)(g * S5ROWS + crb + ai * HALF + m * 16)) * S5K1 + nb0 + bj * HALF); }
            }
            if (k > 0) {
                const int kk = k - 1;
#pragma unroll
                for (int q = 0; q < 4; ++q) { const int ai = kk >> 1, m = 2 * (kk & 1) + (q >> 1), bj = q & 1;
                    const int cr = crb + ai * HALF + m * 16, t = (nb0 + bj * HALF) >> 4;
                    const int tok = cr * S5C + t;
                    const u32x4 w = uu[kk & 1][q];
                    f32x4 y0 = acc[ai][bj][m][0], y1 = acc[ai][bj][m][1];
                    y0[0] += d0[0] * bflo(w.x); y0[1] += d0[1] * bfhi(w.x); y0[2] += d0[2] * bflo(w.y); y0[3] += d0[3] * bfhi(w.y);
                    y1[0] += d1[0] * bflo(w.z); y1[1] += d1[1] * bfhi(w.z); y1[2] += d1[2] * bflo(w.w); y1[3] += d1[3] * bfhi(w.w);
#pragma unroll
                    for (int j = 0; j < 4; ++j) { y0[j] = gelu_tanh(y0[j]); y1[j] = gelu_tanh(y1[j]); }
                    *(u32x4*)(ZG + (size_t)tok * 512 + g * 16 + h0) = pack8(y0, y1);
                }
            }
        }
    }
};
struct EpiG {
    static constexpr bool PERM = true, AFTER_DRAIN = false;
    bf16_t* G;
    __device__ __forceinline__ void operator()(const Acc& acc, const Unit& u, int wr, int wc, int fr, int fq) const {
#pragma unroll
        for (int ai = 0; ai < 2; ++ai)
#pragma unroll
            for (int m = 0; m < 4; ++m) {
                const int row = u.pm * BM + ai * HALF + wr * 64 + m * 16 + fr;
#pragma unroll
                for (int bj = 0; bj < 2; ++bj) { const int col = u.pn * BM + bj * HALF + wc * 32 + 8 * fq; *(u32x4*)(G + (size_t)row * 512 + col) = pack8(acc[ai][bj][m][0], acc[ai][bj][m][1]); }
            }
    }
};
struct EpiGLU {
    static constexpr bool PERM = true, AFTER_DRAIN = false;
    const bf16_t* ZG; const float* bias; bf16_t* MIX;
    __device__ __forceinline__ void operator()(const Acc& acc, const Unit& u, int wr, int wc, int fr, int fq) const {
        const int colb = u.pn * BM + wc * 32 + 8 * fq, rowb = u.pm * BM + wr * 64 + fr;
        f32x4 bb[2][2];
#pragma unroll
        for (int bj = 0; bj < 2; ++bj) { bb[bj][0] = *(const f32x4*)(bias + colb + bj * HALF); bb[bj][1] = *(const f32x4*)(bias + colb + bj * HALF + 4); }
        u32x4 zq[2][4];
#pragma unroll
        for (int k = 0; k < 5; ++k) {
            if (k < 4) {
#pragma unroll
                for (int q = 0; q < 4; ++q) { const int ai = k >> 1, m = 2 * (k & 1) + (q >> 1), bj = q & 1;
                    zq[k & 1][q] = *(const u32x4*)(ZG + (size_t)(rowb + ai * HALF + m * 16) * 512 + colb + bj * HALF); }
            }
            if (k > 0) {
                const int kk = k - 1;
#pragma unroll
                for (int q = 0; q < 4; ++q) { const int ai = kk >> 1, m = 2 * (kk & 1) + (q >> 1), bj = q & 1;
                    const u32x4 zz = zq[kk & 1][q];
                    f32x4 y0 = acc[ai][bj][m][0] + bb[bj][0], y1 = acc[ai][bj][m][1] + bb[bj][1];
                    y0[0] = bflo(zz.x) * sigmoidf_(y0[0]); y0[1] = bfhi(zz.x) * sigmoidf_(y0[1]); y0[2] = bflo(zz.y) * sigmoidf_(y0[2]); y0[3] = bfhi(zz.y) * sigmoidf_(y0[3]);
                    y1[0] = bflo(zz.z) * sigmoidf_(y1[0]); y1[1] = bfhi(zz.z) * sigmoidf_(y1[1]); y1[2] = bflo(zz.w) * sigmoidf_(y1[2]); y1[3] = bfhi(zz.w) * sigmoidf_(y1[3]);
                    *(u32x4*)(MIX + (size_t)(rowb + ai * HALF + m * 16) * DM + 512 + colb + bj * HALF) = pack8(y0, y1);
                }
            }
        }
    }
};
struct EpiRes {
    static constexpr bool PERM = false, AFTER_DRAIN = false;
    const float* base; float* out; const float* gate;
    __device__ __forceinline__ void operator()(const Acc& acc, const Unit& u, int wr, int wc, int fr, int fq) const {
        const int b = u.pm >> 4;
        const int col0 = u.pn * BM + wc * 32 + 4 * fq;
        f32x4 gv[2][2];
#pragma unroll
        for (int bj = 0; bj < 2; ++bj)
#pragma unroll
            for (int n = 0; n < 2; ++n) gv[bj][n] = *(const f32x4*)(gate + (size_t)b * 6144 + col0 + bj * HALF + n * 16);
#pragma unroll
        for (int ai = 0; ai < 2; ++ai)
#pragma unroll
            for (int m = 0; m < 4; ++m) {
                const size_t off = (size_t)(u.pm * BM + ai * HALF + wr * 64 + m * 16 + fr) * DM + col0;
#pragma unroll
                for (int bj = 0; bj < 2; ++bj)
#pragma unroll
                    for (int n = 0; n < 2; ++n) { const f32x4 bs = *(const f32x4*)(base + off + bj * HALF + n * 16); *(f32x4*)(out + off + bj * HALF + n * 16) = bs + gv[bj][n] * acc[ai][bj][m][n]; }
            }
    }
};
struct EpiUp {
    static constexpr bool PERM = true, AFTER_DRAIN = false;
    bf16_t* ACT;
    __device__ __forceinline__ void operator()(const Acc& acc, const Unit& u, int wr, int wc, int fr, int fq) const {
#pragma unroll
        for (int ai = 0; ai < 2; ++ai)
#pragma unroll
            for (int m = 0; m < 4; ++m) {
                const int row = u.pm * BM + ai * HALF + wr * 64 + m * 16 + fr;
                const int col = u.pn * HALF + wc * 32 + 8 * fq;
                f32x4 y0, y1;
#pragma unroll
                for (int j = 0; j < 4; ++j) { y0[j] = siluf_(acc[ai][0][m][0][j]) * acc[ai][1][m][0][j]; y1[j] = siluf_(acc[ai][0][m][1][j]) * acc[ai][1][m][1][j]; }
                *(u32x4*)(ACT + (size_t)row * DFF + col) = pack8(y0, y1);
            }
    }
};
struct PanelSumsq {
    float* xbuf; unsigned* cnt;
    __device__ __forceinline__ void run(const Acc& v, const Unit& u, int wr, int wc, int fr, int fq, LAS unsigned char* lds, int wid, int lane) const {
        LAS float* P = (LAS float*)lds; LAS float* S = (LAS float*)(lds + 8192);
#pragma unroll
        for (int ai = 0; ai < 2; ++ai)
#pragma unroll
            for (int m = 0; m < 4; ++m) {
                float s = 0.f;
#pragma unroll
                for (int bj = 0; bj < 2; ++bj)
#pragma unroll
                    for (int n = 0; n < 2; ++n) { const f32x4 x = v[ai][bj][m][n]; s += (x[0] * x[0] + x[1] * x[1]) + (x[2] * x[2] + x[3] * x[3]); }
                s += __shfl_xor(s, 16); s += __shfl_xor(s, 32);
                if (fq == 0) P[(ai * HALF + wr * 64 + m * 16 + fr) * 4 + wc] = s;
            }
        asm volatile("s_waitcnt lgkmcnt(0)" ::: "memory"); __builtin_amdgcn_s_barrier(); asm volatile("" ::: "memory");
        const int row = wid * 32 + (lane & 31);
        if (lane < 32) { const f32x4 p = *(const LAS f32x4*)(P + row * 4);
            __hip_atomic_store(xbuf + ((size_t)(u.pm * BM + row)) * 4 + u.pn, (p[0] + p[1]) + (p[2] + p[3]), __ATOMIC_RELAXED, __HIP_MEMORY_SCOPE_AGENT); }
        asm volatile("s_waitcnt vmcnt(0)" ::: "memory");
        if (lane == 0) __hip_atomic_fetch_add(cnt + 64 * u.pm, 1u, __ATOMIC_RELAXED, __HIP_MEMORY_SCOPE_AGENT);
        if (wid == 0) {
            unsigned sp = 0;
            while ((unsigned)__builtin_amdgcn_readfirstlane(__hip_atomic_load(cnt + 64 * u.pm, __ATOMIC_RELAXED, __HIP_MEMORY_SCOPE_AGENT)) < 32u) { __builtin_amdgcn_s_sleep(2); if (++sp > (1u << 22)) break; }
            __builtin_amdgcn_fence(__ATOMIC_ACQUIRE, "agent");
        }
        asm volatile("s_waitcnt vmcnt(0) lgkmcnt(0)" ::: "memory"); __builtin_amdgcn_s_barrier(); asm volatile("" ::: "memory");
        if (lane < 32) { const float* slot = xbuf + ((size_t)(u.pm * BM + row)) * 4; float t = 0.f;
#pragma unroll
            for (int q = 0; q < 4; ++q) t += __hip_atomic_load(slot + q, __ATOMIC_RELAXED, __HIP_MEMORY_SCOPE_AGENT);
            S[row] = t; }
        asm volatile("s_waitcnt vmcnt(0) lgkmcnt(0)" ::: "memory"); __builtin_amdgcn_s_barrier(); asm volatile("" ::: "memory");
    }
};
struct EpiWoutNorm {
    static constexpr bool PERM = false, AFTER_DRAIN = true;
    const float* base; float* out; const float* mod; const float* g2; bf16_t* H2; PanelSumsq st;
    __device__ __forceinline__ void fused(Acc& acc, const Unit& u, int wr, int wc, int fr, int fq, LAS unsigned char* lds, int wid, int lane) const {
        const int b = u.pm >> 4, col0 = u.pn * BM + wc * 32 + 4 * fq;
        const float* mb = mod + (size_t)b * 6144;
        const size_t off0 = (size_t)(u.pm * BM + wr * 64 + fr) * DM + col0;
        {
            f32x4 gv[4];
#pragma unroll
            for (int c = 0; c < 4; ++c) gv[c] = *(const f32x4*)(mb + 2 * 1024 + col0 + (c >> 1) * HALF + (c & 1) * 16);
            f32x4 bs[2][8];
#pragma unroll
            for (int k = 0; k < 5; ++k) {
                if (k < 4) {
#pragma unroll
                    for (int q = 0; q < 8; ++q) { const int ai = k >> 1, m = 2 * (k & 1) + (q >> 2), c = q & 3;
                        bs[k & 1][q] = *(const f32x4*)(base + off0 + (size_t)(ai * HALF + m * 16) * DM + (c >> 1) * HALF + (c & 1) * 16); }
                }
                if (k > 0) {
                    const int kk = k - 1;
#pragma unroll
                    for (int q = 0; q < 8; ++q) { const int ai = kk >> 1, m = 2 * (kk & 1) + (q >> 2), c = q & 3;
                        const f32x4 x1 = bs[kk & 1][q] + gv[c] * acc[ai][c >> 1][m][c & 1]; acc[ai][c >> 1][m][c & 1] = x1;
                        *(f32x4*)(out + off0 + (size_t)(ai * HALF + m * 16) * DM + (c >> 1) * HALF + (c & 1) * 16) = x1; }
                }
            }
        }
        st.run(acc, u, wr, wc, fr, fq, lds, wid, lane);
        const LAS float* S = (const LAS float*)(lds + 8192);
        f32x4 ca[4], sh[4];
#pragma unroll
        for (int c = 0; c < 4; ++c) { const int co = (c >> 1) * HALF + (c & 1) * 16;
            const f32x4 gg = *(const f32x4*)(g2 + col0 + co), sc = *(const f32x4*)(mb + 4 * 1024 + col0 + co); sh[c] = *(const f32x4*)(mb + 3 * 1024 + col0 + co); ca[c] = gg * (sc + 1.0f); }
#pragma unroll
        for (int ai = 0; ai < 2; ++ai)
#pragma unroll
            for (int m = 0; m < 4; ++m) { const int r = ai * HALF + wr * 64 + m * 16 + fr; const float rstd = 1.0f / sqrtf(S[r] * (1.f / DM) + 1e-6f);
#pragma unroll
                for (int c = 0; c < 4; ++c) {
                    const f32x4 y = acc[ai][c >> 1][m][c & 1] * rstd * ca[c] + sh[c];
                    u32x2 w; w.x = pk2(y[0], y[1]); w.y = pk2(y[2], y[3]); *(u32x2*)(H2 + off0 + (size_t)(ai * HALF + m * 16) * DM + (c >> 1) * HALF + (c & 1) * 16) = w; }
            }
    }
};
struct EpiDownNorm {
    static constexpr bool PERM = false, AFTER_DRAIN = true;
    float* out; const float* mod; const float* fg; PanelSumsq st;
    __device__ __forceinline__ void fused(Acc& acc, const Unit& u, int wr, int wc, int fr, int fq, LAS unsigned char* lds, int wid, int lane) const {
        const int b = u.pm >> 4, col0 = u.pn * BM + wc * 32 + 4 * fq;
        const float* mb = mod + (size_t)b * 6144;
        const size_t off0 = (size_t)(u.pm * BM + wr * 64 + fr) * DM + col0;
        {
            f32x4 gv[4];
#pragma unroll
            for (int c = 0; c < 4; ++c) gv[c] = *(const f32x4*)(mb + 5 * 1024 + col0 + (c >> 1) * HALF + (c & 1) * 16);
            f32x4 bs[2][8];
#pragma unroll
            for (int k = 0; k < 5; ++k) {
                if (k < 4) {
#pragma unroll
                    for (int q = 0; q < 8; ++q) { const int ai = k >> 1, m = 2 * (k & 1) + (q >> 2), c = q & 3;
                        bs[k & 1][q] = *(const f32x4*)(out + off0 + (size_t)(ai * HALF + m * 16) * DM + (c >> 1) * HALF + (c & 1) * 16); }
                }
                if (k > 0) {
                    const int kk = k - 1, ai = kk >> 1, m0 = 2 * (kk & 1);
#pragma unroll
                    for (int q = 0; q < 8; ++q) { const int m = m0 + (q >> 2), c = q & 3;
                        acc[ai][c >> 1][m][c & 1] = bs[kk & 1][q] + gv[c] * acc[ai][c >> 1][m][c & 1]; }
                    asm volatile("" : "+v"(acc[ai][0][m0][0]), "+v"(acc[ai][0][m0][1]), "+v"(acc[ai][1][m0][0]), "+v"(acc[ai][1][m0][1]),
                                      "+v"(acc[ai][0][m0 + 1][0]), "+v"(acc[ai][0][m0 + 1][1]), "+v"(acc[ai][1][m0 + 1][0]), "+v"(acc[ai][1][m0 + 1][1]) : : "memory");
                }
            }
        }
        st.run(acc, u, wr, wc, fr, fq, lds, wid, lane);
        const LAS float* S = (const LAS float*)(lds + 8192);
        f32x4 fgv[4];
#pragma unroll
        for (int c = 0; c < 4; ++c) fgv[c] = *(const f32x4*)(fg + col0 + (c >> 1) * HALF + (c & 1) * 16);
#pragma unroll
        for (int ai = 0; ai < 2; ++ai)
#pragma unroll
            for (int m = 0; m < 4; ++m) { const int r = ai * HALF + wr * 64 + m * 16 + fr; const float rstd = 1.0f / sqrtf(S[r] * (1.f / DM) + 1e-6f);
#pragma unroll
                for (int c = 0; c < 4; ++c) *(f32x4*)(out + off0 + (size_t)(ai * HALF + m * 16) * DM + (c >> 1) * HALF + (c & 1) * 16) = acc[ai][c >> 1][m][c & 1] * rstd * fgv[c];
            }
    }
};
}


__device__ __forceinline__ void transpose_item(const float* W, int K, int N, bf16_t* WT, int ldt, int k0, int n0, int drow0, LAS float* scr, int lane) {
#pragma unroll 8
    for (int i = 0; i < 32; ++i) { const int kk = 2 * i + (lane >> 5); scr[kk * 33 + (lane & 31)] = W[(size_t)(k0 + kk) * N + n0 + (lane & 31)]; }
    asm volatile("s_waitcnt lgkmcnt(0)" ::: "memory");
    const int c = lane & 7;
#pragma unroll
    for (int j = 0; j < 4; ++j) { const int n = (lane >> 3) + 8 * j; const LAS float* s = scr + (8 * c) * 33 + n;
        u32x4 o; o.x = pk2(s[0 * 33], s[1 * 33]); o.y = pk2(s[2 * 33], s[3 * 33]); o.z = pk2(s[4 * 33], s[5 * 33]); o.w = pk2(s[6 * 33], s[7 * 33]);
        *(u32x4*)(WT + (size_t)(drow0 + n) * ldt + k0 + 8 * c) = o; }
    asm volatile("s_waitcnt lgkmcnt(0)" ::: "memory");
}

__device__ __forceinline__ void p0_weights(const Args& a, LAS unsigned char* lds, int bid, int nb, int part) {
    const int tid = opaque_tid(), lane = tid & 63, wave = tid >> 6;
    LAS float* scr = (LAS float*)(lds + wave * 8704);
    bf16_t* WTIN = (bf16_t*)(a.ws + WS_WTIN); bf16_t* WTOUT = (bf16_t*)(a.ws + WS_WTOUT); bf16_t* WT13 = (bf16_t*)(a.ws + WS_WT13);
    bf16_t* WT2 = (bf16_t*)(a.ws + WS_WT2); bf16_t* WTGLU = (bf16_t*)(a.ws + WS_WTGLU);
    constexpr int I_IN = 16 * 71, I_OUT = 16 * 32, I_1 = 16 * 88, I_2 = 44 * 32, I_GLU = 8 * 16;
    constexpr int NIT = I_IN + I_OUT + 2 * I_1 + I_2 + I_GLU;
    const int gw = bid * 8 + wave, NGW = nb * 8;
    for (int it = (part ? I_IN : 0) + gw; it < (part ? NIT : I_IN); it += NGW) {
        int r = it;
        if (r < I_IN) { const int kb = r / 71, nbk = r % 71; transpose_item(a.in[8], 1024, DIN, WTIN, 1024, kb * 64, nbk * 32, nbk * 32, scr, lane); continue; } r -= I_IN;
        if (r < I_OUT) { const int kb = r / 32, nbk = r % 32; transpose_item(a.in[9], 1024, 1024, WTOUT, 1024, kb * 64, nbk * 32, nbk * 32, scr, lane); continue; } r -= I_OUT;
        if (r < 2 * I_1) { const int sel = r / I_1; r -= sel * I_1; const int kb = r / 88, nbk = r % 88, n0 = nbk * 32;
            transpose_item(a.in[sel ? 32 : 31], 1024, DFF, WT13, 1024, kb * 64, n0, (n0 >> 7) * 256 + (n0 & 127) + sel * 128, scr, lane); continue; } r -= 2 * I_1;
        if (r < I_2) { const int kb = r / 32, nbk = r % 32; transpose_item(a.in[33], DFF, 1024, WT2, DFF, kb * 64, nbk * 32, nbk * 32, scr, lane); continue; } r -= I_2;
        { const int kb = r / 16, nbk = r % 16; transpose_item(a.in[29], 512, 512, WTGLU, 512, kb * 64, nbk * 32, nbk * 32, scr, lane); }
    }
    if (part) return;
    bf16_t* W2T = (bf16_t*)(a.ws + WS_W2T);
    for (int i = bid * NTHREADS + tid; i < 2 * 2 * 512 * 32; i += nb * NTHREADS) { const int j = i & 31, c = (i >> 5) & 511, d = (i >> 14) & 1, which = i >> 15; W2T[i] = (bf16_t)f2bf(a.in[which ? 14 : 12][(d * 32 + j) * 512 + c]); }
    bf16_t* G2T = (bf16_t*)(a.ws + WS_G2T); bf16_t* SIG = (bf16_t*)(a.ws + WS_SIG);
    for (int i = bid * NTHREADS + tid; i < 512 * 256; i += nb * NTHREADS) { const int n = i >> 8, k = i & 255; G2T[i] = k < 96 ? (bf16_t)f2bf(a.in[15][k * 512 + n]) : (bf16_t)0; }
    for (int i = bid * NTHREADS + tid; i < NTL * 20; i += nb * NTHREADS) { const int row = i / 20, q = i % 20; *(u32x4*)(SIG + (size_t)row * 256 + 96 + q * 8) = (u32x4){0u, 0u, 0u, 0u}; }
}

__device__ __forceinline__ void p0_mod(const Args& a, LAS unsigned char* lds, int bid, int nb) {
    const int tid = opaque_tid();
    LAS float* sc = (LAS float*)lds;
    LAS float* red = sc + 5 * 1024;
    float* MOD = (float*)(a.ws + WS_MOD);
    bool filled = false;
    for (int cb = bid; cb < 192; cb += nb) {
        if (!filled) {
            for (int i = tid; i < 5 * 1024; i += NTHREADS) { const float v = (i < 4096) ? a.in[1][i] : a.in[3][i - 4096]; sc[i] = siluf_(v); }
            filled = true; __syncthreads();
        }
        const int col = cb * 32 + (tid & 31), kp = tid >> 5;
        float acc[5] = {0.f, 0.f, 0.f, 0.f, 0.f};
        const float* wp = a.in[4] + (size_t)(kp * 64) * 6144 + col;
#pragma unroll
        for (int k0 = 0; k0 < 64; k0 += 32) {
            float w[32];
#pragma unroll
            for (int k = 0; k < 32; ++k) w[k] = wp[(size_t)(k0 + k) * 6144];
#pragma unroll
            for (int k = 0; k < 32; ++k)
#pragma unroll
                for (int r = 0; r < 5; ++r) acc[r] += sc[r * 1024 + kp * 64 + k0 + k] * w[k]; }
#pragma unroll
        for (int r = 0; r < 5; ++r) red[(kp * 5 + r) * 32 + (tid & 31)] = acc[r];
        __syncthreads();
        if (tid < 160) { const int r = tid >> 5, c = tid & 31; float s = 0.f;
#pragma unroll
            for (int k = 0; k < 16; ++k) s += red[(k * 5 + r) * 32 + c];
            __hip_atomic_store(MOD + r * 6144 + cb * 32 + c, s + a.in[5][cb * 32 + c], __ATOMIC_RELAXED, __HIP_MEMORY_SCOPE_AGENT); }
        asm volatile("s_waitcnt vmcnt(0)" ::: "memory");
        __syncthreads();
        if (tid == 0) __hip_atomic_fetch_add((unsigned*)(a.ws + WS_CTL + 49152), 1u, __ATOMIC_RELAXED, __HIP_MEMORY_SCOPE_AGENT);
    }
}
__device__ __forceinline__ void mod_wait(const Args& a) {
    if (opaque_tid() < 64) { unsigned sp = 0;
        while ((unsigned)__builtin_amdgcn_readfirstlane(__hip_atomic_load((unsigned*)(a.ws + WS_CTL + 49152), __ATOMIC_RELAXED, __HIP_MEMORY_SCOPE_AGENT)) < 192u) { __builtin_amdgcn_s_sleep(2); if (++sp > (1u << 22)) break; }
        __builtin_amdgcn_fence(__ATOMIC_ACQUIRE, "agent"); asm volatile("s_waitcnt vmcnt(0)" ::: "memory"); }
    __syncthreads();
}

__device__ __forceinline__ void p0_s5(const Args& a, LAS unsigned char* lds, int bid, int nb) {
    const int tid = opaque_tid();
    constexpr int PWN = S5C + 1;
    LAS float* pw  = (LAS float*)lds;
    LAS float* bb  = pw + 2 * PWN * 64 * 2;
    LAS float* cc  = bb + 2 * 64 * 16 * 2;
    LAS float* qq  = cc + 16 * 64 * 2;
    bf16_t* BT1 = (bf16_t*)(a.ws + WS_BT1); bf16_t* BT2 = (bf16_t*)(a.ws + WS_BT2); float* TAB = (float*)(a.ws + WS_S5TAB); float* KT = (float*)(a.ws + WS_KT);
    const float* lam_re = a.in[21]; const float* lam_im = a.in[22]; const float* log_step = a.in[23];
    const float* b_re = a.in[24]; const float* b_im = a.in[25]; const float* c_re = a.in[26]; const float* c_im = a.in[27];
    for (int item = bid; item < 256; item += nb) {
        const int g = item >> 3, part = item & 7;
        __syncthreads();
        if (tid < 128) {
            const int p = tid & 63, d = tid >> 6;
            const float step = expf(log_step[d * 32 + g]);
            const float lr = lam_re[(d * 32 + g) * 64 + p], li = lam_im[(d * 32 + g) * 64 + p];
            const float mag = expf(lr * step); float sn, cs; sincosf(li * step, &sn, &cs);
            const float lbr = mag * cs, lbi = mag * sn, den = lr * lr + li * li, nr = lbr - 1.f;
            qq[tid * 2] = (nr * lr + lbi * li) / den; qq[tid * 2 + 1] = (lbi * lr - nr * li) / den;
            float pr = 1.f, pi = 0.f;
#pragma unroll 1
            for (int n = 0; n <= S5C; ++n) { pw[((d * PWN + n) * 64 + p) * 2] = pr; pw[((d * PWN + n) * 64 + p) * 2 + 1] = pi; const float t = pr * lbr - pi * lbi; pi = pr * lbi + pi * lbr; pr = t; }
        }
        __syncthreads();
        for (int i = tid; i < 2 * 64 * 16; i += NTHREADS) {
            const int h = i & 15, p = (i >> 4) & 63, d = i >> 10;
            const float qr = qq[(d * 64 + p) * 2], qi = qq[(d * 64 + p) * 2 + 1];
            const float br = b_re[(g * 64 + p) * 16 + h], bi = b_im[(g * 64 + p) * 16 + h];
            bb[i * 2] = qr * br - qi * bi; bb[i * 2 + 1] = qr * bi + qi * br;
        }
        for (int i = tid; i < 16 * 64; i += NTHREADS) { cc[i * 2] = c_re[g * 1024 + i]; cc[i * 2 + 1] = c_im[g * 1024 + i]; }
        __syncthreads();
        if (part == 0 && tid < 128) { const int d = tid >> 6, p = tid & 63; TAB[((d * 32 + g) * 64 + p) * 2] = pw[((d * PWN + S5C) * 64 + p) * 2]; TAB[((d * 32 + g) * 64 + p) * 2 + 1] = pw[((d * PWN + S5C) * 64 + p) * 2 + 1]; }
        {
            constexpr int PP = S5C / 4, HQN = 32 / PP, NV = 16 / HQN;
            const int hq = tid % HQN, h = (tid / HQN) & 15, q = part * PP + tid / (HQN * 16), d = q / S5C, tau = q % S5C;
            float s[NV];
#pragma unroll
            for (int v = 0; v < NV; ++v) s[v] = 0.f;
#pragma unroll 4
            for (int p = 0; p < 64; ++p) {
                const f32x2 c2 = *(LAS f32x2*)(cc + (h * 64 + p) * 2), p2 = *(LAS f32x2*)(pw + ((d * PWN + tau) * 64 + p) * 2);
                const float xr = c2.x * p2.x - c2.y * p2.y, xi = c2.x * p2.y + c2.y * p2.x;
#pragma unroll
                for (int v = 0; v < NV; v += 2) {
                    const f32x4 b0 = *(LAS f32x4*)(bb + ((d * 64 + p) * 16 + NV * hq + v) * 2);
                    s[v] += xr * b0[0] - xi * b0[1]; s[v + 1] += xr * b0[2] - xi * b0[3];
                }
            }
#pragma unroll
            for (int v = 0; v < NV; v += 2) { f32x2 o; o.x = s[v]; o.y = s[v + 1]; *(f32x2*)(KT + ((size_t)(g * 2 * S5C + q) * 16 + h) * 16 + NV * hq + v) = o; }
        }
        constexpr int RPP = S5U / 8;
        for (int i = tid; i < RPP * 128; i += NTHREADS) {
            const int rl = i >> 7, kp = (i & 127) * 2;
            const int n = part * RPP + rl, t = n >> 4, h = n & 15;
            const int d = kp >> 7, p = (kp >> 1) & 63;
            const int np = d ? (S5C - t) : (t + 1);
            const float ar = pw[((d * PWN + np) * 64 + p) * 2], ai = pw[((d * PWN + np) * 64 + p) * 2 + 1];
            const float cr = cc[(h * 64 + p) * 2], ci = cc[(h * 64 + p) * 2 + 1];
            *(unsigned*)(BT1 + ((size_t)(g * S5U + n)) * S5K1 + S5U + kp) = pk2(cr * ar - ci * ai, -cr * ai - ci * ar);
        }
        for (int i = tid; i < 32 * (S5U / 2); i += NTHREADS) {
            const int rl = i / (S5U / 2), kp = (i % (S5U / 2)) * 2;
            const int n = part * 32 + rl, d = n >> 7, p = (n >> 1) & 63, ri = n & 1;
            float v[2];
#pragma unroll
            for (int e = 0; e < 2; ++e) {
                const int k = kp + e, s = k >> 4, hp = k & 15;
                const int np = d ? s : (S5C - 1 - s);
                const float ar = pw[((d * PWN + np) * 64 + p) * 2], ai = pw[((d * PWN + np) * 64 + p) * 2 + 1];
                const float br = bb[((d * 64 + p) * 16 + hp) * 2], bi = bb[((d * 64 + p) * 16 + hp) * 2 + 1];
                v[e] = ri ? (ar * bi + ai * br) : (ar * br - ai * bi);
            }
            *(unsigned*)(BT2 + ((size_t)(g * 256 + n)) * S5U + kp) = pk2(v[0], v[1]);
        }
    }
    __syncthreads();
}
__device__ __forceinline__ void p1_s5(const Args& a, LAS unsigned char* lds, int bid, int nb) {
    const int tid = opaque_tid();
    LAS float* kt = (LAS float*)lds;
    bf16_t* BT1 = (bf16_t*)(a.ws + WS_BT1); const float* KT = (const float*)(a.ws + WS_KT);
    constexpr int RPP = S5U / 8;
    for (int item = bid; item < 256; item += nb) {
        const int g = item >> 3, part = item & 7;
        __syncthreads();
        for (int i = tid; i < 2 * S5C * 64; i += NTHREADS) *(LAS f32x4*)(kt + 4 * i) = *(const f32x4*)(KT + (size_t)g * (2 * S5C * 256) + 4 * i);
        __syncthreads();
        for (int i = tid; i < RPP * (S5U / 2); i += NTHREADS) {
            const int rl = i / (S5U / 2), kp = (i % (S5U / 2)) * 2;
            const int n = part * RPP + rl, t = n >> 4, h = n & 15, s = kp >> 4, hp = kp & 15;
            const int dd = s > t ? 1 : 0, tau = s > t ? s - t : t - s;
            const f32x2 q = *(const LAS f32x2*)(kt + ((dd * S5C + tau) * 16 + h) * 16 + hp), q1 = *(const LAS f32x2*)(kt + ((S5C * 16 + h) * 16) + hp);
            const float dg = (s == t) ? 1.0f : 0.0f;
            *(unsigned*)(BT1 + ((size_t)(g * S5U + n)) * S5K1 + kp) = pk2(q.x + dg * q1.x, q.y + dg * q1.y);
        }
    }
    __syncthreads();
}

struct RowV { f32x4 v[4]; };
__device__ __forceinline__ RowV row_load(const float* xrow, int lane) { RowV r; const f32x4* xr = (const f32x4*)xrow + lane;
#pragma unroll
    for (int j = 0; j < 4; ++j) r.v[j] = xr[64 * j];
    return r; }
__device__ __forceinline__ float row_rstd(const RowV& r) { float s = 0.f;
#pragma unroll
    for (int j = 0; j < 4; ++j) s += (r.v[j].x * r.v[j].x + r.v[j].y * r.v[j].y) + (r.v[j].z * r.v[j].z + r.v[j].w * r.v[j].w);
    return 1.0f / sqrtf(wave_sum(s) * (1.f / DM) + 1e-6f); }
struct ModV { f32x4 sh[4], sc[4]; };
__device__ __forceinline__ ModV mod_load(const float* shift, const float* scale, int lane) { ModV m;
#pragma unroll
    for (int j = 0; j < 4; ++j) { m.sh[j] = ((const f32x4*)shift)[lane + 64 * j]; m.sc[j] = ((const f32x4*)scale)[lane + 64 * j]; }
    return m; }
__device__ __forceinline__ void norm_mod_store(const RowV& r, const f32x4* gg, const ModV& m, bf16_t* orow, int lane) {
    const float rstd = row_rstd(r);
    u32x2* o8 = (u32x2*)orow + lane;
#pragma unroll
    for (int j = 0; j < 4; ++j) {
        const f32x4 y = r.v[j] * rstd * gg[j] * (m.sc[j] + 1.0f) + m.sh[j];
        u32x2 w; w.x = pk2(y.x, y.y); w.y = pk2(y.z, y.w); o8[64 * j] = w;
    }
}

__device__ __forceinline__ void p_s5_carry(const Args& a, int bid, int nb) {
    const float* E = (const float*)(a.ws + WS_E); const float* TAB = (const float*)(a.ws + WS_S5TAB); bf16_t* Aall = (bf16_t*)(a.ws + WS_AALL);
    constexpr int SL = S5NCH / 8;
    for (int gi = bid * NTHREADS + opaque_tid(); gi < BATCH * 32 * 2 * 64 * 8; gi += nb * NTHREADS) {
        const int seg = gi & 7, p = (gi >> 3) & 63, d = (gi >> 9) & 1, g = (gi >> 10) & 31, b = gi >> 15;
        const float lr = TAB[((d * 32 + g) * 64 + p) * 2], li = TAB[((d * 32 + g) * 64 + p) * 2 + 1];
        const size_t ecol = (size_t)d * 128 + p * 2;
        float hr = 0.f, hi = 0.f;
        f32x2 e[SL];
#pragma unroll
        for (int j = 0; j < SL; ++j) { const int jj = seg * SL + j, cc = d ? S5NCH - 1 - jj : jj; e[j] = *(const f32x2*)(E + ((size_t)(g * S5EROWS + b * S5NCH + cc)) * 256 + ecol); }
        {
            f32x2 ex[S5NCX];
#pragma unroll
            for (int c = 0; c < S5NCX; ++c) { const int cc = d ? S5NCX - 1 - c : c; ex[c] = *(const f32x2*)(E + ((size_t)(g * S5EROWS + S5LR + b * S5NCX + cc)) * 256 + ecol); }
#pragma unroll
            for (int c = 0; c < S5NCX; ++c) { const float nr = lr * hr - li * hi + ex[c].x, ni = lr * hi + li * hr + ex[c].y; hr = nr; hi = ni; }
            if (seg) { hr = 0.f; hi = 0.f; }
        }
        const float h0r = hr, h0i = hi;
#pragma unroll
        for (int j = 0; j < SL; ++j) { const float nr = lr * hr - li * hi + e[j].x, ni = lr * hi + li * hr + e[j].y; hr = nr; hi = ni; }
        float ar = lr, ai = li;
#pragma unroll
        for (int q = 1; q < SL; q <<= 1) { const float nr = ar * ar - ai * ai, ni = 2.f * ar * ai; ar = nr; ai = ni; }
        float fr = hr, fi = hi;
#pragma unroll
        for (int st = 1; st < 8; ++st) {
            const float pr = __shfl_up(fr, 1, 8), pi = __shfl_up(fi, 1, 8);
            if (seg == st) { fr = ar * pr - ai * pi + hr; fi = ar * pi + ai * pr + hi; }
        }
        const float cr_ = __shfl_up(fr, 1, 8), ci_ = __shfl_up(fi, 1, 8);
        hr = seg ? cr_ : h0r; hi = seg ? ci_ : h0i;
#pragma unroll
        for (int j = 0; j < SL; ++j) { const int jj = seg * SL + j, cc = d ? S5NCH - 1 - jj : jj;
            *(unsigned*)(Aall + ((size_t)(g * S5ROWS + b * S5NCH + cc)) * S5K1 + S5U + ecol) = pk2(hr, hi);
            const float nr = lr * hr - li * hi + e[j].x, ni = lr * hi + li * hr + e[j].y; hr = nr; hi = ni; }
    }
}

constexpr int RC = 64, RNCH = (CTXL + SEQ) / RC, RSTG0 = 32, RSTG1 = RNCH - RSTG0, RSTGM = RSTG1, RJOBS = 64 * RSTGM;
constexpr size_t WS_RACT = WS_AALL;
constexpr size_t WS_RRPT = WS_RACT + (size_t)RJOBS * 8192;
constexpr size_t WS_RSL  = WS_RRPT + (size_t)RJOBS * 8192;
constexpr size_t WS_RYL  = WS_RSL + (size_t)RJOBS * 8192;
constexpr size_t WS_RST  = WS_RYL + (size_t)RJOBS * 8192;
static_assert(WS_RST + (size_t)256 * 64 * 16 * 4 <= WS_S5END, "rwkv staging must fit the S5 region");
constexpr size_t WS_YOUT = WS_HMOD;
constexpr size_t WS_MIX  = WS_AALL;
static_assert((size_t)2 * NTL * 512 * 2 <= (size_t)NTOK * DM * 2, "YOUT fits HMOD region");

#define LSYNC() do { __syncthreads(); if ((PROBE_RPT >> 19) & 1) { __syncthreads(); __syncthreads(); __syncthreads(); } } while (0)
constexpr int SLB = 64 * 72 * 2;
typedef float f32x16 __attribute__((ext_vector_type(16)));
#define RSLOT(i) (lds + (i) * SLB)

__device__ __forceinline__ f32x16 tile_mm(const LAS unsigned char* Aop, const LAS unsigned char* Bop, int m0, int n0, f32x16 acc, int lane) {
    const int r = lane & 31, h = lane >> 5;
    const LAS unsigned char* ap = Aop + (m0 + r) * 144 + h * 16;
    const LAS unsigned char* bp = Bop + (n0 + r) * 144 + h * 16;
#pragma unroll
    for (int ks = 0; ks < 4; ++ks) {
        const bf16x8 av = *(const LAS bf16x8*)(ap + ks * 32), bv = *(const LAS bf16x8*)(bp + ks * 32);
        acc = __builtin_amdgcn_mfma_f32_32x32x16_bf16(av, bv, acc, 0, 0, 0);
    }
    return acc;
}
__device__ __forceinline__ f32x16 zero16() { f32x16 z;
#pragma unroll
    for (int i = 0; i < 16; ++i) z[i] = 0.f; return z; }
__device__ __forceinline__ void store_cr(LAS unsigned char* X, const f32x16& acc, int m0, int n0, int lane) {
    LAS unsigned char* p = X + (n0 + (lane & 31)) * 144 + (m0 + 4 * (lane >> 5)) * 2;
#pragma unroll
    for (int g = 0; g < 4; ++g) { u32x2 w; w.x = pk2(acc[4 * g], acc[4 * g + 1]); w.y = pk2(acc[4 * g + 2], acc[4 * g + 3]); *(LAS u32x2*)(p + g * 16) = w; }
}
__device__ __forceinline__ void store_rc(LAS unsigned char* X, const f32x16& acc, int m0, int n0, int lane, bool ident) {
    const int c = n0 + (lane & 31), h = lane >> 5;
#pragma unroll
    for (int r = 0; r < 16; ++r) { const int row = m0 + (r & 3) + 8 * (r >> 2) + 4 * h; float v = acc[r]; if (ident && row == c) v += 1.0f;
        *(LAS bf16_t*)(X + row * 144 + c * 2) = (bf16_t)f2bf(v); }
}
__device__ __forceinline__ f32x16 init_cr(const LAS unsigned char* X, int m0, int n0, int lane) {
    const LAS unsigned char* p = X + (n0 + (lane & 31)) * 144 + (m0 + 4 * (lane >> 5)) * 2;
    f32x16 acc;
#pragma unroll
    for (int g = 0; g < 4; ++g) { const u32x2 w = *(const LAS u32x2*)(p + g * 16); acc[4 * g] = bflo(w.x); acc[4 * g + 1] = bfhi(w.x); acc[4 * g + 2] = bflo(w.y); acc[4 * g + 3] = bfhi(w.y); }
    return acc;
}
__device__ __forceinline__ void mask_ge(f32x16& acc, int m0, int n0, int lane, int dmin) {
    const int c = n0 + (lane & 31), h = lane >> 5;
#pragma unroll
    for (int r = 0; r < 16; ++r) { const int row = m0 + (r & 3) + 8 * (r >> 2) + 4 * h; if (c - row < dmin) acc[r] = 0.f; }
}
__device__ __forceinline__ void store_g_perm(bf16_t* OUT, const f32x16& acc, int m0, int n0, int lane) {
    const int h = lane >> 5; bf16_t* rowp = OUT + (size_t)(n0 + (lane & 31)) * 64 + m0;
#pragma unroll
    for (int g4 = 0; g4 < 4; ++g4) { u32x2 w; w.x = pk2(acc[4 * g4], acc[4 * g4 + 1]); w.y = pk2(acc[4 * g4 + 2], acc[4 * g4 + 3]);
        *(u32x2*)(rowp + 8 * (2 * (g4 & 1) + h) + 4 * (g4 >> 1)) = w; }
}
__device__ __forceinline__ void store_g_cr(bf16_t* OUT, const f32x16& acc, int m0, int n0, int lane) {
    bf16_t* rowp = OUT + (size_t)(n0 + (lane & 31)) * 64 + m0 + 4 * (lane >> 5);
#pragma unroll
    for (int g = 0; g < 4; ++g) { u32x2 w; w.x = pk2(acc[4 * g], acc[4 * g + 1]); w.y = pk2(acc[4 * g + 2], acc[4 * g + 3]); *(u32x2*)(rowp + 8 * g) = w; }
}

typedef short s16x4 __attribute__((ext_vector_type(4)));
__device__ __forceinline__ bf16x8 frag_t(const LAS unsigned char* img, int m0, int ks, int lane) {
    const LAS unsigned char* a0 = img + (16 * ks + 8 * (lane >> 5) + ((lane & 15) >> 2)) * 144 + (m0 + 16 * ((lane >> 4) & 1) + 4 * (lane & 3)) * 2;
    const s16x4 lo = __builtin_amdgcn_ds_read_tr16_b64_v4i16((LAS s16x4*)a0), hi = __builtin_amdgcn_ds_read_tr16_b64_v4i16((LAS s16x4*)(a0 + 4 * 144));
    return (bf16x8){lo[0], lo[1], lo[2], lo[3], hi[0], hi[1], hi[2], hi[3]};
}
__device__ __forceinline__ bf16x8 frag_n(const LAS unsigned char* img, int m0, int ks, int lane) { return *(const LAS bf16x8*)(img + (m0 + (lane & 31)) * 144 + (lane >> 5) * 16 + ks * 32); }
template <bool TA, bool TB>
__device__ __forceinline__ f32x16 tile_mmx(const LAS unsigned char* Aimg, const LAS unsigned char* Bimg, int m0, int n0, int ks0, int ks1, f32x16 acc, int lane) {
    (void)ks0; (void)ks1;
    bf16x8 av[4], bv[4];
#pragma unroll
    for (int ks = 0; ks < 4; ++ks) { av[ks] = TA ? frag_t(Aimg, m0, ks, lane) : frag_n(Aimg, m0, ks, lane); bv[ks] = TB ? frag_t(Bimg, n0, ks, lane) : frag_n(Bimg, n0, ks, lane); }
#pragma unroll
    for (int ks = 0; ks < 4; ++ks) acc = __builtin_amdgcn_mfma_f32_32x32x16_bf16(av[ks], bv[ks], acc, 0, 0, 0);
    return acc;
}
__device__ __forceinline__ f32x16 init_rc(const LAS unsigned char* X, int m0, int n0, int lane) {
    const LAS unsigned char* a0 = X + (m0 + 4 * (lane >> 5) + ((lane & 15) >> 2)) * 144 + (n0 + 16 * ((lane >> 4) & 1) + 4 * (lane & 3)) * 2;
    f32x16 acc;
#pragma unroll
    for (int g = 0; g < 4; ++g) { const s16x4 w = __builtin_amdgcn_ds_read_tr16_b64_v4i16((LAS s16x4*)(a0 + g * 8 * 144));
#pragma unroll
        for (int e = 0; e < 4; ++e) acc[4 * g + e] = __builtin_bit_cast(float, ((unsigned)(unsigned short)w[e]) << 16); }
    return acc;
}
__device__ __forceinline__ void mask_tri(f32x16& acc, int m0, int n0, int lane, int sgn, int dmin, bool ident) {
    const int c = n0 + (lane & 31), h = lane >> 5;
#pragma unroll
    for (int r = 0; r < 16; ++r) { const int row = m0 + (r & 3) + 8 * (r >> 2) + 4 * h; if ((c - row) * sgn < dmin) acc[r] = 0.f; if (ident && row == c) acc[r] += 1.0f; }
}

__device__ __forceinline__ void p_rwkv_A(const Args& a, LAS unsigned char* lds, int bid, int nb, int stage) {
    LAS unsigned char* raw = lds;
    LAS unsigned char* w2t = lds + 8 * SLB + 6912;
    LAS unsigned char* a2t = w2t + 5120;
    LAS unsigned char* twl = a2t + 5120;
    LAS unsigned char* adl = twl + 5120;
    LAS float* cum = (LAS float*)(adl + 5120);
    LAS bf16_t* avl = (LAS bf16_t*)(cum + 4096);
    LAS float* seg = (LAS float*)(avl + 4096);
    LAS float* lamC = (LAS float*)(lds + 14 * SLB);
    static_assert(8 * SLB + 6912 + 4 * 5120 + 16384 + 8192 + 2048 <= 14 * SLB, "prep temporaries");
    static_assert(14 * SLB + 256 <= 131072 && 192 * 384 == 8 * SLB, "rwkv LDS");
    const bf16_t* Z = (const bf16_t*)(a.ws + WS_Z);
    const bf16_t* W2T = (const bf16_t*)(a.ws + WS_W2T);
    float* BON = (float*)(a.ws + WS_BON);
    bf16_t* RACT = (bf16_t*)(a.ws + WS_RACT); bf16_t* RRPT = (bf16_t*)(a.ws + WS_RRPT); bf16_t* RSL = (bf16_t*)(a.ws + WS_RSL); bf16_t* RYL = (bf16_t*)(a.ws + WS_RYL);
    const int tid0 = threadIdx.x;
    const int vcu = (nb % 8 == 0) ? (bid % 8) * (nb / 8) + bid / 8 : bid;
    const int nstg = stage ? RSTG1 : RSTG0, cs0 = stage ? RSTG0 : 0;
    u32x4 rq[9], wq, xq;
    unsigned long long tacc_ = 0, tprev_ = PROBE_SEC ? __builtin_amdgcn_s_memrealtime() : 0ull;
#define TSEC(id) do { if (PROBE_SEC == 10) { if ((id) == 8) { const unsigned long long tn_ = __builtin_amdgcn_s_memrealtime(); tacc_ += tn_ - tprev_; tprev_ = tn_; } } \
        else if (PROBE_SEC) { const unsigned long long tn_ = __builtin_amdgcn_s_memrealtime(); if ((id) == PROBE_SEC) tacc_ += tn_ - tprev_; tprev_ = tn_; } } while (0)
#define RWA_ISSUE(jn_) do { const int tq_ = opaque_tid(); const int chain_ = (jn_) / nstg, cs_ = cs0 + (jn_) % nstg, d_ = chain_ >> 5, b_ = (chain_ >> 3) & 3, h_ = chain_ & 7; \
        const bool ctx_ = cs_ < CTXL / RC; const int cidx_ = ctx_ ? cs_ : cs_ - CTXL / RC, gi_ = d_ ? ((ctx_ ? CTXL / RC : SEQ / RC) - 1 - cidx_) : cidx_; \
        _Pragma("unroll") for (int it = 0; it < 9; ++it) { const int pc = it * 512 + tq_, slot = pc / 24, q = pc - slot * 24, X = q >> 3, c8 = q & 7; int tok; \
            if (ctx_) { const int t = min(max(64 * (gi_ - 1) + slot, 0), CTXL - 1); tok = NTL + b_ * CTXL + t; } \
            else { const int rr_ = min(max(gi_ - 1 + (slot >> 6), 0), 63); tok = b_ * SEQ + rr_ * 64 + (slot & 63); } \
            rq[it] = *(const u32x4*)(Z + ((unsigned)tok * ZLD + X * 512 + h_ * 64 + c8 * 8)); } \
        { const int rw = tq_ >> 3, pq = tq_ & 7, which = pq >> 2, p4 = pq & 3; \
          wq = *(const u32x4*)(W2T + ((size_t)((which * 2 + d_) * 512 + h_ * 64 + rw)) * 32 + p4 * 8); \
          const int pj = d_ ? 63 - rw : rw; const int tokrow = ctx_ ? (NTL + b_ * CTXL + gi_ * 64 + pj) : (b_ * SEQ + gi_ * 64 + pj); \
          xq = *(const u32x4*)(Z + ((unsigned)tokrow * ZLD + (which ? COL_AD : COL_WD) + d_ * 32 + p4 * 8)); } } while (0)
    if (vcu < 64 * nstg) RWA_ISSUE(vcu);
    for (int jl = vcu; jl < 64 * nstg; jl += nb) {
        TSEC(8);
        int tid_ = tid0; asm volatile("" : "+v"(tid_));
        const int tid = tid_, lane = tid & 63, wave = __builtin_amdgcn_readfirstlane(tid >> 6);
        const int chain = jl / nstg, cs = cs0 + jl % nstg;
        const int d = chain >> 5, b = (chain >> 3) & 3, h = chain & 7;
        float* BONd = BON + (size_t)d * NTL * 8;
        const bool isctx = cs < CTXL / RC;
        const int cidx = isctx ? cs : cs - CTXL / RC;
        const int gi = d ? ((isctx ? CTXL / RC : SEQ / RC) - 1 - cidx) : cidx;
#pragma unroll 1
        for (int rp_ = 0; rp_ <= ((PROBE_RPT >> 18) & 1); ++rp_) {
        __syncthreads();
#pragma unroll
        for (int it = 0; it < 9; ++it) *(LAS u32x4*)(raw + (it * 512 + tid) * 16) = rq[it];
        {
            const int rw = tid >> 3, pq = tid & 7, which = pq >> 2, p4 = pq & 3;
            *(LAS u32x4*)((which ? a2t : w2t) + rw * 80 + p4 * 16) = wq;
            u32x4 xv = xq;
            if (!which) { xv.x = pk2(tanh_fast(bflo(xv.x)), tanh_fast(bfhi(xv.x))); xv.y = pk2(tanh_fast(bflo(xv.y)), tanh_fast(bfhi(xv.y)));
                          xv.z = pk2(tanh_fast(bflo(xv.z)), tanh_fast(bfhi(xv.z))); xv.w = pk2(tanh_fast(bflo(xv.w)), tanh_fast(bfhi(xv.w))); }
            *(LAS u32x4*)((which ? adl : twl) + rw * 80 + p4 * 16) = xv;
        }
        f32x4 cw9[9];
#pragma unroll
        for (int tap = 0; tap < 9; ++tap) cw9[tap] = *(const f32x4*)(a.in[10] + tap * 1536 + min(tid >> 7, 2) * 512 + h * 64 + 4 * (tid & 15));
        __syncthreads();
        TSEC(1);
        {
            const int which = wave >> 2, m0 = ((wave >> 1) & 1) * 32, n0 = (wave & 1) * 32, r31 = lane & 31, hh = lane >> 5;
            const LAS unsigned char* ap = (which ? adl : twl) + (m0 + r31) * 80 + hh * 16;
            const LAS unsigned char* bp = (which ? a2t : w2t) + (n0 + r31) * 80 + hh * 16;
            f32x16 acc = zero16();
#pragma unroll
            for (int ks = 0; ks < 2; ++ks) acc = __builtin_amdgcn_mfma_f32_32x32x16_bf16(*(const LAS bf16x8*)(ap + ks * 32), *(const LAS bf16x8*)(bp + ks * 32), acc, 0, 0, 0);
            const int c = n0 + r31;
            const float bias = a.in[which ? 13 : 11][d * 512 + h * 64 + c];
#pragma unroll
            for (int r = 0; r < 16; ++r) {
                const int srow = m0 + (r & 3) + 8 * (r >> 2) + 4 * hh; const float x = acc[r] + bias;
                if (which) avl[srow * 64 + c] = (bf16_t)f2bf(sigmoidf_(x));
                else { const float sp = fmaxf(-x, 0.f) + flog(1.0f + fexp(-fabsf(x))); cum[srow * 64 + c] = -fexp(-sp - 0.5f); }
            }
        }
        const int tt = tid >> 4, cg = tid & 15, ch = h * 64 + 4 * cg;
        const f32x4 kkw = *(const f32x4*)(a.in[16] + ch), kaw = *(const f32x4*)(a.in[17] + ch), rkw = *(const f32x4*)(a.in[18] + ch);
        f32x4 kkn_[2], bv_[2], kd_[2], rr_[2], vv_[2];
        f32x4 cvr[2], cvk[2];
        {
            const int X = tid >> 7, cgc = tid & 15, tb = (tid >> 4) & 7;
            f32x4 oacc[8];
#pragma unroll
            for (int j = 0; j < 8; ++j) oacc[j] = (f32x4){0.f, 0.f, 0.f, 0.f};
            if (X < 3) {
#pragma unroll 1
                for (int aa = 0; aa < 3; ++aa) {
                    const bool rowok = isctx ? (aa == 1) : ((unsigned)(gi - 1 + aa) < 64u);
                    if (!rowok) continue;
                    f32x4 w[3];
#pragma unroll
                    for (int bb2 = 0; bb2 < 3; ++bb2) w[bb2] = aa == 0 ? cw9[bb2] : (aa == 1 ? cw9[3 + bb2] : cw9[6 + bb2]);
                    u32x2 q[10];
#pragma unroll
                    for (int e = 0; e < 10; ++e) {
                        const int jj = 8 * tb + e - 1;
                        int slot; bool ok;
                        if (isctx) { slot = 64 + jj; ok = (unsigned)(64 * gi + jj) < (unsigned)CTXL; }
                        else { slot = aa * 64 + min(max(jj, 0), 63); ok = (unsigned)jj < 64u; }
                        q[e] = *(const LAS u32x2*)(raw + slot * 384 + X * 128 + cgc * 8);
                        if (!ok) { q[e].x = 0u; q[e].y = 0u; }
                    }
#pragma unroll
                    for (int j = 0; j < 8; ++j)
#pragma unroll
                        for (int bb2 = 0; bb2 < 3; ++bb2) { const u32x2 v = q[j + bb2];
                            oacc[j][0] += bflo(v.x) * w[bb2][0]; oacc[j][1] += bfhi(v.x) * w[bb2][1]; oacc[j][2] += bflo(v.y) * w[bb2][2]; oacc[j][3] += bfhi(v.y) * w[bb2][3]; }
                }
            }
            TSEC(2);
            __syncthreads();
            if (X < 3) {
                LAS float* cvo = (LAS float*)raw;
#pragma unroll
                for (int j = 0; j < 8; ++j) { const int pj = 8 * tb + j, sidx = d ? 63 - pj : pj; *(LAS f32x4*)(cvo + (sidx * 3 + X) * 64 + 4 * cgc) = oacc[j]; }
            }
        }
        __syncthreads();
#pragma unroll
        for (int half = 0; half < 2; ++half) { const LAS float* cvo = (const LAS float*)raw + ((half * 32 + tt) * 3) * 64 + 4 * cg;
            cvr[half] = *(const LAS f32x4*)(cvo); cvk[half] = *(const LAS f32x4*)(cvo + 64); vv_[half] = *(const LAS f32x4*)(cvo + 128); }
#pragma unroll
        for (int half = 0; half < 2; ++half) {
            const int s = half * 32 + tt, pj = d ? 63 - s : s;
            const int tokrow = b * SEQ + gi * 64 + pj;
            const f32x4 rr = cvr[half], kv = cvk[half];
            f32x4 kkn = kv * kkw;
            const float ss = row16_sum(kkn[0] * kkn[0] + kkn[1] * kkn[1] + kkn[2] * kkn[2] + kkn[3] * kkn[3]);
            kkn = kkn * __builtin_amdgcn_rsqf(fmaxf(ss, 1e-12f));
            const u32x2 aq = *(const LAS u32x2*)(avl + s * 64 + 4 * cg);
            const f32x4 av = {bflo(aq.x), bfhi(aq.x), bflo(aq.y), bfhi(aq.y)};
            f32x4 kd, bv;
#pragma unroll
            for (int j = 0; j < 4; ++j) { kd[j] = kv[j] * (1.0f + (av[j] - 1.0f) * kaw[j]); bv[j] = kkn[j] * av[j]; }
            const float bon = row16_sum(rr[0] * kd[0] * rkw[0] + rr[1] * kd[1] * rkw[1] + rr[2] * kd[2] * rkw[2] + rr[3] * kd[3] * rkw[3]);
            if (!isctx && cg == 0) BONd[(size_t)tokrow * 8 + h] = bon;
            kkn_[half] = kkn; bv_[half] = bv; kd_[half] = kd; rr_[half] = rr;
        }
        TSEC(3);
        {
            const int k = tid & 63, sg = tid >> 6;
            float run = 0.f;
#pragma unroll
            for (int j = 0; j < 8; ++j) { run += cum[(8 * sg + j) * 64 + k]; cum[(8 * sg + j) * 64 + k] = run; }
            seg[sg * 64 + k] = run;
            __syncthreads();
            float pre = 0.f;
            for (int q = 0; q < sg; ++q) pre += seg[q * 64 + k];
#pragma unroll
            for (int j = 0; j < 8; ++j) cum[(8 * sg + j) * 64 + k] += pre;
            __syncthreads();
        }
        TSEC(4);
        const f32x4 LC = *(LAS f32x4*)(cum + 63 * 64 + 4 * cg);
        const f32x4 eLC = {fexp(LC[0]), fexp(LC[1]), fexp(LC[2]), fexp(LC[3])};
#pragma unroll 1
        for (int re_ = 0; re_ <= ((PROBE_RPT >> 21) & 1); ++re_)
#pragma unroll
        for (int half = 0; half < 2; ++half) {
            const int s = half * 32 + tt;
            const f32x4 L = *(LAS f32x4*)(cum + s * 64 + 4 * cg);
            f32x4 Lp = {0.f, 0.f, 0.f, 0.f}; if (s > 0) Lp = *(LAS f32x4*)(cum + (s - 1) * 64 + 4 * cg);
            f32x4 bh, kh, at, rt, bb2, kb2;
#pragma unroll
            for (int j = 0; j < 4; ++j) {
                const float em = fexp(-L[j]), ep = __builtin_amdgcn_rcpf(em), epv = fexp(Lp[j]), ec = eLC[j] * em;
                bh[j] = bv_[half][j] * em; kh[j] = kd_[half][j] * em; at[j] = -kkn_[half][j] * epv; rt[j] = rr_[half][j] * ep;
                bb2[j] = bv_[half][j] * ec; kb2[j] = kd_[half][j] * ec;
            }
            const int so = s * 144 + 8 * cg; u32x2 w;
            w.x = pk2(bh[0], bh[1]); w.y = pk2(bh[2], bh[3]); *(LAS u32x2*)(RSLOT(0) + so) = w;
            w.x = pk2(kh[0], kh[1]); w.y = pk2(kh[2], kh[3]); *(LAS u32x2*)(RSLOT(1) + so) = w;
            w.x = pk2(at[0], at[1]); w.y = pk2(at[2], at[3]); *(LAS u32x2*)(RSLOT(2) + so) = w;
            w.x = pk2(rt[0], rt[1]); w.y = pk2(rt[2], rt[3]); *(LAS u32x2*)(RSLOT(3) + so) = w;
            w.x = pk2(bb2[0], bb2[1]); w.y = pk2(bb2[2], bb2[3]); *(LAS u32x2*)(RSLOT(4) + so) = w;
            w.x = pk2(kb2[0], kb2[1]); w.y = pk2(kb2[2], kb2[3]); *(LAS u32x2*)(RSLOT(5) + so) = w;
            w.x = pk2(vv_[half][0], vv_[half][1]); w.y = pk2(vv_[half][2], vv_[half][3]); *(LAS u32x2*)(RSLOT(6) + so) = w;
            if (s == 63) *(LAS f32x4*)(lamC + 4 * cg) = eLC;
        }
        __syncthreads();
        }
        TSEC(5);
        if (jl + nb < 64 * nstg) RWA_ISSUE(jl + nb);
        TSEC(6);
#pragma unroll 1
        for (int T = wave; T < 20; T += 8) {
            const int prod = T % 5, tq = T / 5; const bool ti = (prod == 1 || prod == 2);
            const int mt = (tq == 2 || (tq == 1 && ti) || (tq == 3 && !ti)) ? 32 : 0, nt = (tq == 2 || (tq == 1 && !ti) || (tq == 3 && ti)) ? 32 : 0;
            f32x16 acc = zero16();
            if (tq < 3) {
                const int ia = prod == 0 ? 0 : (prod == 3 ? 0 : (prod == 4 ? 1 : 2)), ib = prod == 0 ? 2 : (prod == 1 ? 0 : (prod == 2 ? 1 : 3));
                acc = tile_mmx<false, false>(RSLOT(ia), RSLOT(ib), mt, nt, 0, 4, acc, lane);
                mask_tri(acc, mt, nt, lane, ti ? -1 : 1, prod >= 3 ? 0 : 1, prod == 1);
            }
            store_cr(RSLOT(7 + prod), acc, mt, nt, lane);
        }
        LSYNC();
        if (wave < 4) { const int mt = (wave >> 1) * 32, nt = (wave & 1) * 32; f32x16 acc = zero16();
            if (wave != 2) acc = tile_mmx<true, false>(RSLOT(7), RSLOT(7), mt, nt, wave == 3 ? 2 : 0, wave == 0 ? 2 : 4, acc, lane);
            store_cr(RSLOT(0), acc, mt, nt, lane); }
        LSYNC();
#pragma unroll
        for (int lv = 1; lv <= 4; ++lv) {
            const int pc_in = (lv & 1) ? 0 : 7, pc_out = (lv & 1) ? 7 : 0, tr_in = (lv & 1) ? 8 : 1, tr_out = (lv & 1) ? 1 : 8;
            const int w4 = wave & 3, mt = (w4 >> 1) * 32, nt = (w4 & 1) * 32;
            if (wave < 4) {
                if (w4 != 2) { f32x16 acc = tile_mmx<true, false>(RSLOT(pc_in), RSLOT(pc_in), mt, nt, w4 == 3 ? 2 : 0, w4 == 0 ? 2 : 4, zero16(), lane);
                    if (lv == 4) mask_tri(acc, mt, nt, lane, 1, -64, true);
                    store_cr(RSLOT(pc_out), acc, mt, nt, lane); }
            } else {
                if (w4 != 1) { f32x16 acc = init_cr(RSLOT(tr_in), mt, nt, lane);
                    acc = tile_mmx<false, false>(RSLOT(pc_in), RSLOT(tr_in), mt, nt, w4 == 3 ? 2 : 0, w4 == 0 ? 2 : 4, acc, lane);
                    store_cr(RSLOT(tr_out), acc, mt, nt, lane); }
                else if (lv == 1) store_cr(RSLOT(tr_out), zero16(), mt, nt, lane);
            }
            LSYNC();
        }
        if (wave < 4) { const int mt = (wave >> 1) * 32, nt = (wave & 1) * 32; f32x16 acc = zero16();
            if (wave != 2) acc = tile_mmx<false, false>(RSLOT(8), RSLOT(0), mt, nt, wave == 3 ? 2 : 0, wave == 0 ? 2 : 4, acc, lane);
            store_cr(RSLOT(1), acc, mt, nt, lane); }
        LSYNC();
        { const int w4 = wave & 3, mt = (w4 >> 1) * 32, nt = (w4 & 1) * 32; f32x16 acc = zero16();
            if (wave < 4) { acc = tile_mmx<false, true>(RSLOT(1), RSLOT(2), mt, nt, 0, mt ? 4 : 2, acc, lane); store_cr(RSLOT(7), acc, mt, nt, lane); }
            else { if (w4 != 1) acc = tile_mmx<false, false>(RSLOT(1), RSLOT(9), mt, nt, w4 == 3 ? 2 : 0, w4 == 0 ? 2 : 4, acc, lane); store_cr(RSLOT(0), acc, mt, nt, lane); } }
        LSYNC();
        TSEC(7);
#pragma unroll 1
        for (int rl_ = 0; rl_ <= ((PROBE_RPT >> 22) & 1); ++rl_)
        {
            const int prod = wave >> 1, mt = (wave & 1) * 32;
            bf16_t* actj = RACT + (size_t)jl * 4096; bf16_t* rptj = RRPT + (size_t)jl * 4096;
#pragma unroll
            for (int nt2 = 0; nt2 < 2; ++nt2) {
                const int nt = nt2 * 32;
                if (prod == 0) { f32x16 acc = init_cr(RSLOT(3), mt, nt, lane); acc = tile_mmx<false, false>(RSLOT(7), RSLOT(10), mt, nt, 0, nt ? 4 : 2, acc, lane); store_g_perm(rptj, acc, mt, nt, lane); }
                else if (prod == 1) { f32x16 acc = zero16();
                    if (!(mt && !nt)) { acc = init_cr(RSLOT(11), mt, nt, lane); acc = tile_mmx<false, false>(RSLOT(0), RSLOT(10), mt, nt, mt ? 2 : 0, nt ? 4 : 2, acc, lane); }
                    store_cr(RSLOT(8), acc, mt, nt, lane); }
                else if (prod == 2) { f32x16 acc = tile_mmx<false, true>(RSLOT(7), RSLOT(4), mt, nt, 0, 4, zero16(), lane);
                    { const int c = nt + (lane & 31), hh = lane >> 5;
#pragma unroll
                      for (int r = 0; r < 16; ++r) { const int row = mt + (r & 3) + 8 * (r >> 2) + 4 * hh; if (row == c) acc[r] += lamC[row]; } }
                    store_g_perm(actj, acc, mt, nt, lane); }
                else { f32x16 acc = init_rc(RSLOT(5), mt, nt, lane); acc = tile_mmx<false, true>(RSLOT(0), RSLOT(4), mt, nt, mt ? 2 : 0, 4, acc, lane); store_cr(RSLOT(9), acc, mt, nt, lane); }
            }
        }
        LSYNC();
#pragma unroll 1
        for (int rl_ = 0; rl_ <= ((PROBE_RPT >> 22) & 1); ++rl_)
        { const int mt = ((wave >> 1) & 1) * 32, nt = (wave & 1) * 32;
            const f32x16 acc = tile_mmx<false, true>(RSLOT(wave < 4 ? 9 : 8), RSLOT(6), mt, nt, 0, (wave >= 4 && !mt) ? 2 : 4, zero16(), lane);
            store_g_cr((wave < 4 ? RSL : RYL) + (size_t)jl * 4096, acc, mt, nt, lane); }
        TSEC(9);
    }
#undef RWA_ISSUE
    if (PROBE_SEC && bid == 0 && tid0 == 0) { const unsigned long long t0_ = __builtin_amdgcn_s_memrealtime(); while (__builtin_amdgcn_s_memrealtime() - t0_ < 64ull * tacc_) __builtin_amdgcn_s_sleep(8); }
#undef TSEC
    LSYNC();
}

__device__ __forceinline__ void p_rwkv_S(const Args& a, LAS unsigned char* lds, int bid, int nb, int stage) {
    const int tid = opaque_tid(), lane = tid & 63, wave = __builtin_amdgcn_readfirstlane(tid >> 6), vl = lane & 15, g = lane >> 4;
    const int role = wave >> 2, mt = wave & 3;
    const bf16_t* OPB = (const bf16_t*)(a.ws + (role ? WS_RRPT : WS_RACT)); const bf16_t* INB = (const bf16_t*)(a.ws + (role ? WS_RYL : WS_RSL));
    float* RST = (float*)(a.ws + WS_RST); bf16_t* YOUT = (bf16_t*)(a.ws + WS_YOUT);
    LAS unsigned char* bfr = lds;
    const int vcu = (nb % 8 == 0) ? (bid % 8) * (nb / 8) + bid / 8 : bid;
    const int nstg = stage ? RSTG1 : RSTG0, cs0 = stage ? RSTG0 : 0;
    const unsigned long long ts0_ = (PROBE_SEC == 20 || PROBE_SEC == 21) ? __builtin_amdgcn_s_memrealtime() : 0ull; unsigned long long ts1_ = ts0_;
    for (int u = vcu; u < 256; u += nb) {
        const int chain = u >> 2, vq = u & 3, d = chain >> 5, b = (chain >> 3) & 3, h = chain & 7;
        f32x4 S = {0.f, 0.f, 0.f, 0.f};
        float* rst = RST + ((size_t)u * 64 + lane) * 16 + 4 * mt;
        if (stage != 0 && role == 0) S = *(const f32x4*)rst;
        __syncthreads();
        if (role == 0) { u32x2 w; w.x = pk2(S[0], S[1]); w.y = pk2(S[2], S[3]); *(LAS u32x2*)(bfr + ((mt >> 1) * 64 + lane) * 16 + (mt & 1) * 8) = w; }
        __syncthreads();
        bf16_t* Yd = YOUT + (size_t)d * NTL * 512 + h * 64 + vq * 16 + vl;
        const bf16_t* opp = OPB + (size_t)chain * nstg * 4096 + (16 * mt + vl) * 64 + 8 * g;
        const bf16_t* inp = INB + (size_t)chain * nstg * 4096 + (vq * 16 + vl) * 64 + 16 * mt + 4 * g;
        bf16x8 fa[8][2]; u32x2 ini[8];
#define RW_LOAD(q, c_) do { fa[q][0] = *(const bf16x8*)(opp + (size_t)(c_) * 4096); fa[q][1] = *(const bf16x8*)(opp + (size_t)(c_) * 4096 + 32); ini[q] = *(const u32x2*)(inp + (size_t)(c_) * 4096); } while (0)
#define RW_STEP(q, c_) do { \
            const LAS unsigned char* bp = bfr + ((c_) & 1) * 2048 + lane * 16; \
            const bf16x8 b0 = *(const LAS bf16x8*)(bp), b1 = *(const LAS bf16x8*)(bp + 1024); \
            f32x4 acc = {bflo(ini[q].x), bfhi(ini[q].x), bflo(ini[q].y), bfhi(ini[q].y)}; \
            acc = __builtin_amdgcn_mfma_f32_16x16x32_bf16(fa[q][0], b0, acc, 0, 0, 0); acc = __builtin_amdgcn_mfma_f32_16x16x32_bf16(fa[q][1], b1, acc, 0, 0, 0); \
            if (role == 0) { S = acc; u32x2 w; w.x = pk2(acc[0], acc[1]); w.y = pk2(acc[2], acc[3]); *(LAS u32x2*)(bfr + (((c_) + 1) & 1) * 2048 + ((mt >> 1) * 64 + lane) * 16 + (mt & 1) * 8) = w; } \
            else { const int cs_ = cs0 + (c_); \
                if (cs_ >= CTXL / RC) { _Pragma("unroll") for (int r = 0; r < 4; ++r) { const int i_ = cs_ * RC + 16 * mt + 4 * g + r - CTXL; const int pos_ = d ? (SEQ - 1 - i_) : i_; \
                    const bf16_t* yp_ = Yd + (size_t)(b * SEQ + pos_) * 512; const unsigned yv_ = f2bf(acc[r]); \
                    asm volatile("global_store_short %0, %1, off\n\ts_nop 0" :: "v"(yp_), "v"(yv_) : "memory"); } } } \
            asm volatile("s_waitcnt lgkmcnt(0)" ::: "memory"); __builtin_amdgcn_s_barrier(); asm volatile("" ::: "memory"); } while (0)
        RW_LOAD(0, 0); RW_LOAD(1, 1); RW_LOAD(2, 2); RW_LOAD(3, 3); RW_LOAD(4, 4); RW_LOAD(5, 5); RW_LOAD(6, 6);
        static_assert(RSTG0 % 8 == 0 && RSTG1 % 8 == 4, "the prefetch ring below: full groups of 8 chunks, then 4");
#define RW_PAIR(q) do { RW_LOAD(((q) + 7) & 7, min(c + (q) + 7, nstg - 1)); RW_STEP(q, c + (q)); } while (0)
        int c = 0;
        if (PROBE_SEC == 21) ts1_ = __builtin_amdgcn_s_memrealtime();
#pragma unroll 1
        for (; c + 8 <= nstg; c += 8) {
            RW_PAIR(0); RW_PAIR(1); RW_PAIR(2); RW_PAIR(3); RW_PAIR(4); RW_PAIR(5); RW_PAIR(6); RW_PAIR(7);
        }
        if (c < nstg) { RW_STEP(0, c); RW_STEP(1, c + 1); RW_STEP(2, c + 2); RW_STEP(3, c + 3); }
#undef RW_PAIR
#undef RW_LOAD
#undef RW_STEP
        if (stage == 0 && role == 0) *(f32x4*)rst = S;
    }
    if ((PROBE_SEC == 20 || PROBE_SEC == 21) && bid == 0 && tid == 0) { const unsigned long long t0_ = __builtin_amdgcn_s_memrealtime(), dt_ = t0_ - (PROBE_SEC == 21 ? ts1_ : ts0_); while (__builtin_amdgcn_s_memrealtime() - t0_ < 64ull * dt_) __builtin_amdgcn_s_sleep(8); }
    __syncthreads();
}

__device__ __forceinline__ float grp8_sum(float v) { v += dppf<0xB1>(v); v += dppf<0x4E>(v); v += dppf<0x141>(v); return v; }
__device__ __forceinline__ void p_rwkv_readout(const Args& a, int bid, int nb) {
    const int tid = opaque_tid(), lane = tid & 63, wave = tid >> 6, hf = wave & 1, c0 = hf * 256 + lane * 4, h = c0 >> 6;
    const bf16_t* Z = (const bf16_t*)(a.ws + WS_Z); const bf16_t* Y = (const bf16_t*)(a.ws + WS_YOUT); const float* BON = (const float*)(a.ws + WS_BON);
    const bf16_t* GATE = (const bf16_t*)(a.ws + WS_GATE); bf16_t* MIX = (bf16_t*)(a.ws + WS_MIX);
    const f32x4 lnw = *(const f32x4*)(a.in[19] + c0), lnb = *(const f32x4*)(a.in[20] + c0);
    f32x4 cw[9];
#pragma unroll
    for (int tap = 0; tap < 9; ++tap) cw[tap] = *(const f32x4*)(a.in[10] + tap * 1536 + 1024 + c0);
#pragma unroll 1
    for (int it = bid * 8 + wave; it < NTL / 2; it += nb * 8) {
        const int tok0 = (it >> 1) * 4, b = tok0 >> 12, pos0 = tok0 & 4095, ti = pos0 >> 6, tj0 = pos0 & 63;
        u32x2 q[3][6], yf[4], yb[4], gt[4]; float bo0[4], bo1[4];
#pragma unroll
        for (int aa = 0; aa < 3; ++aa) {
            const int iic = min(max(ti + aa - 1, 0), 63);
#pragma unroll
            for (int e = 0; e < 6; ++e) q[aa][e] = *(const u32x2*)(Z + ((unsigned)(b * SEQ + iic * 64 + min(max(tj0 + e - 1, 0), 63)) * ZLD + COL_V + c0));
        }
#pragma unroll
        for (int t = 0; t < 4; ++t) { const int tok = tok0 + t;
            yf[t] = *(const u32x2*)(Y + (size_t)tok * 512 + c0); yb[t] = *(const u32x2*)(Y + (size_t)(NTL + tok) * 512 + c0);
            gt[t] = *(const u32x2*)(GATE + (size_t)tok * 512 + c0); bo0[t] = BON[(size_t)tok * 8 + h]; bo1[t] = BON[(size_t)(NTL + tok) * 8 + h]; }
        asm volatile("" ::: "memory");
        f32x4 v[4];
#pragma unroll
        for (int t = 0; t < 4; ++t) v[t] = (f32x4){0.f, 0.f, 0.f, 0.f};
#pragma unroll
        for (int aa = 0; aa < 3; ++aa) {
            const bool rowok = (unsigned)(ti + aa - 1) < 64u;
#pragma unroll
            for (int e = 0; e < 6; ++e) { const bool ok = rowok && (unsigned)(tj0 + e - 1) < 64u; if (!ok) q[aa][e] = (u32x2){0u, 0u}; }
#pragma unroll
            for (int t = 0; t < 4; ++t)
#pragma unroll
                for (int bb2 = 0; bb2 < 3; ++bb2) { const u32x2 x = q[aa][t + bb2]; const f32x4 w = cw[aa * 3 + bb2];
                    v[t][0] += bflo(x.x) * w[0]; v[t][1] += bfhi(x.x) * w[1]; v[t][2] += bflo(x.y) * w[2]; v[t][3] += bfhi(x.y) * w[3]; }
        }
#pragma unroll
        for (int t = 0; t < 4; ++t) {
            const int tok = tok0 + t;
            const float bonus = bo0[t] + bo1[t];
            f32x4 y = {bflo(yf[t].x) + bflo(yb[t].x), bfhi(yf[t].x) + bfhi(yb[t].x), bflo(yf[t].y) + bflo(yb[t].y), bfhi(yf[t].y) + bfhi(yb[t].y)};
            const float mu = row16_sum((y[0] + y[1]) + (y[2] + y[3])) * (1.f / 64.f);
            y = y - mu;
            const float rstd = __builtin_amdgcn_rsqf(row16_sum((y[0] * y[0] + y[1] * y[1]) + (y[2] * y[2] + y[3] * y[3])) * (1.f / 64.f) + 64e-5f);
            const f32x4 gv = {bflo(gt[t].x), bfhi(gt[t].x), bflo(gt[t].y), bfhi(gt[t].y)};
            const f32x4 o = (y * rstd * lnw + lnb + bonus * v[t]) * gv;
            u32x2 w; w.x = pk2(o[0], o[1]); w.y = pk2(o[2], o[3]);
            *(u32x2*)(MIX + (size_t)tok * DM + c0) = w;
        }
    }
}

constexpr int NPH = 16;
__global__ void __launch_bounds__(NTHREADS, 2) mega(Args a) {
    __builtin_assume(__builtin_amdgcn_workitem_id_y() == 0); __builtin_assume(__builtin_amdgcn_workitem_id_z() == 0);
    extern __shared__ __attribute__((aligned(16))) unsigned char lds_raw[];
    LAS unsigned char* lds = (LAS unsigned char*)lds_raw;
    cg::grid_group grid = cg::this_grid();
    const int tid = threadIdx.x, bid = blockIdx.x, nb = gridDim.x;
    unsigned char* ws = a.ws;
    float* MOD = (float*)(ws + WS_MOD);
    const int lo = a.ph_lo, hi = a.ph_hi;
    volatile LAS unsigned* misc = (volatile LAS unsigned*)(lds + 131072);
    if (tid < 4) misc[tid] = 0u;
    __syncthreads();
    const XcdBarrier xbar = xcd_barrier_post((unsigned*)(ws + WS_CTL), misc);
#define IN(k) (lo <= (k) && (k) < hi)
#define SEAM(k) do { if (IN(k) && IN((k) + 1)) xcd_barrier(xbar); } while (0)
    if (lo < 0) grid.sync();
    unsigned long long pht0_ = 0, phtacc_ = 0;
#define PHASE(k, ...) if (PROBE_PHT == (k) || ((k) == 1 && PROBE_PHT >= 30 && PROBE_PHT <= 33)) pht0_ = __builtin_amdgcn_s_memrealtime(); if (IN(k)) { __VA_ARGS__ if ((PROBE_RPT >> (k)) & 1) { xcd_barrier(xbar); __VA_ARGS__ } } SEAM(k); if (PROBE_PHT == (k)) phtacc_ = __builtin_amdgcn_s_memrealtime() - pht0_;
    PHASE(1, {
        p0_mod(a, lds, bid, nb);
        __syncthreads();
        if (PROBE_PHT == 30) phtacc_ = __builtin_amdgcn_s_memrealtime() - pht0_;
        p0_weights(a, lds, bid, nb, 0);
        __syncthreads();
        if (PROBE_PHT == 31) phtacc_ = __builtin_amdgcn_s_memrealtime() - pht0_;
        p0_s5(a, lds, bid, nb);
        if (PROBE_PHT == 32) phtacc_ = __builtin_amdgcn_s_memrealtime() - pht0_;
        mod_wait(a);
        if (PROBE_PHT == 33) phtacc_ = __builtin_amdgcn_s_memrealtime() - pht0_;
        bf16_t* HM = (bf16_t*)(ws + WS_HMOD); const int t_ = opaque_tid(), lane = t_ & 63, wave = t_ >> 6;
        f32x4 gg_[4];
        _Pragma("unroll") for (int j = 0; j < 4; ++j) gg_[j] = ((const f32x4*)a.in[6])[lane + 64 * j];
        for (int row0 = bid * 8 + wave; row0 < NTOK; row0 += nb * 32) {
            RowV rv[4]; ModV mv[2];
            _Pragma("unroll") for (int q = 0; q < 4; ++q) { const int row = min(row0 + q * nb * 8, NTOK - 1); rv[q] = row_load(row < NTL ? a.in[0] + (size_t)row * DM : a.in[2] + (size_t)(row - NTL) * DM, lane); }
            { const int mb = row0 < NTL ? (row0 >> 12) : 4; mv[0] = mod_load(MOD + mb * 6144, MOD + mb * 6144 + 1024, lane); }
            _Pragma("unroll") for (int q = 0; q < 4; ++q) { const int row = row0 + q * nb * 8;
                if (q < 3) { const int rn = min(row + nb * 8, NTOK - 1), mbn = rn < NTL ? (rn >> 12) : 4; mv[(q + 1) & 1] = mod_load(MOD + mbn * 6144, MOD + mbn * 6144 + 1024, lane); }
                if (row < NTOK) norm_mod_store(rv[q], gg_, mv[q & 1], HM + (size_t)row * DM, lane); }
        }
    })
    PHASE(2, {
        pg8::Gemm g{(const bf16_t*)(ws + WS_HMOD), (const bf16_t*)(ws + WS_WTIN), DM, DM, DM};
        pg8::StaticOrder S; S.init(NTOK, DINP, nb, bid);
        pg8::EpiZ E{(bf16_t*)(ws + WS_Z), (bf16_t*)(ws + WS_AALL), (bf16_t*)(ws + WS_SIG)};
        pg8::gemm_phase(lds, g, S, E);
        constexpr int G1_FULL = (NTOK / 256) * (DINP / 256) - 2 * 256;
        if (nb == 256 && bid >= G1_FULL) { __syncthreads(); p0_weights(a, lds, bid - G1_FULL, nb - G1_FULL, 1); }
        else if (nb != 256) { __syncthreads(); p0_weights(a, lds, bid, nb, 1); }
    })
    PHASE(3, {
        int k3_ = S5U; asm volatile("" : "+s"(k3_));
        pg8::Gemm g{(const bf16_t*)(ws + WS_AALL), (const bf16_t*)(ws + WS_BT2), S5K1, S5U, k3_};
        pg8::S5Order2 S{nb, bid};
        pg8::EpiE E{(float*)(ws + WS_E)};
        _Pragma("unroll 1") for (int r_ = 0; r_ <= ((PROBE_RPT >> 26) & 1); ++r_) pg8::gemm_phase(lds, g, S, E);
        constexpr int NE = 32 * S5NRT;
        if (nb > NE + 32) { if (bid >= NE) { _Pragma("unroll 1") for (int r_ = 0; r_ <= ((PROBE_RPT >> 27) & 1); ++r_) p1_s5(a, lds, bid - NE, nb - NE); } }
        else { __syncthreads(); p1_s5(a, lds, bid, nb); }
    })
    PHASE(4, { p_s5_carry(a, bid, nb); if ((PROBE_RPT >> 23) & 1) { for (int q_ = 0; q_ < 10; ++q_) xcd_barrier(xbar); } })
    PHASE(5, {
        const bool xcd8 = (nb == 256); const int yidx = xcd8 ? (bid & 7) * 16 + (bid >> 3) : bid; const bool ywg = xcd8 ? (bid >> 3) < 16 : bid < nb / 2;
        if (ywg) {
            pg8::Gemm g{(const bf16_t*)(ws + WS_AALL), (const bf16_t*)(ws + WS_BT1), S5K1, S5K1, S5K1};
            pg8::S5Order1 S{nb / 2, yidx};
            pg8::EpiY E{(const bf16_t*)(ws + WS_AALL), a.in[28], (bf16_t*)(ws + WS_ZG)};
            _Pragma("unroll 1") for (int r_ = 0; r_ <= ((PROBE_RPT >> 24) & 1); ++r_) pg8::gemm_phase(lds, g, S, E);
        } else {
            pg8::Gemm g2{(const bf16_t*)(ws + WS_SIG), (const bf16_t*)(ws + WS_G2T), 256, 256, 256};
            pg8::StaticOrder S2; S2.init(NTL, 512, nb - nb / 2, xcd8 ? (bid & 7) * 16 + (bid >> 3) - 16 : bid - nb / 2);
            pg8::EpiG E2{(bf16_t*)(ws + WS_GATE)};
            _Pragma("unroll 1") for (int r_ = 0; r_ <= ((PROBE_RPT >> 25) & 1); ++r_) pg8::gemm_phase(lds, g2, S2, E2);
        }
    })
#pragma unroll 1
    for (int rep6 = 0; rep6 <= ((PROBE_RPT >> 6) & 1); ++rep6) {
        if (rep6) xcd_barrier(xbar);
#pragma unroll 1
        for (int st = 0; st < 2; ++st) {
            if (PROBE_PHT == 6 + 2 * st) pht0_ = __builtin_amdgcn_s_memrealtime();
            if (IN(6 + 2 * st)) { p_rwkv_A(a, lds, bid, nb, st); if ((PROBE_RPT >> 16) & 1) { xcd_barrier(xbar); p_rwkv_A(a, lds, bid, nb, st); } }
            if (IN(6 + 2 * st) && IN(7 + 2 * st)) xcd_barrier(xbar);
            if (PROBE_PHT == 6 + 2 * st) phtacc_ = __builtin_amdgcn_s_memrealtime() - pht0_;
            if (PROBE_PHT == 7 + 2 * st) pht0_ = __builtin_amdgcn_s_memrealtime();
            if (IN(7 + 2 * st)) { p_rwkv_S(a, lds, bid, nb, st); if ((PROBE_RPT >> 17) & 1) { xcd_barrier(xbar); p_rwkv_S(a, lds, bid, nb, st); } }
            if (st == 0 && IN(7) && IN(8)) xcd_barrier(xbar);
            if (PROBE_PHT == 7 && st == 0) phtacc_ = __builtin_amdgcn_s_memrealtime() - pht0_;
        }
    }
    SEAM(9);
    if (PROBE_PHT == 9) phtacc_ = __builtin_amdgcn_s_memrealtime() - pht0_;
    PHASE(10, {
        p_rwkv_readout(a, bid, nb);
        __syncthreads();
        pg8::Gemm g{(const bf16_t*)(ws + WS_ZG), (const bf16_t*)(ws + WS_WTGLU), 512, 512, 512};
        pg8::StaticOrder S; S.init(NTL, 512, nb, bid);
        pg8::EpiGLU E{(const bf16_t*)(ws + WS_ZG), a.in[30], (bf16_t*)(ws + WS_MIX)};
        pg8::gemm_phase(lds, g, S, E);
    })
    PHASE(11, {
        pg8::Gemm g{(const bf16_t*)(ws + WS_MIX), (const bf16_t*)(ws + WS_WTOUT), DM, DM, DM};
        pg8::StaticOrder S; S.init(NTL, DM, nb, bid);
        pg8::PanelSumsq st{(float*)(ws + WS_XBUF), (unsigned*)(ws + WS_CTL + 16384)};
        pg8::EpiWoutNorm E{a.in[0], a.out, MOD, a.in[7], (bf16_t*)(ws + WS_HMOD), st};
        pg8::gemm_phase(lds, g, S, E);
    })
    PHASE(13, {
        pg8::Gemm g{(const bf16_t*)(ws + WS_HMOD), (const bf16_t*)(ws + WS_WT13), DM, DM, DM};
        pg8::StaticOrder S; S.init(NTL, 2 * DFF, nb, bid);
        pg8::EpiUp E{(bf16_t*)(ws + WS_ACT)};
        pg8::gemm_phase(lds, g, S, E);
    })
    if (PROBE_PHT == 14) pht0_ = __builtin_amdgcn_s_memrealtime();
    if (IN(14)) {
        pg8::Gemm g{(const bf16_t*)(ws + WS_ACT), (const bf16_t*)(ws + WS_WT2), DFF, DFF, DFF};
        pg8::StaticOrder S; S.init(NTL, DM, nb, bid);
        pg8::PanelSumsq st{(float*)(ws + WS_XBUF) + 64 * 256 * 4, (unsigned*)(ws + WS_CTL + 32768)};
        pg8::EpiDownNorm E{a.out, MOD, a.in[34], st};
        pg8::gemm_phase(lds, g, S, E);
    }
    if (PROBE_PHT == 14) { asm volatile("s_waitcnt vmcnt(0)" ::: "memory"); __syncthreads(); phtacc_ = __builtin_amdgcn_s_memrealtime() - pht0_; }
#undef PHASE
    if (PROBE_PHT >= 0 && bid == 0 && tid == 0) { const unsigned long long t0_ = __builtin_amdgcn_s_memrealtime(); while (__builtin_amdgcn_s_memrealtime() - t0_ < 64ull * phtacc_) __builtin_amdgcn_s_sleep(8); }
#undef IN
#undef SEAM
}

extern "C" void kernel_launch(void* const* d_in, const int* in_sizes, int n_in, void* d_out, int out_size, void* d_ws, size_t ws_size, hipStream_t stream) {
    static int grid_blocks = 0;
    if (!grid_blocks) {
        int dev = 0, cus = 0, per_cu = 0;
        (void)hipGetDevice(&dev);
        (void)hipDeviceGetAttribute(&cus, hipDeviceAttributeMultiprocessorCount, dev);
        if (hipFuncSetAttribute((const void*)mega, hipFuncAttributeMaxDynamicSharedMemorySize, LDS_BYTES) != hipSuccess) fprintf(stderr, "hipFuncSetAttribute failed\n");
        (void)hipOccupancyMaxActiveBlocksPerMultiprocessor(&per_cu, (const void*)mega, NTHREADS, LDS_BYTES);
        if (ws_size < WS_END || n_in != 35) { fprintf(stderr, "kernel_launch: need %zu bytes of workspace (have %zu), 35 inputs (have %d)\n", (size_t)WS_END, ws_size, n_in); grid_blocks = -1; return; }
        if (per_cu < 1) { fprintf(stderr, "kernel_launch: occupancy query says %d blocks per CU\n", per_cu); per_cu = 1; }
        grid_blocks = cus;
        if (cus != 256) fprintf(stderr, "kernel_launch: built for a 256-CU device (the fused-norm GEMM epilogues need exactly one 256x256 unit per workgroup); got %d CUs\n", cus);
    }
    if (grid_blocks < 0) return;
    Args a{};
    for (int i = 0; i < 35; ++i) a.in[i] = (const float*)d_in[i];
    a.out = (float*)d_out; a.ws = (unsigned char*)d_ws; a.ph_lo = 0; a.ph_hi = NPH;
    (void)hipMemsetAsync((char*)d_ws + WS_CTL, 0, CTL_BYTES, stream);
    void* args[] = {&a};
    hipError_t e = hipLaunchCooperativeKernel((const void*)mega, dim3(grid_blocks), dim3(NTHREADS), args, LDS_BYTES, stream);
    if (e != hipSuccess) fprintf(stderr, "cooperative launch failed: %s (grid %d)\n", hipGetErrorString(e), grid_blocks);
}
```

```cpp
#include <hip/hip_runtime.h>
#include <hip/hip_cooperative_groups.h>
#include <cstdio>
namespace cg = cooperative_groups;

#define LAS __attribute__((address_space(3)))
typedef unsigned short bf16_t;
typedef short bf16x8 __attribute__((ext_vector_type(8)));
typedef float f32x4 __attribute__((ext_vector_type(4)));
typedef float f32x2 __attribute__((ext_vector_type(2)));
typedef unsigned u32x4 __attribute__((ext_vector_type(4)));
typedef unsigned u32x2 __attribute__((ext_vector_type(2)));

constexpr int NTHREADS = 512;
constexpr int LDS_BYTES = 131072 + 4096;
constexpr int DM = 1024, BATCH = 4, SEQ = 4096, CTXL = 256;
constexpr int NTL = BATCH * SEQ, NTC = BATCH * CTXL, NTOK = NTL + NTC;
constexpr int DIN = 2272, DINP = 2304, ZLD = 1792;
constexpr int COL_K = 512, COL_V = 1024, COL_WD = 1536, COL_AD = 1600, COL_GD = 1664, COL_U = 1760;
constexpr int DFF = 2816;
__host__ __device__ constexpr unsigned zidx(unsigned tok, unsigned col) { return ((col >> 5) * (unsigned)NTOK + tok) * 32u + (col & 31u); }
constexpr int S5C = 16;
constexpr int S5U = S5C * 16;
constexpr int S5LR = NTL / S5C, S5XR = NTC / S5C;
constexpr int S5EROWS = S5LR + S5XR;
constexpr int S5NRT = (S5EROWS + 255) / 256;
constexpr int S5ROWS = S5NRT * 256;
constexpr int S5K1 = S5U + 256;
constexpr int S5NRY = S5LR / 256, S5NCY = S5U / 256;
constexpr int S5NCH = SEQ / S5C, S5NCX = CTXL / S5C;

constexpr size_t al256(size_t x) { return (x + 255) & ~(size_t)255; }
constexpr size_t WS_CTL   = 0;
constexpr size_t CTL_BYTES = 65536;
constexpr size_t WS_MOD   = CTL_BYTES;
constexpr size_t WS_WTIN  = al256(WS_MOD + (size_t)5 * 6144 * 4);
constexpr size_t WS_WTOUT = al256(WS_WTIN + (size_t)DINP * DM * 2);
constexpr size_t WS_WT13  = al256(WS_WTOUT + (size_t)DM * DM * 2);
constexpr size_t WS_WT2   = al256(WS_WT13 + (size_t)2 * DFF * DM * 2);
constexpr size_t WS_WTGLU = al256(WS_WT2 + (size_t)DM * DFF * 2);
constexpr size_t WS_S5TAB = al256(WS_WTGLU + (size_t)512 * 512 * 2);
constexpr size_t WS_KT    = al256(WS_S5TAB + (size_t)2 * 32 * 64 * 2 * 4);
constexpr size_t WS_W2T   = al256(WS_KT + (size_t)32 * (2 * S5C * 256) * 4);
constexpr size_t WS_BON   = al256(WS_W2T + (size_t)2 * 2 * 512 * 32 * 2);
constexpr size_t WS_ZG    = al256(WS_BON + (size_t)2 * NTL * 8 * 4);
constexpr size_t WS_HMOD  = al256(WS_ZG + (size_t)NTL * 512 * 2);
constexpr size_t WS_Z     = al256(WS_HMOD + (size_t)NTOK * DM * 2);
constexpr size_t WS_AALL  = al256(WS_Z + (size_t)NTOK * ZLD * 2);
constexpr size_t WS_BT1   = al256(WS_AALL + (size_t)32 * S5ROWS * S5K1 * 2);
constexpr size_t WS_BT2   = al256(WS_BT1 + (size_t)32 * S5U * S5K1 * 2);
constexpr size_t WS_E     = al256(WS_BT2 + (size_t)32 * 256 * S5U * 2);
constexpr size_t WS_S5END = al256(WS_E + (size_t)32 * S5EROWS * 256 * 4);
constexpr size_t WS_SIG   = WS_S5END;
constexpr size_t WS_G2T   = al256(WS_SIG + (size_t)NTL * 256 * 2);
constexpr size_t WS_GATE  = al256(WS_G2T + (size_t)512 * 256 * 2);
constexpr size_t WS_XBUF  = al256(WS_GATE + (size_t)NTL * 512 * 2);
constexpr size_t WS_END2  = al256(WS_XBUF + (size_t)2 * 64 * 256 * 4 * 4);
constexpr size_t WS_ACT   = WS_Z;

constexpr size_t WS_END = WS_END2;
static_assert(WS_ACT + (size_t)NTL * DFF * 2 <= WS_S5END, "ACT alias");
static_assert(WS_END <= (size_t)256 * 1024 * 1024, "workspace");

#ifndef PROBE_RPT
#define PROBE_RPT 0
#endif
#ifndef PROBE_PHT
#define PROBE_PHT -1
#endif
#ifndef PROBE_BID
#define PROBE_BID 0
#endif
#ifndef PROBE_SEC
#define PROBE_SEC 0
#endif
struct Args { const float* in[35]; float* out; unsigned char* ws; int ph_lo, ph_hi; };

typedef __bf16 bf16x2_t __attribute__((ext_vector_type(2)));
__device__ __forceinline__ unsigned pk2(float lo, float hi) { const f32x2 v = {lo, hi}; return __builtin_bit_cast(unsigned, __builtin_convertvector(v, bf16x2_t)); }
__device__ __forceinline__ unsigned f2bf(float f) { return pk2(f, f) & 0xffffu; }
__device__ __forceinline__ float bflo(unsigned w) { return __builtin_bit_cast(float, w << 16); }
__device__ __forceinline__ float bfhi(unsigned w) { return __builtin_bit_cast(float, w & 0xffff0000u); }
__device__ __forceinline__ float bf2f(bf16_t b) { return __builtin_bit_cast(float, ((unsigned)b) << 16); }
__device__ __forceinline__ float wave_sum(float v) {
#pragma unroll
    for (int o = 1; o < 64; o <<= 1) v += __shfl_xor(v, o);
    return v;
}
template <int CTRL> __device__ __forceinline__ float dppf(float v) { return __builtin_bit_cast(float, __builtin_amdgcn_update_dpp(0, __builtin_bit_cast(int, v), CTRL, 0xf, 0xf, false)); }
__device__ __forceinline__ float row16_sum(float v) { v += dppf<0x128>(v); v += dppf<0x124>(v); v += dppf<0x122>(v); v += dppf<0x121>(v); return v; }
__device__ __forceinline__ int opaque_tid() { int t = threadIdx.x; asm volatile("" : "+v"(t)); return t; }
__device__ __forceinline__ float fexp(float x) { return __builtin_amdgcn_exp2f(x * 1.4426950408889634f); }
__device__ __forceinline__ float flog(float x) { return __builtin_amdgcn_logf(x) * 0.6931471805599453f; }
__device__ __forceinline__ float sigmoidf_(float x) { return __builtin_amdgcn_rcpf(1.0f + fexp(-x)); }
__device__ __forceinline__ float siluf_(float x) { return x * __builtin_amdgcn_rcpf(1.0f + fexp(-x)); }
__device__ __forceinline__ float tanh_fast(float x) { return 1.0f - 2.0f * __builtin_amdgcn_rcpf(1.0f + fexp(2.0f * x)); }
__device__ __forceinline__ float gelu_tanh(float x) { const float u = 0.7978845608028654f * (x + 0.044715f * x * x * x); return x - x * __builtin_amdgcn_rcpf(1.0f + fexp(2.0f * u)); }

#define XB_TMO      128
#define XB_XCNT(j)  (256  + 64 * (j))
#define XB_XSUB(j)  (1280 + 64 * (j))
#define XB_XGEN(j)  (2304 + 64 * (j))
#define XB_TOP      3328
#define XB_TOPGEN   3392
#define XCD_BAR_WORDS 3456
#define XB_SPIN_CAP (1u << 20)
static_assert(XCD_BAR_WORDS * 4 <= CTL_BYTES, "ctl");
__device__ __forceinline__ unsigned xb_ld(unsigned* p)              { return __hip_atomic_load(p, __ATOMIC_RELAXED, __HIP_MEMORY_SCOPE_AGENT); }
__device__ __forceinline__ unsigned xb_add(unsigned* p, unsigned v) { return __hip_atomic_fetch_add(p, v, __ATOMIC_RELAXED, __HIP_MEMORY_SCOPE_AGENT); }
__device__ __forceinline__ unsigned xb_xcc_id() { return (unsigned)__builtin_amdgcn_s_getreg((3 << 11) | 20) & 0xFu; }
#define XB_SPIN(cond, bar) do { unsigned _sp = 0; while (cond) { __builtin_amdgcn_s_sleep(1); \
    if ((++_sp & 255u) == 0u) { if (xb_ld(&(bar)[XB_TMO])) break; if (_sp > XB_SPIN_CAP) { atomicAdd(&(bar)[XB_TMO], 1u); break; } } } } while (0)
struct XcdBarrier { unsigned* bar; unsigned x; volatile LAS unsigned* st; };
__device__ __forceinline__ XcdBarrier xcd_barrier_post(unsigned* bar, volatile LAS unsigned* st) {
    XcdBarrier b; b.bar = bar; b.x = xb_xcc_id(); b.st = st;
    if (threadIdx.x == 0) (void)xb_add(&bar[XB_XCNT(b.x)], 1u);
    return b;
}
__device__ __forceinline__ void xcd_barrier_complete(unsigned* bar, unsigned x, unsigned& nloc, unsigned& nx) {
    const unsigned G = gridDim.x * gridDim.y * gridDim.z;
    unsigned sum, cnt, mine, sp = 0u;
    for (;;) {
        sum = 0u; cnt = 0u; mine = 0u;
#pragma unroll
        for (unsigned j = 0; j < 16; ++j) { const unsigned c = xb_ld(&bar[XB_XCNT(j)]); sum += c; cnt += (c > 0u) ? 1u : 0u; mine = (j == x) ? c : mine; }
        if (sum == G) break;
        __builtin_amdgcn_s_sleep(1);
        if ((++sp & 255u) == 0u) { if (xb_ld(&bar[XB_TMO])) break; if (sp > XB_SPIN_CAP) { atomicAdd(&bar[XB_TMO], 1u); break; } }
    }
    nloc = mine > 0u ? mine : 1u; nx = cnt > 0u ? cnt : 1u;
}
__device__ __forceinline__ void xcd_barrier(const XcdBarrier& b) {
    asm volatile("s_waitcnt vmcnt(0)" ::: "memory");
    __syncthreads();
    if (threadIdx.x == 0) {
        unsigned* bar = b.bar;
        __builtin_amdgcn_s_waitcnt(0);
        unsigned nloc = b.st[0], nx = b.st[1];
        if (nloc == 0u) { xcd_barrier_complete(bar, b.x, nloc, nx); b.st[0] = nloc; b.st[1] = nx; }
        const unsigned seq = b.st[2]; b.st[2] = seq + 1u;
        const unsigned old = xb_add(&bar[XB_XSUB(b.x)], 1u);
        if (old + 1u == (seq + 1u) * nloc) {
            __builtin_amdgcn_fence(__ATOMIC_RELEASE, "agent");
            asm volatile("s_waitcnt vmcnt(0)" ::: "memory");
            const unsigned og = xb_add(&bar[XB_TOP], 1u);
            if (og + 1u == (seq + 1u) * nx) xb_add(&bar[XB_TOPGEN], 1u);
            else XB_SPIN(xb_ld(&bar[XB_TOPGEN]) == seq, bar);
        } else {
            XB_SPIN(xb_ld(&bar[XB_TOPGEN]) == seq, bar);
        }
        __builtin_amdgcn_fence(__ATOMIC_ACQUIRE, "agent");
        asm volatile("s_waitcnt vmcnt(0)" ::: "memory");
    }
    __syncthreads();
}

namespace pg8 {
constexpr int BM = 256, BK = 64, HALF = 128, HTB = HALF * BK * 2, STAGE_BYTES = 8 * HTB, NXCD = 8, WGM = 8;
__host__ __device__ __forceinline__ int lds_byte(int r, int c) { const int st = (r >> 4) * 2 + (c >> 5), rr = r & 15, cc = c & 31, ob = rr * 64 + cc * 2; return st * 1024 + (ob ^ (((ob >> 9) & 1) << 5)); }
__host__ __device__ __forceinline__ void stage_rc(int b, int& R, int& C) { const int st = b / 1024, sb = b % 1024, swz = sb ^ (((sb >> 9) & 1) << 5); R = (st >> 1) * 16 + swz / 64; C = (st & 1) * 32 + (swz % 64) / 2; }
__host__ __device__ __forceinline__ int perm32(int rho) { const int n = rho >> 4, i = rho & 15; return 8 * (i >> 2) + 4 * n + (i & 3); }
struct Unit { int pm, pn; };
struct Gemm { const bf16_t* A; const bf16_t* Bt; int lda, ldb, K; int gs = 16; };
struct StaticOrder {
    int nM, nN, nwg, G, c;
    __device__ void init(int M, int N, int G_, int c_) { nM = M / BM; nN = N / BM; nwg = nM * nN; G = G_; c = c_; }
    __device__ bool next(int i, Unit& u) const {
        const long L = (long)i * G + c; if (L >= nwg) return false;
        int wgid = (int)L; { const int q = nwg / NXCD, r = nwg % NXCD, xcd = wgid % NXCD, off = wgid / NXCD; wgid = (xcd < r ? xcd * (q + 1) : r * (q + 1) + (xcd - r) * q) + off; }
        const int nig = WGM * nN, gid = wgid / nig, fm = gid * WGM, gsz = (nM - fm) < WGM ? (nM - fm) : WGM;
        u.pm = fm + ((wgid % nig) % gsz); u.pn = (wgid % nig) / gsz; return true;
    }
};
struct S5Order2 { int G, c; __device__ bool next(int i, Unit& u) const { const int L = i * G + c; if (L >= 32 * S5NRT) return false; const int g = L / S5NRT; u.pm = g * S5NRT + L % S5NRT; u.pn = g; return true; } };
struct S5Order1 { int G, c; __device__ bool next(int i, Unit& u) const { const int L = i * G + c; if (L >= 32 * S5NRY * S5NCY) return false; const int g = L / (S5NRY * S5NCY), q = L % (S5NRY * S5NCY); u.pm = g * S5NRT + q / S5NCY; u.pn = g * S5NCY + q % S5NCY; return true; } };

template <class Epi, class Sched>
__device__ __forceinline__ void gemm_phase(LAS unsigned char* lds, const Gemm g, const Sched& S, const Epi& E) {
    int tid_ = threadIdx.x; asm volatile("" : "+v"(tid_));
    const int tid = tid_, wid = __builtin_amdgcn_readfirstlane(tid >> 6), lane = tid & 63, wr = wid >> 2, wc = wid & 3, fr = lane & 15, fq = lane >> 4;
    const int K = g.K, nt = K / BK;
    unsigned voffA[2], voffB[2];
#pragma unroll
    for (int i = 0; i < 2; ++i) { int R, C; stage_rc(tid * 16 + i * 8192, R, C); const int Rb = Epi::PERM ? ((R & ~31) + perm32(R & 31)) : R;
        voffA[i] = (unsigned)(R * g.lda + (C >> 4) * g.gs + (C & 15)) * 2u; voffB[i] = (unsigned)(Rb * g.ldb + C) * 2u; }
    const size_t kstep = (size_t)(BK * 2), kstepA = (size_t)g.gs * 8;
    const size_t hstepA = (size_t)HALF * g.lda * 2, hstepB = (size_t)HALF * g.ldb * 2;
    const size_t tstepA = 2 * hstepA, tstepB = 2 * hstepB;
    const unsigned ldsw = (unsigned)wid * 1024u;
    const int aoff = lds_byte(wr * 64 + fr, fq * 8), boff = lds_byte(wc * 32 + fr, fq * 8);
#define PG8_SA(b, h) (((b) * 2 + (h)) * HTB)
#define PG8_SB(b, h) ((4 + (b) * 2 + (h)) * HTB)
#define PG8_STAGE(bufoff, gbase, voff) do { _Pragma("unroll") for (int _i = 0; _i < 2; ++_i) \
        __builtin_amdgcn_global_load_lds((const unsigned*)((const char*)(gbase) + (voff)[_i]), (LAS unsigned*)(lds + (bufoff) + ldsw + _i * 8192), 16, 0, 0); } while (0)
#define PG8_LDA(dst, b, h) do { _Pragma("unroll") for (int m = 0; m < 4; ++m) _Pragma("unroll") for (int k = 0; k < 2; ++k) dst[m][k] = *(const LAS bf16x8*)(lds + PG8_SA(b, h) + aoff + m * 2048 + k * 1024); } while (0)
#define PG8_LDB(dst, b, h) do { _Pragma("unroll") for (int n = 0; n < 2; ++n) _Pragma("unroll") for (int k = 0; k < 2; ++k) dst[n][k] = *(const LAS bf16x8*)(lds + PG8_SB(b, h) + boff + n * 2048 + k * 1024); } while (0)
#define PG8_MMA(ai, bj, At, Bt) do { __builtin_amdgcn_s_setprio(1); _Pragma("unroll") for (int m = 0; m < 4; ++m) _Pragma("unroll") for (int n = 0; n < 2; ++n) _Pragma("unroll") for (int k = 0; k < 2; ++k) \
        acc[ai][bj][m][n] = __builtin_amdgcn_mfma_f32_16x16x32_bf16(Bt[n][k], At[m][k], acc[ai][bj][m][n], 0, 0, 0); __builtin_amdgcn_s_setprio(0); } while (0)
#define PG8_WAIT_V(n) asm volatile("s_waitcnt vmcnt(" #n ")" ::: "memory")
#define PG8_WAIT_L(n) asm volatile("s_waitcnt lgkmcnt(" #n ")" ::: "memory")
#define PG8_BAR __builtin_amdgcn_s_barrier()
#define PG8_SCHED __builtin_amdgcn_sched_barrier(0)
    Unit cur, nxt; int ui = 0;
    if (!S.next(0, cur)) return;
    f32x4 acc[2][2][4][2];
#pragma unroll
    for (int a = 0; a < 2; ++a)
#pragma unroll
        for (int b = 0; b < 2; ++b)
#pragma unroll
            for (int m = 0; m < 4; ++m)
#pragma unroll
                for (int n = 0; n < 2; ++n) acc[a][b][m][n] = (f32x4){0.f, 0.f, 0.f, 0.f};
    bf16x8 At[4][2], B0[2][2], B1[2][2];
    const char* cA = (const char*)g.A + (size_t)cur.pm * tstepA; const char* cB = (const char*)g.Bt + (size_t)cur.pn * tstepB;
    PG8_STAGE(PG8_SB(0, 0), cB, voffB); PG8_STAGE(PG8_SA(0, 0), cA, voffA); PG8_STAGE(PG8_SB(0, 1), cB + hstepB, voffB); PG8_STAGE(PG8_SA(0, 1), cA + hstepA, voffA);
    if (wr == 1) PG8_BAR;
    PG8_WAIT_V(4); PG8_BAR;
    PG8_STAGE(PG8_SB(1, 0), cB + kstep, voffB); PG8_STAGE(PG8_SA(1, 0), cA + kstepA, voffA); PG8_STAGE(PG8_SB(1, 1), cB + hstepB + kstep, voffB);
    PG8_WAIT_V(6); PG8_BAR;
    for (;;) {
        const bool has_next = S.next(ui + 1, nxt);
        const char* nA = has_next ? (const char*)g.A + (size_t)nxt.pm * tstepA : cA; const char* nB = has_next ? (const char*)g.Bt + (size_t)nxt.pn * tstepB : cB;
        for (int t = 0; t < nt; t += 2) {
            const bool last = (t == nt - 2);
            const char* a1 = cA + (size_t)(t + 1) * kstepA;
            const char* a2 = last ? nA : cA + (size_t)(t + 2) * kstepA; const char* b2 = last ? nB : cB + (size_t)(t + 2) * kstep;
            const char* a3 = a2 + kstepA; const char* b3 = b2 + kstep;
            PG8_LDB(B0, 0, 0); PG8_SCHED; PG8_LDA(At, 0, 0); PG8_STAGE(PG8_SA(1, 1), a1 + hstepA, voffA);
            PG8_WAIT_L(8); PG8_BAR; PG8_WAIT_L(0); PG8_MMA(0, 0, At, B0); PG8_BAR; PG8_SCHED;
            PG8_LDB(B1, 0, 1); PG8_STAGE(PG8_SB(0, 0), b2, voffB);
            PG8_BAR; PG8_WAIT_L(0); PG8_MMA(0, 1, At, B1); PG8_BAR;
            PG8_LDA(At, 0, 1); PG8_STAGE(PG8_SA(0, 0), a2, voffA);
            PG8_BAR; PG8_WAIT_L(0); PG8_MMA(1, 0, At, B0); PG8_BAR; PG8_SCHED;
            PG8_STAGE(PG8_SB(0, 1), b2 + hstepB, voffB);
            PG8_WAIT_V(6); PG8_BAR; PG8_MMA(1, 1, At, B1); PG8_BAR;
            PG8_LDB(B0, 1, 0); PG8_SCHED; PG8_LDA(At, 1, 0); PG8_STAGE(PG8_SA(0, 1), a2 + hstepA, voffA);
            PG8_WAIT_L(8); PG8_BAR; PG8_WAIT_L(0); PG8_MMA(0, 0, At, B0); PG8_BAR; PG8_SCHED;
            PG8_LDB(B1, 1, 1); PG8_STAGE(PG8_SB(1, 0), b3, voffB);
            PG8_BAR; PG8_WAIT_L(0); PG8_MMA(0, 1, At, B1); PG8_BAR;
            PG8_LDA(At, 1, 1); PG8_STAGE(PG8_SA(1, 0), a3, voffA);
            PG8_BAR; PG8_WAIT_L(0); PG8_MMA(1, 0, At, B0); PG8_BAR; PG8_SCHED;
            PG8_STAGE(PG8_SB(1, 1), b3 + hstepB, voffB);
            PG8_WAIT_V(6); PG8_BAR; PG8_MMA(1, 1, At, B1); PG8_BAR;
        }
        if constexpr (!Epi::AFTER_DRAIN) E(acc, cur, wr, wc, fr, fq);
        if (!has_next) break;
#pragma unroll
        for (int a = 0; a < 2; ++a)
#pragma unroll
            for (int b = 0; b < 2; ++b)
#pragma unroll
                for (int m = 0; m < 4; ++m)
#pragma unroll
                    for (int n = 0; n < 2; ++n) acc[a][b][m][n] = (f32x4){0.f, 0.f, 0.f, 0.f};
        cur = nxt; cA = nA; cB = nB; ++ui;
    }
    PG8_WAIT_V(0);
    if (wr == 0) PG8_BAR;
    PG8_BAR;
    if constexpr (Epi::AFTER_DRAIN) E.fused(acc, cur, wr, wc, fr, fq, lds, wid, lane);
#undef PG8_SA
#undef PG8_SB
#undef PG8_STAGE
#undef PG8_LDA
#undef PG8_LDB
#undef PG8_MMA
#undef PG8_WAIT_V
#undef PG8_WAIT_L
#undef PG8_BAR
#undef PG8_SCHED
}
typedef f32x4 Acc[2][2][4][2];

__device__ __forceinline__ u32x4 pack8(const f32x4 v0, const f32x4 v1) { u32x4 w; w.x = pk2(v0[0], v0[1]); w.y = pk2(v0[2], v0[3]); w.z = pk2(v1[0], v1[1]); w.w = pk2(v1[2], v1[3]); return w; }

struct EpiZ {
    static constexpr bool PERM = true, AFTER_DRAIN = false;
    bf16_t* Z; bf16_t* Aall; bf16_t* SIG;
    __device__ __forceinline__ void operator()(const Acc& acc, const Unit& u, int wr, int wc, int fr, int fq) const {
#pragma unroll
        for (int ai = 0; ai < 2; ++ai)
#pragma unroll
            for (int m = 0; m < 4; ++m) {
                const int row = u.pm * BM + ai * HALF + wr * 64 + m * 16 + fr;
                int cr, s; if (row < NTL) { cr = (unsigned)row / S5C; s = (unsigned)row % S5C; } else { const unsigned rc = row - NTL; cr = S5LR + rc / S5C; s = rc % S5C; }
#pragma unroll
                for (int bj = 0; bj < 2; ++bj) {
                    const int col = u.pn * BM + bj * HALF + wc * 32 + 8 * fq;
                    const u32x4 w = pack8(acc[ai][bj][m][0], acc[ai][bj][m][1]);
                    if (col >= COL_GD && col < COL_U) { if (row < NTL) { f32x4 s0, s1;
#pragma unroll
                            for (int j = 0; j < 4; ++j) { s0[j] = sigmoidf_(acc[ai][bj][m][0][j]); s1[j] = sigmoidf_(acc[ai][bj][m][1][j]); }
                            *(u32x4*)(SIG + (size_t)row * 256 + (col - COL_GD)) = pack8(s0, s1); } }
                    else if (col < COL_U) *(u32x4*)(Z + zidx(row, col)) = w;
                    else if (col < DIN) { const int g = (col - COL_U) >> 4, h0 = (col - COL_U) & 15; *(u32x4*)(Aall + ((size_t)(g * S5ROWS + cr)) * S5K1 + s * 16 + h0) = w; }
                }
            }
    }
};
struct EpiE {
    static constexpr bool PERM = false, AFTER_DRAIN = false;
    float* E;
    __device__ __forceinline__ void operator()(const Acc& acc, const Unit& u, int wr, int wc, int fr, int fq) const {
        const int g = u.pn;
#pragma unroll
        for (int ai = 0; ai < 2; ++ai)
#pragma unroll
            for (int m = 0; m < 4; ++m) {
                const int cr = (u.pm - g * S5NRT) * BM + ai * HALF + wr * 64 + m * 16 + fr;
                if (cr < S5EROWS) {
                    float* rowp = E + ((size_t)(g * S5EROWS + cr)) * 256 + wc * 32 + 4 * fq;
#pragma unroll
                    for (int bj = 0; bj < 2; ++bj)
#pragma unroll
                        for (int n = 0; n < 2; ++n) *(f32x4*)(rowp + bj * HALF + n * 16) = acc[ai][bj][m][n];
                }
            }
    }
};
struct EpiY {
    static constexpr bool PERM = true, AFTER_DRAIN = false;
    const bf16_t* Aall; const float* dskip; bf16_t* ZG;
    __device__ __forceinline__ void operator()(const Acc& acc, const Unit& u, int wr, int wc, int fr, int fq) const {
        const int g = u.pn / S5NCY, pnn = u.pn % S5NCY;
        const int h0 = (8 * fq) & 15;
        const f32x4 d0 = *(const f32x4*)(dskip + g * 16 + h0), d1 = *(const f32x4*)(dskip + g * 16 + h0 + 4);
        const int crb = (u.pm - g * S5NRT) * BM + wr * 64 + fr;
        const int nb0 = pnn * BM + wc * 32 + 8 * fq;
        u32x4 uu[2][4];
#pragma unroll
        for (int k = 0; k < 5; ++k) {
            if (k < 4) {
#pragma unroll
                for (int q = 0; q < 4; ++q) { const int ai = k >> 1, m = 2 * (k & 1) + (q >> 1), bj = q & 1;
                    uu[k & 1][q] = *(const u32x4*)(Aall + ((size_t)(g * S5ROWS + crb + ai * HALF + m * 16)) * S5K1 + nb0 + bj * HALF); }
            }
            if (k > 0) {
                const int kk = k - 1;
#pragma unroll
                for (int q = 0; q < 4; ++q) { const int ai = kk >> 1, m = 2 * (kk & 1) + (q >> 1), bj = q & 1;
                    const int cr = crb + ai * HALF + m * 16, t = (nb0 + bj * HALF) >> 4;
                    const int tok = cr * S5C + t;
                    const u32x4 w = uu[kk & 1][q];
                    f32x4 y0 = acc[ai][bj][m][0], y1 = acc[ai][bj][m][1];
                    y0[0] += d0[0] * bflo(w.x); y0[1] += d0[1] * bfhi(w.x); y0[2] += d0[2] * bflo(w.y); y0[3] += d0[3] * bfhi(w.y);
                    y1[0] += d1[0] * bflo(w.z); y1[1] += d1[1] * bfhi(w.z); y1[2] += d1[2] * bflo(w.w); y1[3] += d1[3] * bfhi(w.w);
#pragma unroll
                    for (int j = 0; j < 4; ++j) { y0[j] = gelu_tanh(y0[j]); y1[j] = gelu_tanh(y1[j]); }
                    *(u32x4*)(ZG + ((size_t)g * NTL + tok) * 16 + h0) = pack8(y0, y1);
                }
            }
        }
    }
};
struct EpiG {
    static constexpr bool PERM = true, AFTER_DRAIN = false;
    bf16_t* G;
    __device__ __forceinline__ void operator()(const Acc& acc, const Unit& u, int wr, int wc, int fr, int fq) const {
#pragma unroll
        for (int ai = 0; ai < 2; ++ai)
#pragma unroll
            for (int m = 0; m < 4; ++m) {
                const int row = u.pm * BM + ai * HALF + wr * 64 + m * 16 + fr;
#pragma unroll
                for (int bj = 0; bj < 2; ++bj) { const int col = u.pn * BM + bj * HALF + wc * 32 + 8 * fq; *(u32x4*)(G + (size_t)row * 512 + col) = pack8(acc[ai][bj][m][0], acc[ai][bj][m][1]); }
            }
    }
};
struct EpiGLU {
    static constexpr bool PERM = true, AFTER_DRAIN = false;
    const bf16_t* ZG; const float* bias; bf16_t* MIX;
    __device__ __forceinline__ void operator()(const Acc& acc, const Unit& u, int wr, int wc, int fr, int fq) const {
        const int colb = u.pn * BM + wc * 32 + 8 * fq, rowb = u.pm * BM + wr * 64 + fr;
        f32x4 bb[2][2];
#pragma unroll
        for (int bj = 0; bj < 2; ++bj) { bb[bj][0] = *(const f32x4*)(bias + colb + bj * HALF); bb[bj][1] = *(const f32x4*)(bias + colb + bj * HALF + 4); }
        u32x4 zq[2][4];
#pragma unroll
        for (int k = 0; k < 5; ++k) {
            if (k < 4) {
#pragma unroll
                for (int q = 0; q < 4; ++q) { const int ai = k >> 1, m = 2 * (k & 1) + (q >> 1), bj = q & 1;
                    { const int col = colb + bj * HALF; zq[k & 1][q] = *(const u32x4*)(ZG + ((size_t)(col >> 4) * NTL + rowb + ai * HALF + m * 16) * 16 + (col & 15)); } }
            }
            if (k > 0) {
                const int kk = k - 1;
#pragma unroll
                for (int q = 0; q < 4; ++q) { const int ai = kk >> 1, m = 2 * (kk & 1) + (q >> 1), bj = q & 1;
                    const u32x4 zz = zq[kk & 1][q];
                    f32x4 y0 = acc[ai][bj][m][0] + bb[bj][0], y1 = acc[ai][bj][m][1] + bb[bj][1];
                    y0[0] = bflo(zz.x) * sigmoidf_(y0[0]); y0[1] = bfhi(zz.x) * sigmoidf_(y0[1]); y0[2] = bflo(zz.y) * sigmoidf_(y0[2]); y0[3] = bfhi(zz.y) * sigmoidf_(y0[3]);
                    y1[0] = bflo(zz.z) * sigmoidf_(y1[0]); y1[1] = bfhi(zz.z) * sigmoidf_(y1[1]); y1[2] = bflo(zz.w) * sigmoidf_(y1[2]); y1[3] = bfhi(zz.w) * sigmoidf_(y1[3]);
                    *(u32x4*)(MIX + (size_t)(rowb + ai * HALF + m * 16) * DM + 512 + colb + bj * HALF) = pack8(y0, y1);
                }
            }
        }
    }
};
struct EpiRes {
    static constexpr bool PERM = false, AFTER_DRAIN = false;
    const float* base; float* out; const float* gate;
    __device__ __forceinline__ void operator()(const Acc& acc, const Unit& u, int wr, int wc, int fr, int fq) const {
        const int b = u.pm >> 4;
        const int col0 = u.pn * BM + wc * 32 + 4 * fq;
        f32x4 gv[2][2];
#pragma unroll
        for (int bj = 0; bj < 2; ++bj)
#pragma unroll
            for (int n = 0; n < 2; ++n) gv[bj][n] = *(const f32x4*)(gate + (size_t)b * 6144 + col0 + bj * HALF + n * 16);
#pragma unroll
        for (int ai = 0; ai < 2; ++ai)
#pragma unroll
            for (int m = 0; m < 4; ++m) {
                const size_t off = (size_t)(u.pm * BM + ai * HALF + wr * 64 + m * 16 + fr) * DM + col0;
#pragma unroll
                for (int bj = 0; bj < 2; ++bj)
#pragma unroll
                    for (int n = 0; n < 2; ++n) { const f32x4 bs = *(const f32x4*)(base + off + bj * HALF + n * 16); *(f32x4*)(out + off + bj * HALF + n * 16) = bs + gv[bj][n] * acc[ai][bj][m][n]; }
            }
    }
};
struct EpiUp {
    static constexpr bool PERM = true, AFTER_DRAIN = false;
    bf16_t* ACT;
    __device__ __forceinline__ void operator()(const Acc& acc, const Unit& u, int wr, int wc, int fr, int fq) const {
#pragma unroll
        for (int ai = 0; ai < 2; ++ai)
#pragma unroll
            for (int m = 0; m < 4; ++m) {
                const int row = u.pm * BM + ai * HALF + wr * 64 + m * 16 + fr;
                const int col = u.pn * HALF + wc * 32 + 8 * fq;
                f32x4 y0, y1;
#pragma unroll
                for (int j = 0; j < 4; ++j) { y0[j] = siluf_(acc[ai][0][m][0][j]) * acc[ai][1][m][0][j]; y1[j] = siluf_(acc[ai][0][m][1][j]) * acc[ai][1][m][1][j]; }
                *(u32x4*)(ACT + ((size_t)(col >> 4) * NTL + row) * 16 + (col & 15)) = pack8(y0, y1);
            }
    }
};
struct PanelSumsq {
    float* xbuf; unsigned* cnt;
    __device__ __forceinline__ void run(const Acc& v, const Unit& u, int wr, int wc, int fr, int fq, LAS unsigned char* lds, int wid, int lane) const {
        LAS float* P = (LAS float*)lds; LAS float* S = (LAS float*)(lds + 8192);
#pragma unroll
        for (int ai = 0; ai < 2; ++ai)
#pragma unroll
            for (int m = 0; m < 4; ++m) {
                float s = 0.f;
#pragma unroll
                for (int bj = 0; bj < 2; ++bj)
#pragma unroll
                    for (int n = 0; n < 2; ++n) { const f32x4 x = v[ai][bj][m][n]; s += (x[0] * x[0] + x[1] * x[1]) + (x[2] * x[2] + x[3] * x[3]); }
                s += __shfl_xor(s, 16); s += __shfl_xor(s, 32);
                if (fq == 0) P[(ai * HALF + wr * 64 + m * 16 + fr) * 4 + wc] = s;
            }
        asm volatile("s_waitcnt lgkmcnt(0)" ::: "memory"); __builtin_amdgcn_s_barrier(); asm volatile("" ::: "memory");
        const int row = wid * 32 + (lane & 31);
        if (lane < 32) { const f32x4 p = *(const LAS f32x4*)(P + row * 4);
            __hip_atomic_store(xbuf + ((size_t)(u.pm * BM + row)) * 4 + u.pn, (p[0] + p[1]) + (p[2] + p[3]), __ATOMIC_RELAXED, __HIP_MEMORY_SCOPE_AGENT); }
        asm volatile("s_waitcnt vmcnt(0)" ::: "memory");
        if (lane == 0) __hip_atomic_fetch_add(cnt + 64 * u.pm, 1u, __ATOMIC_RELAXED, __HIP_MEMORY_SCOPE_AGENT);
        if (wid == 0) {
            unsigned sp = 0;
            while ((unsigned)__builtin_amdgcn_readfirstlane(__hip_atomic_load(cnt + 64 * u.pm, __ATOMIC_RELAXED, __HIP_MEMORY_SCOPE_AGENT)) < 32u) { __builtin_amdgcn_s_sleep(2); if (++sp > (1u << 22)) break; }
            __builtin_amdgcn_fence(__ATOMIC_ACQUIRE, "agent");
        }
        asm volatile("s_waitcnt vmcnt(0) lgkmcnt(0)" ::: "memory"); __builtin_amdgcn_s_barrier(); asm volatile("" ::: "memory");
        if (lane < 32) { const float* slot = xbuf + ((size_t)(u.pm * BM + row)) * 4; float t = 0.f;
#pragma unroll
            for (int q = 0; q < 4; ++q) t += __hip_atomic_load(slot + q, __ATOMIC_RELAXED, __HIP_MEMORY_SCOPE_AGENT);
            S[row] = t; }
        asm volatile("s_waitcnt vmcnt(0) lgkmcnt(0)" ::: "memory"); __builtin_amdgcn_s_barrier(); asm volatile("" ::: "memory");
    }
};
#define DBG_MARK(id) do { if (PROBE_PHT == (id) && blockIdx.x == PROBE_BID && threadIdx.x == 0) *dbg = __builtin_amdgcn_s_memrealtime(); } while (0)
struct EpiWoutNorm {
    static constexpr bool PERM = false, AFTER_DRAIN = true;
    const float* base; float* X1; const float* mod; const float* g2; bf16_t* H2; PanelSumsq st; unsigned long long* dbg;
    __device__ __forceinline__ void fused(Acc& acc, const Unit& u, int wr, int wc, int fr, int fq, LAS unsigned char* lds, int wid, int lane) const {
        const int b = u.pm >> 4, col0 = u.pn * BM + wc * 32 + 4 * fq;
        const float* mb = mod + (size_t)b * 6144;
        const size_t off0 = (size_t)(u.pm * BM + wr * 64 + fr) * DM + col0;
        DBG_MARK(41);
        {
            f32x4 gv[4];
#pragma unroll
            for (int c = 0; c < 4; ++c) gv[c] = *(const f32x4*)(mb + 2 * 1024 + col0 + (c >> 1) * HALF + (c & 1) * 16);
            f32x4 bs[2][8];
#pragma unroll
            for (int k = 0; k < 5; ++k) {
                if (k < 4) {
#pragma unroll
                    for (int q = 0; q < 8; ++q) { const int ai = k >> 1, m = 2 * (k & 1) + (q >> 2), c = q & 3;
                        bs[k & 1][q] = __builtin_nontemporal_load((const f32x4*)(base + off0 + (size_t)(ai * HALF + m * 16) * DM + (c >> 1) * HALF + (c & 1) * 16)); }
                }
                if (k > 0) {
                    const int kk = k - 1, ai = kk >> 1, m0 = 2 * (kk & 1);
#pragma unroll
                    for (int q = 0; q < 8; ++q) { const int m = m0 + (q >> 2), c = q & 3;
                        acc[ai][c >> 1][m][c & 1] = bs[kk & 1][q] + gv[c] * acc[ai][c >> 1][m][c & 1]; }
                    asm volatile("" : "+v"(acc[ai][0][m0][0]), "+v"(acc[ai][0][m0][1]), "+v"(acc[ai][1][m0][0]), "+v"(acc[ai][1][m0][1]),
                                      "+v"(acc[ai][0][m0 + 1][0]), "+v"(acc[ai][0][m0 + 1][1]), "+v"(acc[ai][1][m0 + 1][0]), "+v"(acc[ai][1][m0 + 1][1]) : : "memory");
                }
            }
        }
        if (PROBE_PHT == 42) { asm volatile("s_waitcnt vmcnt(0)" ::: "memory"); DBG_MARK(42); }
        st.run(acc, u, wr, wc, fr, fq, lds, wid, lane);
        DBG_MARK(43);
        const LAS float* S = (const LAS float*)(lds + 8192);
        f32x4 ca[4], sh[4];
        float* const x1p = X1 + ((size_t)((u.pm * 4 + u.pn) * 8 + wid) * 32) * 256 + lane * 4;
#pragma unroll
        for (int c = 0; c < 4; ++c) { const int co = (c >> 1) * HALF + (c & 1) * 16;
            const f32x4 gg = *(const f32x4*)(g2 + col0 + co), sc = *(const f32x4*)(mb + 4 * 1024 + col0 + co); sh[c] = *(const f32x4*)(mb + 3 * 1024 + col0 + co); ca[c] = gg * (sc + 1.0f); }
#pragma unroll
        for (int ai = 0; ai < 2; ++ai)
#pragma unroll
            for (int m = 0; m < 4; ++m) { const int r = ai * HALF + wr * 64 + m * 16 + fr; const float rstd = 1.0f / sqrtf(S[r] * (1.f / DM) + 1e-6f);
#pragma unroll
                for (int c = 0; c < 4; ++c) {
                    const f32x4 x1 = acc[ai][c >> 1][m][c & 1]; const size_t o_ = off0 + (size_t)(ai * HALF + m * 16) * DM + (c >> 1) * HALF + (c & 1) * 16;
                    *(f32x4*)(x1p + (size_t)((ai * 4 + m) * 4 + c) * 256) = x1;
                    const f32x4 y = x1 * rstd * ca[c] + sh[c];
                    u32x2 w; w.x = pk2(y[0], y[1]); w.y = pk2(y[2], y[3]);
                    *(u32x2*)(H2 + ((size_t)(u.pn * 16 + (c >> 1) * 8 + wc * 2 + (c & 1)) * NTL + (u.pm * BM + ai * HALF + wr * 64 + m * 16 + fr)) * 16 + 4 * fq) = w; }
            }
        if (PROBE_PHT == 44) { asm volatile("s_waitcnt vmcnt(0)" ::: "memory"); DBG_MARK(44); }
    }
};
struct EpiDownNorm {
    static constexpr bool PERM = false, AFTER_DRAIN = true;
    float* out; const float* X1; const float* mod; const float* fg; PanelSumsq st;
    __device__ __forceinline__ void fused(Acc& acc, const Unit& u, int wr, int wc, int fr, int fq, LAS unsigned char* lds, int wid, int lane) const {
        const int b = u.pm >> 4, col0 = u.pn * BM + wc * 32 + 4 * fq;
        const float* mb = mod + (size_t)b * 6144;
        const size_t off0 = (size_t)(u.pm * BM + wr * 64 + fr) * DM + col0;
        {
            f32x4 gv[4];
#pragma unroll
            for (int c = 0; c < 4; ++c) gv[c] = *(const f32x4*)(mb + 5 * 1024 + col0 + (c >> 1) * HALF + (c & 1) * 16);
            f32x4 bs[2][8];
            const float* const x1p = X1 + ((size_t)((u.pm * 4 + u.pn) * 8 + wid) * 32) * 256 + lane * 4;
#pragma unroll
            for (int k = 0; k < 5; ++k) {
                if (k < 4) {
#pragma unroll
                    for (int q = 0; q < 8; ++q) { const int ai = k >> 1, m = 2 * (k & 1) + (q >> 2), c = q & 3;
                        bs[k & 1][q] = __builtin_nontemporal_load((const f32x4*)(x1p + (size_t)((ai * 4 + m) * 4 + c) * 256)); }
                }
                if (k > 0) {
                    const int kk = k - 1, ai = kk >> 1, m0 = 2 * (kk & 1);
#pragma unroll
                    for (int q = 0; q < 8; ++q) { const int m = m0 + (q >> 2), c = q & 3;
                        acc[ai][c >> 1][m][c & 1] = bs[kk & 1][q] + gv[c] * acc[ai][c >> 1][m][c & 1]; }
                    asm volatile("" : "+v"(acc[ai][0][m0][0]), "+v"(acc[ai][0][m0][1]), "+v"(acc[ai][1][m0][0]), "+v"(acc[ai][1][m0][1]),
                                      "+v"(acc[ai][0][m0 + 1][0]), "+v"(acc[ai][0][m0 + 1][1]), "+v"(acc[ai][1][m0 + 1][0]), "+v"(acc[ai][1][m0 + 1][1]) : : "memory");
                }
            }
        }
        st.run(acc, u, wr, wc, fr, fq, lds, wid, lane);
        const LAS float* S = (const LAS float*)(lds + 8192);
        f32x4 fgv[4];
#pragma unroll
        for (int c = 0; c < 4; ++c) fgv[c] = *(const f32x4*)(fg + col0 + (c >> 1) * HALF + (c & 1) * 16);
        const bool hi8 = (fr & 8) != 0;
        const size_t offx = (size_t)(u.pm * BM + wr * 64 + (fr & 7)) * DM + u.pn * BM + wc * 32 + (hi8 ? 16 : 0) + 4 * fq;
#pragma unroll
        for (int ai = 0; ai < 2; ++ai)
#pragma unroll
            for (int m = 0; m < 4; ++m) { const int r = ai * HALF + wr * 64 + m * 16 + fr; const float rstd = 1.0f / sqrtf(S[r] * (1.f / DM) + 1e-6f);
#pragma unroll
                for (int bj = 0; bj < 2; ++bj) {
                    const f32x4 x0 = acc[ai][bj][m][0] * rstd * fgv[bj * 2], x1 = acc[ai][bj][m][1] * rstd * fgv[bj * 2 + 1];
                    f32x4 s1, s2;
#pragma unroll
                    for (int j = 0; j < 4; ++j) { const float y1 = dppf<0x128>(x1[j]), z0 = dppf<0x128>(x0[j]); s1[j] = hi8 ? y1 : x0[j]; s2[j] = hi8 ? x1[j] : z0; }
                    float* o = out + offx + (size_t)(ai * HALF + m * 16) * DM + bj * HALF;
                    *(f32x4*)o = s1; *(f32x4*)(o + (size_t)8 * DM) = s2;
                }
            }
    }
};
}


__device__ __forceinline__ void transpose_item(const float* W, int K, int N, bf16_t* WT, int ldt, int k0, int n0, int drow0, LAS float* scr, int lane) {
    {
        f32x4 v[8]; const int kr = lane >> 3, c4 = (lane & 7) * 4;
#pragma unroll
        for (int i = 0; i < 8; ++i) v[i] = __builtin_nontemporal_load((const f32x4*)(W + (size_t)(k0 + 8 * i + kr) * N + n0 + c4));
#pragma unroll
        for (int i = 0; i < 8; ++i) { LAS float* d = scr + (8 * i + kr) * 33 + c4; d[0] = v[i][0]; d[1] = v[i][1]; d[2] = v[i][2]; d[3] = v[i][3]; }
    }
    asm volatile("s_waitcnt lgkmcnt(0)" ::: "memory");
    const int c = lane & 7;
#pragma unroll
    for (int j = 0; j < 4; ++j) { const int n = (lane >> 3) + 8 * j; const LAS float* s = scr + (8 * c) * 33 + n;
        u32x4 o; o.x = pk2(s[0 * 33], s[1 * 33]); o.y = pk2(s[2 * 33], s[3 * 33]); o.z = pk2(s[4 * 33], s[5 * 33]); o.w = pk2(s[6 * 33], s[7 * 33]);
        *(u32x4*)(WT + (size_t)(drow0 + n) * ldt + k0 + 8 * c) = o; }
    asm volatile("s_waitcnt lgkmcnt(0)" ::: "memory");
}

__device__ __forceinline__ void p0_weights(const Args& a, LAS unsigned char* lds, int bid, int nb, int part) {
    const int tid = opaque_tid(), lane = tid & 63, wave = tid >> 6;
    LAS float* scr = (LAS float*)(lds + wave * 8704);
    bf16_t* WTIN = (bf16_t*)(a.ws + WS_WTIN); bf16_t* WTOUT = (bf16_t*)(a.ws + WS_WTOUT); bf16_t* WT13 = (bf16_t*)(a.ws + WS_WT13);
    bf16_t* WT2 = (bf16_t*)(a.ws + WS_WT2); bf16_t* WTGLU = (bf16_t*)(a.ws + WS_WTGLU);
    constexpr int I_IN = 16 * 71, I_OUT = 16 * 32, I_1 = 16 * 88, I_2 = 44 * 32, I_GLU = 8 * 16;
    constexpr int NIT = I_IN + I_OUT + 2 * I_1 + I_2 + I_GLU;
    const int gw = bid * 8 + wave, NGW = nb * 8;
    for (int it = (part ? I_IN : 0) + gw; it < (part ? NIT : I_IN); it += NGW) {
        int r = it;
        if (r < I_IN) { const int kb = r / 71, nbk = r % 71; transpose_item(a.in[8], 1024, DIN, WTIN, 1024, kb * 64, nbk * 32, nbk * 32, scr, lane); continue; } r -= I_IN;
        if (r < I_OUT) { const int kb = r / 32, nbk = r % 32; transpose_item(a.in[9], 1024, 1024, WTOUT, 1024, kb * 64, nbk * 32, nbk * 32, scr, lane); continue; } r -= I_OUT;
        if (r < 2 * I_1) { const int sel = r / I_1; r -= sel * I_1; const int kb = r / 88, nbk = r % 88, n0 = nbk * 32;
            transpose_item(a.in[sel ? 32 : 31], 1024, DFF, WT13, 1024, kb * 64, n0, (n0 >> 7) * 256 + (n0 & 127) + sel * 128, scr, lane); continue; } r -= 2 * I_1;
        if (r < I_2) { const int kb = r / 32, nbk = r % 32; transpose_item(a.in[33], DFF, 1024, WT2, DFF, kb * 64, nbk * 32, nbk * 32, scr, lane); continue; } r -= I_2;
        { const int kb = r / 16, nbk = r % 16; transpose_item(a.in[29], 512, 512, WTGLU, 512, kb * 64, nbk * 32, nbk * 32, scr, lane); }
    }
    if (part) return;
    bf16_t* W2T = (bf16_t*)(a.ws + WS_W2T);
    for (int i = bid * NTHREADS + tid; i < 2 * 2 * 512 * 32; i += nb * NTHREADS) { const int j = i & 31, c = (i >> 5) & 511, d = (i >> 14) & 1, which = i >> 15; W2T[i] = (bf16_t)f2bf(a.in[which ? 14 : 12][(d * 32 + j) * 512 + c]); }
    bf16_t* G2T = (bf16_t*)(a.ws + WS_G2T); bf16_t* SIG = (bf16_t*)(a.ws + WS_SIG);
    for (int i = bid * NTHREADS + tid; i < 512 * 256; i += nb * NTHREADS) { const int n = i >> 8, k = i & 255; G2T[i] = k < 96 ? (bf16_t)f2bf(a.in[15][k * 512 + n]) : (bf16_t)0; }
    for (int i = bid * NTHREADS + tid; i < NTL * 20; i += nb * NTHREADS) { const int row = i / 20, q = i % 20; *(u32x4*)(SIG + (size_t)row * 256 + 96 + q * 8) = (u32x4){0u, 0u, 0u, 0u}; }
}

__device__ __forceinline__ void p0_mod(const Args& a, LAS unsigned char* lds, int bid, int nb) {
    const int tid = opaque_tid();
    LAS float* sc = (LAS float*)lds;
    LAS float* red = sc + 5 * 1024;
    float* MOD = (float*)(a.ws + WS_MOD);
    bool filled = false;
    for (int cb = bid; cb < 192; cb += nb) {
        const int col = cb * 32 + (tid & 31), kp = tid >> 5;
        const float* wp = a.in[4] + (size_t)(kp * 64) * 6144 + col;
        float w[64];
#pragma unroll
        for (int k = 0; k < 64; ++k) w[k] = __builtin_nontemporal_load(wp + (size_t)k * 6144);
        if (!filled) {
            for (int i = tid; i < 5 * 1024; i += NTHREADS) { const float v = (i < 4096) ? a.in[1][i] : a.in[3][i - 4096]; sc[i] = siluf_(v); }
            filled = true; __syncthreads();
        }
        float acc[5] = {0.f, 0.f, 0.f, 0.f, 0.f};
#pragma unroll
        for (int k = 0; k < 64; ++k)
#pragma unroll
            for (int r = 0; r < 5; ++r) acc[r] += sc[r * 1024 + kp * 64 + k] * w[k];
#pragma unroll
        for (int r = 0; r < 5; ++r) red[(kp * 5 + r) * 32 + (tid & 31)] = acc[r];
        __syncthreads();
        if (tid < 160) { const int r = tid >> 5, c = tid & 31; float s = 0.f;
#pragma unroll
            for (int k = 0; k < 16; ++k) s += red[(k * 5 + r) * 32 + c];
            __hip_atomic_store(MOD + r * 6144 + cb * 32 + c, s + a.in[5][cb * 32 + c], __ATOMIC_RELAXED, __HIP_MEMORY_SCOPE_AGENT); }
        asm volatile("s_waitcnt vmcnt(0)" ::: "memory");
        __syncthreads();
        if (tid == 0) __hip_atomic_fetch_add((unsigned*)(a.ws + WS_CTL + 49152), 1u, __ATOMIC_RELAXED, __HIP_MEMORY_SCOPE_AGENT);
    }
}
__device__ __forceinline__ void mod_wait(const Args& a) {
    if (opaque_tid() < 64) { unsigned sp = 0;
        while ((unsigned)__builtin_amdgcn_readfirstlane(__hip_atomic_load((unsigned*)(a.ws + WS_CTL + 49152), __ATOMIC_RELAXED, __HIP_MEMORY_SCOPE_AGENT)) < 192u) { __builtin_amdgcn_s_sleep(2); if (++sp > (1u << 22)) break; }
        __builtin_amdgcn_fence(__ATOMIC_ACQUIRE, "agent"); asm volatile("s_waitcnt vmcnt(0)" ::: "memory"); }
    __syncthreads();
}

__device__ __forceinline__ void p0_s5(const Args& a, LAS unsigned char* lds, int bid, int nb, int item_lo = 0, int item_hi = 256) {
    const int tid = opaque_tid();
    constexpr int PWN = S5C + 1;
    LAS float* pw  = (LAS float*)lds;
    LAS float* bb  = pw + 2 * PWN * 64 * 2;
    LAS float* cc  = bb + 2 * 64 * 16 * 2;
    LAS float* qq  = cc + 16 * 64 * 2;
    bf16_t* BT1 = (bf16_t*)(a.ws + WS_BT1); bf16_t* BT2 = (bf16_t*)(a.ws + WS_BT2); float* TAB = (float*)(a.ws + WS_S5TAB); float* KT = (float*)(a.ws + WS_KT);
    const float* lam_re = a.in[21]; const float* lam_im = a.in[22]; const float* log_step = a.in[23];
    const float* b_re = a.in[24]; const float* b_im = a.in[25]; const float* c_re = a.in[26]; const float* c_im = a.in[27];
    for (int item = item_lo + bid; item < item_hi; item += nb) {
        const int g = item >> 3, part = item & 7;
        float brv[4], biv[4], crv[2], civ[2];
#pragma unroll
        for (int k = 0; k < 4; ++k) { const int i = tid + k * NTHREADS, h = i & 15, p = (i >> 4) & 63; brv[k] = b_re[(g * 64 + p) * 16 + h]; biv[k] = b_im[(g * 64 + p) * 16 + h]; }
#pragma unroll
        for (int k = 0; k < 2; ++k) { const int i = tid + k * NTHREADS; crv[k] = c_re[g * 1024 + i]; civ[k] = c_im[g * 1024 + i]; }
        float ls_ = 0.f, lr_ = 1.f, li_ = 0.f;
        if (tid < 128) { const int p = tid & 63, d = tid >> 6; ls_ = log_step[d * 32 + g]; lr_ = lam_re[(d * 32 + g) * 64 + p]; li_ = lam_im[(d * 32 + g) * 64 + p]; }
        __syncthreads();
        if (tid < 128) {
            const int p = tid & 63, d = tid >> 6;
            const float step = expf(ls_);
            const float lr = lr_, li = li_;
            const float mag = expf(lr * step); float sn, cs; sincosf(li * step, &sn, &cs);
            const float lbr = mag * cs, lbi = mag * sn, den = lr * lr + li * li, nr = lbr - 1.f;
            qq[tid * 2] = (nr * lr + lbi * li) / den; qq[tid * 2 + 1] = (lbi * lr - nr * li) / den;
            float pr = 1.f, pi = 0.f;
#pragma unroll 1
            for (int n = 0; n <= S5C; ++n) { pw[((d * PWN + n) * 64 + p) * 2] = pr; pw[((d * PWN + n) * 64 + p) * 2 + 1] = pi; const float t = pr * lbr - pi * lbi; pi = pr * lbi + pi * lbr; pr = t; }
        }
        __syncthreads();
#pragma unroll
        for (int k = 0; k < 4; ++k) {
            const int i = tid + k * NTHREADS, p = (i >> 4) & 63, d = i >> 10;
            const float qr = qq[(d * 64 + p) * 2], qi = qq[(d * 64 + p) * 2 + 1];
            const float br = brv[k], bi = biv[k];
            bb[i * 2] = qr * br - qi * bi; bb[i * 2 + 1] = qr * bi + qi * br;
        }
#pragma unroll
        for (int k = 0; k < 2; ++k) { const int i = tid + k * NTHREADS; cc[i * 2] = crv[k]; cc[i * 2 + 1] = civ[k]; }
        __syncthreads();
        if (part == 0 && tid < 128) { const int d = tid >> 6, p = tid & 63; TAB[((d * 32 + g) * 64 + p) * 2] = pw[((d * PWN + S5C) * 64 + p) * 2]; TAB[((d * 32 + g) * 64 + p) * 2 + 1] = pw[((d * PWN + S5C) * 64 + p) * 2 + 1]; }
        {
            constexpr int PP = S5C / 4, HQN = 32 / PP, NV = 16 / HQN;
            const int hq = tid % HQN, h = (tid / HQN) & 15, q = part * PP + tid / (HQN * 16), d = q / S5C, tau = q % S5C;
            float s[NV];
#pragma unroll
            for (int v = 0; v < NV; ++v) s[v] = 0.f;
#pragma unroll 4
            for (int p = 0; p < 64; ++p) {
                const f32x2 c2 = *(LAS f32x2*)(cc + (h * 64 + p) * 2), p2 = *(LAS f32x2*)(pw + ((d * PWN + tau) * 64 + p) * 2);
                const float xr = c2.x * p2.x - c2.y * p2.y, xi = c2.x * p2.y + c2.y * p2.x;
#pragma unroll
                for (int v = 0; v < NV; v += 2) {
                    const f32x4 b0 = *(LAS f32x4*)(bb + ((d * 64 + p) * 16 + NV * hq + v) * 2);
                    s[v] += xr * b0[0] - xi * b0[1]; s[v + 1] += xr * b0[2] - xi * b0[3];
                }
            }
#pragma unroll
            for (int v = 0; v < NV; v += 2) { f32x2 o; o.x = s[v]; o.y = s[v + 1]; *(f32x2*)(KT + ((size_t)(g * 2 * S5C + q) * 16 + h) * 16 + NV * hq + v) = o; }
        }
        constexpr int RPP = S5U / 8;
        for (int i = tid; i < RPP * 128; i += NTHREADS) {
            const int rl = i >> 7, kp = (i & 127) * 2;
            const int n = part * RPP + rl, t = n >> 4, h = n & 15;
            const int d = kp >> 7, p = (kp >> 1) & 63;
            const int np = d ? (S5C - t) : (t + 1);
            const float ar = pw[((d * PWN + np) * 64 + p) * 2], ai = pw[((d * PWN + np) * 64 + p) * 2 + 1];
            const float cr = cc[(h * 64 + p) * 2], ci = cc[(h * 64 + p) * 2 + 1];
            *(unsigned*)(BT1 + ((size_t)(g * S5U + n)) * S5K1 + S5U + kp) = pk2(cr * ar - ci * ai, -cr * ai - ci * ar);
        }
        for (int i = tid; i < 32 * (S5U / 2); i += NTHREADS) {
            const int rl = i / (S5U / 2), kp = (i % (S5U / 2)) * 2;
            const int n = part * 32 + rl, d = n >> 7, p = (n >> 1) & 63, ri = n & 1;
            float v[2];
#pragma unroll
            for (int e = 0; e < 2; ++e) {
                const int k = kp + e, s = k >> 4, hp = k & 15;
                const int np = d ? s : (S5C - 1 - s);
                const float ar = pw[((d * PWN + np) * 64 + p) * 2], ai = pw[((d * PWN + np) * 64 + p) * 2 + 1];
                const float br = bb[((d * 64 + p) * 16 + hp) * 2], bi = bb[((d * 64 + p) * 16 + hp) * 2 + 1];
                v[e] = ri ? (ar * bi + ai * br) : (ar * br - ai * bi);
            }
            *(unsigned*)(BT2 + ((size_t)(g * 256 + n)) * S5U + kp) = pk2(v[0], v[1]);
        }
    }
    __syncthreads();
}
__device__ __forceinline__ void p1_s5(const Args& a, LAS unsigned char* lds, int bid, int nb) {
    const int tid = opaque_tid();
    LAS float* kt = (LAS float*)lds;
    bf16_t* BT1 = (bf16_t*)(a.ws + WS_BT1); const float* KT = (const float*)(a.ws + WS_KT);
    constexpr int RPP = S5U / 8;
    for (int item = bid; item < 256; item += nb) {
        const int g = item >> 3, part = item & 7;
        __syncthreads();
        for (int i = tid; i < 2 * S5C * 64; i += NTHREADS) *(LAS f32x4*)(kt + 4 * i) = *(const f32x4*)(KT + (size_t)g * (2 * S5C * 256) + 4 * i);
        __syncthreads();
        for (int i = tid; i < RPP * (S5U / 2); i += NTHREADS) {
            const int rl = i / (S5U / 2), kp = (i % (S5U / 2)) * 2;
            const int n = part * RPP + rl, t = n >> 4, h = n & 15, s = kp >> 4, hp = kp & 15;
            const int dd = s > t ? 1 : 0, tau = s > t ? s - t : t - s;
            const f32x2 q = *(const LAS f32x2*)(kt + ((dd * S5C + tau) * 16 + h) * 16 + hp), q1 = *(const LAS f32x2*)(kt + ((S5C * 16 + h) * 16) + hp);
            const float dg = (s == t) ? 1.0f : 0.0f;
            *(unsigned*)(BT1 + ((size_t)(g * S5U + n)) * S5K1 + kp) = pk2(q.x + dg * q1.x, q.y + dg * q1.y);
        }
    }
    __syncthreads();
}

struct RowV { f32x4 v[4]; };
__device__ __forceinline__ RowV row_load(const float* xrow, int lane) { RowV r; const f32x4* xr = (const f32x4*)xrow + lane;
#pragma unroll
    for (int j = 0; j < 4; ++j) r.v[j] = __builtin_nontemporal_load(xr + 64 * j);
    return r; }
__device__ __forceinline__ float row_rstd(const RowV& r) { float s = 0.f;
#pragma unroll
    for (int j = 0; j < 4; ++j) s += (r.v[j].x * r.v[j].x + r.v[j].y * r.v[j].y) + (r.v[j].z * r.v[j].z + r.v[j].w * r.v[j].w);
    return 1.0f / sqrtf(wave_sum(s) * (1.f / DM) + 1e-6f); }
__device__ __forceinline__ void norm_mod_finish(const RowV& r, const float* g, const float* shift, const float* scale, bf16_t* orow, int lane) {
    const float rstd = row_rstd(r);
    u32x2* o8 = (u32x2*)orow + lane;
#pragma unroll
    for (int j = 0; j < 4; ++j) {
        const f32x4 gg = ((const f32x4*)g)[lane + 64 * j], sh = ((const f32x4*)shift)[lane + 64 * j], sc = ((const f32x4*)scale)[lane + 64 * j];
        const f32x4 y = r.v[j] * rstd * gg * (sc + 1.0f) + sh;
        u32x2 w; w.x = pk2(y.x, y.y); w.y = pk2(y.z, y.w); o8[64 * j] = w;
    }
}

__device__ __forceinline__ void p_s5_carry(const Args& a, LAS unsigned char* lds, int bid, int nb) {
    const float* E = (const float*)(a.ws + WS_E); const float* TAB = (const float*)(a.ws + WS_S5TAB); bf16_t* Aall = (bf16_t*)(a.ws + WS_AALL);
    constexpr int SL = S5NCH / 8;
    LAS f32x2* xch = (LAS f32x2*)lds;
    const int tid = opaque_tid(), p = tid & 63, seg = __builtin_amdgcn_readfirstlane(tid >> 6);
    for (int item = bid; item < BATCH * 32 * 2; item += nb) {
        const int d = item & 1, g = (item >> 1) & 31, b = item >> 6;
        const float lr = TAB[((d * 32 + g) * 64 + p) * 2], li = TAB[((d * 32 + g) * 64 + p) * 2 + 1];
        const size_t ecol = (size_t)d * 128 + p * 2;
        float hr = 0.f, hi = 0.f;
        f32x2 e[SL];
#pragma unroll
        for (int j = 0; j < SL; ++j) { const int jj = seg * SL + j, cc = d ? S5NCH - 1 - jj : jj; e[j] = __builtin_nontemporal_load((const f32x2*)(E + ((size_t)(g * S5EROWS + b * S5NCH + cc)) * 256 + ecol)); }
        if (seg == 0) {
            f32x2 ex[S5NCX];
#pragma unroll
            for (int c = 0; c < S5NCX; ++c) { const int cc = d ? S5NCX - 1 - c : c; ex[c] = __builtin_nontemporal_load((const f32x2*)(E + ((size_t)(g * S5EROWS + S5LR + b * S5NCX + cc)) * 256 + ecol)); }
#pragma unroll
            for (int c = 0; c < S5NCX; ++c) { const float nr = lr * hr - li * hi + ex[c].x, ni = lr * hi + li * hr + ex[c].y; hr = nr; hi = ni; }
        }
        const float h0r = hr, h0i = hi;
#pragma unroll
        for (int j = 0; j < SL; ++j) { const float nr = lr * hr - li * hi + e[j].x, ni = lr * hi + li * hr + e[j].y; hr = nr; hi = ni; }
        __syncthreads();
        { f32x2 w; w.x = hr; w.y = hi; xch[seg * 64 + p] = w; }
        float ar = lr, ai = li;
#pragma unroll
        for (int q = 1; q < SL; q <<= 1) { const float nr = ar * ar - ai * ai, ni = 2.f * ar * ai; ar = nr; ai = ni; }
        __syncthreads();
        float fr = 0.f, fi = 0.f;
        for (int k = 0; k < seg; ++k) { const f32x2 l = xch[k * 64 + p]; const float nr = ar * fr - ai * fi + l.x, ni = ar * fi + ai * fr + l.y; fr = nr; fi = ni; }
        hr = seg ? fr : h0r; hi = seg ? fi : h0i;
#pragma unroll
        for (int j = 0; j < SL; ++j) { const int jj = seg * SL + j, cc = d ? S5NCH - 1 - jj : jj;
            *(unsigned*)(Aall + ((size_t)(g * S5ROWS + b * S5NCH + cc)) * S5K1 + S5U + ecol) = pk2(hr, hi);
            const float nr = lr * hr - li * hi + e[j].x, ni = lr * hi + li * hr + e[j].y; hr = nr; hi = ni; }
    }
    __syncthreads();
}

constexpr int RC = 64, RNCH = (CTXL + SEQ) / RC, RSTG0 = 32, RSTG1 = RNCH - RSTG0, RSTGM = RSTG1, RSLOT = RSTGM + 1, RJOBS = 64 * RSLOT;
constexpr size_t WS_RACT = WS_AALL;
constexpr size_t WS_RRPT = WS_RACT + (size_t)RJOBS * 8192;
constexpr size_t WS_RSL  = WS_RRPT + (size_t)RJOBS * 8192;
constexpr size_t WS_RYL  = WS_RSL + (size_t)RJOBS * 8192;
constexpr size_t WS_RST  = WS_RYL + (size_t)RJOBS * 8192;
static_assert(WS_RST + (size_t)256 * 64 * 16 * 4 <= WS_S5END, "rwkv staging must fit the S5 region");
constexpr size_t WS_YOUT = WS_HMOD;
constexpr size_t WS_MIX  = WS_AALL;
constexpr size_t WS_X1F  = al256(WS_MIX + (size_t)NTL * DM * 2);
static_assert(WS_X1F + (size_t)NTL * DM * 4 <= WS_XBUF && WS_X1F >= WS_ACT + (size_t)NTL * DFF * 2, "x1 buffer");
static_assert((size_t)2 * NTL * 512 * 2 <= (size_t)NTOK * DM * 2, "YOUT fits HMOD region");

#define LSYNC() do { __syncthreads(); if ((PROBE_RPT >> 19) & 1) { __syncthreads(); __syncthreads(); __syncthreads(); } } while (0)
constexpr int SLB = 64 * 72 * 2;
typedef float f32x16 __attribute__((ext_vector_type(16)));
#define RSLOT(i) (lds + (i) * SLB)

__device__ __forceinline__ f32x16 tile_mm(const LAS unsigned char* Aop, const LAS unsigned char* Bop, int m0, int n0, f32x16 acc, int lane) {
    const int r = lane & 31, h = lane >> 5;
    const LAS unsigned char* ap = Aop + (m0 + r) * 144 + h * 16;
    const LAS unsigned char* bp = Bop + (n0 + r) * 144 + h * 16;
#pragma unroll
    for (int ks = 0; ks < 4; ++ks) {
        const bf16x8 av = *(const LAS bf16x8*)(ap + ks * 32), bv = *(const LAS bf16x8*)(bp + ks * 32);
        acc = __builtin_amdgcn_mfma_f32_32x32x16_bf16(av, bv, acc, 0, 0, 0);
    }
    return acc;
}
__device__ __forceinline__ f32x16 zero16() { f32x16 z;
#pragma unroll
    for (int i = 0; i < 16; ++i) z[i] = 0.f; return z; }
__device__ __forceinline__ void store_cr(LAS unsigned char* X, const f32x16& acc, int m0, int n0, int lane) {
    LAS unsigned char* p = X + (n0 + (lane & 31)) * 144 + (m0 + 4 * (lane >> 5)) * 2;
#pragma unroll
    for (int g = 0; g < 4; ++g) { u32x2 w; w.x = pk2(acc[4 * g], acc[4 * g + 1]); w.y = pk2(acc[4 * g + 2], acc[4 * g + 3]); *(LAS u32x2*)(p + g * 16) = w; }
}
__device__ __forceinline__ void store_rc(LAS unsigned char* X, const f32x16& acc, int m0, int n0, int lane, bool ident) {
    const int c = n0 + (lane & 31), h = lane >> 5;
#pragma unroll
    for (int r = 0; r < 16; ++r) { const int row = m0 + (r & 3) + 8 * (r >> 2) + 4 * h; float v = acc[r]; if (ident && row == c) v += 1.0f;
        *(LAS bf16_t*)(X + row * 144 + c * 2) = (bf16_t)f2bf(v); }
}
__device__ __forceinline__ f32x16 init_cr(const LAS unsigned char* X, int m0, int n0, int lane) {
    const LAS unsigned char* p = X + (n0 + (lane & 31)) * 144 + (m0 + 4 * (lane >> 5)) * 2;
    f32x16 acc;
#pragma unroll
    for (int g = 0; g < 4; ++g) { const u32x2 w = *(const LAS u32x2*)(p + g * 16); acc[4 * g] = bflo(w.x); acc[4 * g + 1] = bfhi(w.x); acc[4 * g + 2] = bflo(w.y); acc[4 * g + 3] = bfhi(w.y); }
    return acc;
}
__device__ __forceinline__ void mask_ge(f32x16& acc, int m0, int n0, int lane, int dmin) {
    const int c = n0 + (lane & 31), h = lane >> 5;
#pragma unroll
    for (int r = 0; r < 16; ++r) { const int row = m0 + (r & 3) + 8 * (r >> 2) + 4 * h; if (c - row < dmin) acc[r] = 0.f; }
}
__device__ __forceinline__ void store_g_perm(bf16_t* OUT, const f32x16& acc, int m0, int n0, int lane) {
    const int h = lane >> 5, row = n0 + (lane & 31); bf16_t* rowp = OUT + (row >> 4) * 1024 + (row & 15) * 8;
#pragma unroll
    for (int g4 = 0; g4 < 4; ++g4) { u32x2 w; w.x = pk2(acc[4 * g4], acc[4 * g4 + 1]); w.y = pk2(acc[4 * g4 + 2], acc[4 * g4 + 3]);
        const int kp = m0 + 8 * (2 * (g4 & 1) + h) + 4 * (g4 >> 1);
        *(u32x2*)(rowp + (kp >> 5) * 512 + ((kp >> 3) & 3) * 128 + (kp & 7)) = w; }
}
__device__ __forceinline__ void store_g_cr(bf16_t* OUT, const f32x16& acc, int m0, int n0, int lane) {
    const int row = n0 + (lane & 31); bf16_t* rowp = OUT + (row >> 4) * 1024 + (row & 15) * 4;
#pragma unroll
    for (int g = 0; g < 4; ++g) { u32x2 w; w.x = pk2(acc[4 * g], acc[4 * g + 1]); w.y = pk2(acc[4 * g + 2], acc[4 * g + 3]);
        const int col = m0 + 4 * (lane >> 5) + 8 * g;
        *(u32x2*)(rowp + (col >> 4) * 256 + ((col >> 2) & 3) * 64) = w; }
}

typedef short s16x4 __attribute__((ext_vector_type(4)));
__device__ __forceinline__ bf16x8 frag_t(const LAS unsigned char* img, int m0, int ks, int lane) {
    const LAS unsigned char* a0 = img + (16 * ks + 8 * (lane >> 5) + ((lane & 15) >> 2)) * 144 + (m0 + 16 * ((lane >> 4) & 1) + 4 * (lane & 3)) * 2;
    const s16x4 lo = __builtin_amdgcn_ds_read_tr16_b64_v4i16((LAS s16x4*)a0), hi = __builtin_amdgcn_ds_read_tr16_b64_v4i16((LAS s16x4*)(a0 + 4 * 144));
    return (bf16x8){lo[0], lo[1], lo[2], lo[3], hi[0], hi[1], hi[2], hi[3]};
}
__device__ __forceinline__ bf16x8 frag_n(const LAS unsigned char* img, int m0, int ks, int lane) { return *(const LAS bf16x8*)(img + (m0 + (lane & 31)) * 144 + (lane >> 5) * 16 + ks * 32); }
template <bool TA, bool TB, int KS0, int KS1>
__device__ __forceinline__ f32x16 tile_mmk(const LAS unsigned char* Aimg, const LAS unsigned char* Bimg, int m0, int n0, f32x16 acc, int lane) {
    bf16x8 av[KS1 - KS0], bv[KS1 - KS0];
#pragma unroll
    for (int ks = KS0; ks < KS1; ++ks) { av[ks - KS0] = TA ? frag_t(Aimg, m0, ks, lane) : frag_n(Aimg, m0, ks, lane); bv[ks - KS0] = TB ? frag_t(Bimg, n0, ks, lane) : frag_n(Bimg, n0, ks, lane); }
    __builtin_amdgcn_s_setprio(1);
#pragma unroll
    for (int ks = KS0; ks < KS1; ++ks) acc = __builtin_amdgcn_mfma_f32_32x32x16_bf16(av[ks - KS0], bv[ks - KS0], acc, 0, 0, 0);
    __builtin_amdgcn_s_setprio(0);
    return acc;
}
template <bool TA, bool TB>
__device__ __forceinline__ f32x16 tile_mmx(const LAS unsigned char* Aimg, const LAS unsigned char* Bimg, int m0, int n0, int ks0, int ks1, f32x16 acc, int lane) {
    if (ks0 == 0 && ks1 == 4) return tile_mmk<TA, TB, 0, 4>(Aimg, Bimg, m0, n0, acc, lane);
    if (ks0 == 0 && ks1 == 2) return tile_mmk<TA, TB, 0, 2>(Aimg, Bimg, m0, n0, acc, lane);
    if (ks0 == 2 && ks1 == 4) return tile_mmk<TA, TB, 2, 4>(Aimg, Bimg, m0, n0, acc, lane);
    return acc;
}
__device__ __forceinline__ f32x16 init_rc(const LAS unsigned char* X, int m0, int n0, int lane) {
    const LAS unsigned char* a0 = X + (m0 + 4 * (lane >> 5) + ((lane & 15) >> 2)) * 144 + (n0 + 16 * ((lane >> 4) & 1) + 4 * (lane & 3)) * 2;
    f32x16 acc;
#pragma unroll
    for (int g = 0; g < 4; ++g) { const s16x4 w = __builtin_amdgcn_ds_read_tr16_b64_v4i16((LAS s16x4*)(a0 + g * 8 * 144));
#pragma unroll
        for (int e = 0; e < 4; ++e) acc[4 * g + e] = __builtin_bit_cast(float, ((unsigned)(unsigned short)w[e]) << 16); }
    return acc;
}
__device__ __forceinline__ void mask_tri(f32x16& acc, int m0, int n0, int lane, int sgn, int dmin, bool ident) {
    const int c = n0 + (lane & 31), h = lane >> 5;
#pragma unroll
    for (int r = 0; r < 16; ++r) { const int row = m0 + (r & 3) + 8 * (r >> 2) + 4 * h; if ((c - row) * sgn < dmin) acc[r] = 0.f; if (ident && row == c) acc[r] += 1.0f; }
}

__device__ __forceinline__ void p_rwkv_A(const Args& a, LAS unsigned char* lds, int bid, int nb, int stage) {
    LAS unsigned char* raw = lds;
    LAS unsigned char* w2t = lds + 8 * SLB + 6912;
    LAS unsigned char* a2t = w2t + 5120;
    LAS unsigned char* twl = a2t + 5120;
    LAS unsigned char* adl = twl + 5120;
    LAS float* cum = (LAS float*)(adl + 5120);
    LAS bf16_t* avl = (LAS bf16_t*)(cum + 4096);
    LAS float* seg = (LAS float*)(avl + 4096);
    LAS float* lamC = (LAS float*)(lds + 14 * SLB);
    static_assert(8 * SLB + 6912 + 4 * 5120 + 16384 + 8192 + 2048 <= 14 * SLB, "prep temporaries");
    static_assert(14 * SLB + 256 <= 131072 && 192 * 384 == 8 * SLB, "rwkv LDS");
    const bf16_t* Z = (const bf16_t*)(a.ws + WS_Z);
    const bf16_t* W2T = (const bf16_t*)(a.ws + WS_W2T);
    float* BON = (float*)(a.ws + WS_BON);
    bf16_t* RACT = (bf16_t*)(a.ws + WS_RACT); bf16_t* RRPT = (bf16_t*)(a.ws + WS_RRPT); bf16_t* RSL = (bf16_t*)(a.ws + WS_RSL); bf16_t* RYL = (bf16_t*)(a.ws + WS_RYL);
    const int tid0 = threadIdx.x;
    const int vcu = (nb % 8 == 0) ? (bid % 8) * (nb / 8) + bid / 8 : bid;
    const int nstg = stage ? RSTG1 : RSTG0, cs0 = stage ? RSTG0 : 0;
    u32x4 rq[9], wq, xq;
    unsigned long long tacc_ = 0, tprev_ = PROBE_SEC ? __builtin_amdgcn_s_memrealtime() : 0ull;
#define TSEC(id) do { if (PROBE_SEC == 10) { if ((id) == 8) { const unsigned long long tn_ = __builtin_amdgcn_s_memrealtime(); tacc_ += tn_ - tprev_; tprev_ = tn_; } } \
        else if (PROBE_SEC) { const unsigned long long tn_ = __builtin_amdgcn_s_memrealtime(); if ((id) == PROBE_SEC) tacc_ += tn_ - tprev_; tprev_ = tn_; } } while (0)
#define RWA_ISSUE(jn_) do { const int tq_ = opaque_tid(); const int chain_ = (jn_) / nstg, cs_ = cs0 + (jn_) % nstg, d_ = chain_ >> 5, b_ = (chain_ >> 3) & 3, h_ = chain_ & 7; \
        const bool ctx_ = cs_ < CTXL / RC; const int cidx_ = ctx_ ? cs_ : cs_ - CTXL / RC, gi_ = d_ ? ((ctx_ ? CTXL / RC : SEQ / RC) - 1 - cidx_) : cidx_; \
        _Pragma("unroll") for (int it = 0; it < 9; ++it) { const int pc = it * 512 + tq_, slot = pc / 24, q = pc - slot * 24, X = q >> 3, c8 = q & 7; int tok; \
            if (ctx_) { const int t = min(max(64 * (gi_ - 1) + slot, 0), CTXL - 1); tok = NTL + b_ * CTXL + t; } \
            else { const int rr_ = min(max(gi_ - 1 + (slot >> 6), 0), 63); tok = b_ * SEQ + rr_ * 64 + (slot & 63); } \
            rq[it] = *(const u32x4*)(Z + zidx(tok, X * 512 + h_ * 64 + c8 * 8)); } \
        { const int rw = tq_ >> 3, pq = tq_ & 7, which = pq >> 2, p4 = pq & 3; \
          wq = *(const u32x4*)(W2T + ((size_t)((which * 2 + d_) * 512 + h_ * 64 + rw)) * 32 + p4 * 8); \
          const int pj = d_ ? 63 - rw : rw; const int tokrow = ctx_ ? (NTL + b_ * CTXL + gi_ * 64 + pj) : (b_ * SEQ + gi_ * 64 + pj); \
          xq = *(const u32x4*)(Z + zidx(tokrow, (which ? COL_AD : COL_WD) + d_ * 32 + p4 * 8)); } } while (0)
    if (vcu < 64 * nstg) RWA_ISSUE(vcu);
    for (int jl = vcu; jl < 64 * nstg; jl += nb) {
        TSEC(8);
        int tid_ = tid0; asm volatile("" : "+v"(tid_));
        const int tid = tid_, lane = tid & 63, wave = __builtin_amdgcn_readfirstlane(tid >> 6);
        const int chain = jl / nstg, cs = cs0 + jl % nstg, jslot = chain * RSLOT + jl % nstg;
        const int d = chain >> 5, b = (chain >> 3) & 3, h = chain & 7;
        float* BONd = BON + (size_t)d * NTL * 8;
        const bool isctx = cs < CTXL / RC;
        const int cidx = isctx ? cs : cs - CTXL / RC;
        const int gi = d ? ((isctx ? CTXL / RC : SEQ / RC) - 1 - cidx) : cidx;
#pragma unroll 1
        for (int rp_ = 0; rp_ <= ((PROBE_RPT >> 18) & 1); ++rp_) {
        __syncthreads();
#pragma unroll
        for (int it = 0; it < 9; ++it) *(LAS u32x4*)(raw + (it * 512 + tid) * 16) = rq[it];
        {
            const int rw = tid >> 3, pq = tid & 7, which = pq >> 2, p4 = pq & 3;
            *(LAS u32x4*)((which ? a2t : w2t) + rw * 80 + p4 * 16) = wq;
            u32x4 xv = xq;
            if (!which) { xv.x = pk2(tanh_fast(bflo(xv.x)), tanh_fast(bfhi(xv.x))); xv.y = pk2(tanh_fast(bflo(xv.y)), tanh_fast(bfhi(xv.y)));
                          xv.z = pk2(tanh_fast(bflo(xv.z)), tanh_fast(bfhi(xv.z))); xv.w = pk2(tanh_fast(bflo(xv.w)), tanh_fast(bfhi(xv.w))); }
            *(LAS u32x4*)((which ? adl : twl) + rw * 80 + p4 * 16) = xv;
        }
        f32x4 cw9[9];
#pragma unroll
        for (int tap = 0; tap < 9; ++tap) cw9[tap] = *(const f32x4*)(a.in[10] + tap * 1536 + min(tid >> 7, 2) * 512 + h * 64 + 4 * (tid & 15));
        __syncthreads();
        TSEC(1);
        {
            const int which = ((wave >> 1) & 1) ^ 1, m0 = (wave >> 2) * 32, n0 = (wave & 1) * 32, r31 = lane & 31, hh = lane >> 5;
            const LAS unsigned char* ap = (which ? adl : twl) + (m0 + r31) * 80 + hh * 16;
            const LAS unsigned char* bp = (which ? a2t : w2t) + (n0 + r31) * 80 + hh * 16;
            f32x16 acc = zero16();
#pragma unroll
            for (int ks = 0; ks < 2; ++ks) acc = __builtin_amdgcn_mfma_f32_32x32x16_bf16(*(const LAS bf16x8*)(ap + ks * 32), *(const LAS bf16x8*)(bp + ks * 32), acc, 0, 0, 0);
            const int c = n0 + r31;
            const float bias = a.in[which ? 13 : 11][d * 512 + h * 64 + c];
#pragma unroll
            for (int r = 0; r < 16; ++r) {
                const int srow = m0 + (r & 3) + 8 * (r >> 2) + 4 * hh; const float x = acc[r] + bias;
                if (which) avl[srow * 64 + c] = (bf16_t)f2bf(sigmoidf_(x));
                else { const float sp = fmaxf(-x, 0.f) + flog(1.0f + fexp(-fabsf(x))); cum[srow * 64 + c] = -fexp(-sp - 0.5f); }
            }
        }
        const int tt = tid >> 4, cg = tid & 15, ch = h * 64 + 4 * cg;
        const f32x4 kkw = *(const f32x4*)(a.in[16] + ch), kaw = *(const f32x4*)(a.in[17] + ch), rkw = *(const f32x4*)(a.in[18] + ch);
        f32x4 kkn_[2], bv_[2], kd_[2], rr_[2], vv_[2];
        f32x4 cvr[2], cvk[2];
        {
            const int X = tid >> 7, cgc = tid & 15, tb = (tid >> 4) & 7;
            f32x4 oacc[8];
#pragma unroll
            for (int j = 0; j < 8; ++j) oacc[j] = (f32x4){0.f, 0.f, 0.f, 0.f};
            if (X < 3) {
#pragma unroll 1
                for (int aa = 0; aa < 3; ++aa) {
                    const bool rowok = isctx ? (aa == 1) : ((unsigned)(gi - 1 + aa) < 64u);
                    if (!rowok) continue;
                    f32x4 w[3];
#pragma unroll
                    for (int bb2 = 0; bb2 < 3; ++bb2) w[bb2] = aa == 0 ? cw9[bb2] : (aa == 1 ? cw9[3 + bb2] : cw9[6 + bb2]);
                    u32x2 q[10];
#pragma unroll
                    for (int e = 0; e < 10; ++e) {
                        const int jj = 8 * tb + e - 1;
                        int slot; bool ok;
                        if (isctx) { slot = 64 + jj; ok = (unsigned)(64 * gi + jj) < (unsigned)CTXL; }
                        else { slot = aa * 64 + min(max(jj, 0), 63); ok = (unsigned)jj < 64u; }
                        q[e] = *(const LAS u32x2*)(raw + slot * 384 + X * 128 + cgc * 8);
                        if (!ok) { q[e].x = 0u; q[e].y = 0u; }
                    }
#pragma unroll
                    for (int j = 0; j < 8; ++j)
#pragma unroll
                        for (int bb2 = 0; bb2 < 3; ++bb2) { const u32x2 v = q[j + bb2];
                            oacc[j][0] += bflo(v.x) * w[bb2][0]; oacc[j][1] += bfhi(v.x) * w[bb2][1]; oacc[j][2] += bflo(v.y) * w[bb2][2]; oacc[j][3] += bfhi(v.y) * w[bb2][3]; }
                }
            }
            TSEC(2);
            __syncthreads();
            if (X < 3) {
                LAS float* cvo = (LAS float*)raw;
#pragma unroll
                for (int j = 0; j < 8; ++j) { const int pj = 8 * tb + j, sidx = d ? 63 - pj : pj; *(LAS f32x4*)(cvo + (sidx * 3 + X) * 64 + 4 * cgc) = oacc[j]; }
            }
        }
        __syncthreads();
#pragma unroll
        for (int half = 0; half < 2; ++half) { const LAS float* cvo = (const LAS float*)raw + ((half * 32 + tt) * 3) * 64 + 4 * cg;
            cvr[half] = *(const LAS f32x4*)(cvo); cvk[half] = *(const LAS f32x4*)(cvo + 64); vv_[half] = *(const LAS f32x4*)(cvo + 128); }
#pragma unroll
        for (int half = 0; half < 2; ++half) {
            const int s = half * 32 + tt, pj = d ? 63 - s : s;
            const int tokrow = b * SEQ + gi * 64 + pj;
            const f32x4 rr = cvr[half], kv = cvk[half];
            f32x4 kkn = kv * kkw;
            const float ss = row16_sum(kkn[0] * kkn[0] + kkn[1] * kkn[1] + kkn[2] * kkn[2] + kkn[3] * kkn[3]);
            kkn = kkn * __builtin_amdgcn_rsqf(fmaxf(ss, 1e-12f));
            const u32x2 aq = *(const LAS u32x2*)(avl + s * 64 + 4 * cg);
            const f32x4 av = {bflo(aq.x), bfhi(aq.x), bflo(aq.y), bfhi(aq.y)};
            f32x4 kd, bv;
#pragma unroll
            for (int j = 0; j < 4; ++j) { kd[j] = kv[j] * (1.0f + (av[j] - 1.0f) * kaw[j]); bv[j] = kkn[j] * av[j]; }
            const float bon = row16_sum(rr[0] * kd[0] * rkw[0] + rr[1] * kd[1] * rkw[1] + rr[2] * kd[2] * rkw[2] + rr[3] * kd[3] * rkw[3]);
            if (!isctx && cg == 0) BONd[(size_t)tokrow * 8 + h] = bon;
            kkn_[half] = kkn; bv_[half] = bv; kd_[half] = kd; rr_[half] = rr;
        }
        TSEC(3);
        {
            const int k = tid & 63, sg = tid >> 6;
            float run = 0.f;
#pragma unroll
            for (int j = 0; j < 8; ++j) { run += cum[(8 * sg + j) * 64 + k]; cum[(8 * sg + j) * 64 + k] = run; }
            seg[sg * 64 + k] = run;
            __syncthreads();
            float pre = 0.f;
            for (int q = 0; q < sg; ++q) pre += seg[q * 64 + k];
#pragma unroll
            for (int j = 0; j < 8; ++j) cum[(8 * sg + j) * 64 + k] += pre;
            __syncthreads();
        }
        TSEC(4);
        const f32x4 LC = *(LAS f32x4*)(cum + 63 * 64 + 4 * cg);
        const f32x4 eLC = {fexp(LC[0]), fexp(LC[1]), fexp(LC[2]), fexp(LC[3])};
#pragma unroll 1
        for (int re_ = 0; re_ <= ((PROBE_RPT >> 21) & 1); ++re_)
#pragma unroll
        for (int half = 0; half < 2; ++half) {
            const int s = half * 32 + tt;
            const f32x4 L = *(LAS f32x4*)(cum + s * 64 + 4 * cg);
            f32x4 Lp = {0.f, 0.f, 0.f, 0.f}; if (s > 0) Lp = *(LAS f32x4*)(cum + (s - 1) * 64 + 4 * cg);
            f32x4 bh, kh, at, rt, bb2, kb2;
#pragma unroll
            for (int j = 0; j < 4; ++j) {
                const float em = fexp(-L[j]), ep = __builtin_amdgcn_rcpf(em), epv = fexp(Lp[j]), ec = eLC[j] * em;
                bh[j] = bv_[half][j] * em; kh[j] = kd_[half][j] * em; at[j] = -kkn_[half][j] * epv; rt[j] = rr_[half][j] * ep;
                bb2[j] = bv_[half][j] * ec; kb2[j] = kd_[half][j] * ec;
            }
            const int so = s * 144 + 8 * cg; u32x2 w;
            w.x = pk2(bh[0], bh[1]); w.y = pk2(bh[2], bh[3]); *(LAS u32x2*)(RSLOT(0) + so) = w;
            w.x = pk2(kh[0], kh[1]); w.y = pk2(kh[2], kh[3]); *(LAS u32x2*)(RSLOT(1) + so) = w;
            w.x = pk2(at[0], at[1]); w.y = pk2(at[2], at[3]); *(LAS u32x2*)(RSLOT(2) + so) = w;
            w.x = pk2(rt[0], rt[1]); w.y = pk2(rt[2], rt[3]); *(LAS u32x2*)(RSLOT(3) + so) = w;
            w.x = pk2(bb2[0], bb2[1]); w.y = pk2(bb2[2], bb2[3]); *(LAS u32x2*)(RSLOT(4) + so) = w;
            w.x = pk2(kb2[0], kb2[1]); w.y = pk2(kb2[2], kb2[3]); *(LAS u32x2*)(RSLOT(5) + so) = w;
            w.x = pk2(vv_[half][0], vv_[half][1]); w.y = pk2(vv_[half][2], vv_[half][3]); *(LAS u32x2*)(RSLOT(6) + so) = w;
            if (s == 63) *(LAS f32x4*)(lamC + 4 * cg) = eLC;
        }
        __syncthreads();
        }
        TSEC(5);
        if (jl + nb < 64 * nstg) RWA_ISSUE(jl + nb);
        TSEC(6);
#pragma unroll 1
        for (int T = wave; T < 20; T += 8) {
            const int prod = T % 5, tq = T / 5; const bool ti = (prod == 1 || prod == 2);
            const int mt = (tq == 2 || (tq == 1 && ti) || (tq == 3 && !ti)) ? 32 : 0, nt = (tq == 2 || (tq == 1 && !ti) || (tq == 3 && ti)) ? 32 : 0;
            f32x16 acc = zero16();
            if (tq < 3) {
                const int ia = prod == 0 ? 0 : (prod == 3 ? 0 : (prod == 4 ? 1 : 2)), ib = prod == 0 ? 2 : (prod == 1 ? 0 : (prod == 2 ? 1 : 3));
                acc = tile_mmx<false, false>(RSLOT(ia), RSLOT(ib), mt, nt, 0, 4, acc, lane);
                mask_tri(acc, mt, nt, lane, ti ? -1 : 1, prod >= 3 ? 0 : 1, prod == 1);
            }
            store_cr(RSLOT(7 + prod), acc, mt, nt, lane);
        }
        LSYNC();
        if (wave < 4) { const int mt = (wave >> 1) * 32, nt = (wave & 1) * 32; f32x16 acc = zero16();
            if (wave != 2) acc = tile_mmx<true, false>(RSLOT(7), RSLOT(7), mt, nt, wave == 3 ? 2 : 0, wave == 0 ? 2 : 4, acc, lane);
            store_cr(RSLOT(0), acc, mt, nt, lane); }
        LSYNC();
#pragma unroll
        for (int lv = 1; lv <= 4; ++lv) {
            const int pc_in = (lv & 1) ? 0 : 7, pc_out = (lv & 1) ? 7 : 0, tr_in = (lv & 1) ? 8 : 1, tr_out = (lv & 1) ? 1 : 8;
            const int w4 = wave & 3, mt = (w4 >> 1) * 32, nt = (w4 & 1) * 32;
            if (wave < 4) {
                if (w4 != 2) { f32x16 acc = tile_mmx<true, false>(RSLOT(pc_in), RSLOT(pc_in), mt, nt, w4 == 3 ? 2 : 0, w4 == 0 ? 2 : 4, zero16(), lane);
                    if (lv == 4) mask_tri(acc, mt, nt, lane, 1, -64, true);
                    store_cr(RSLOT(pc_out), acc, mt, nt, lane); }
            } else {
                if (w4 != 1) { f32x16 acc = init_cr(RSLOT(tr_in), mt, nt, lane);
                    acc = tile_mmx<false, false>(RSLOT(pc_in), RSLOT(tr_in), mt, nt, w4 == 3 ? 2 : 0, w4 == 0 ? 2 : 4, acc, lane);
                    store_cr(RSLOT(tr_out), acc, mt, nt, lane); }
                else if (lv == 1) store_cr(RSLOT(tr_out), zero16(), mt, nt, lane);
            }
            LSYNC();
        }
        if (wave < 4) { const int mt = (wave >> 1) * 32, nt = (wave & 1) * 32; f32x16 acc = zero16();
            if (wave != 2) acc = tile_mmx<false, false>(RSLOT(8), RSLOT(0), mt, nt, wave == 3 ? 2 : 0, wave == 0 ? 2 : 4, acc, lane);
            store_cr(RSLOT(1), acc, mt, nt, lane); }
        LSYNC();
        { const int w4 = wave & 3, mt = (w4 >> 1) * 32, nt = (w4 & 1) * 32; f32x16 acc = zero16();
            if (wave < 4) { acc = tile_mmx<false, true>(RSLOT(1), RSLOT(2), mt, nt, 0, mt ? 4 : 2, acc, lane); store_cr(RSLOT(7), acc, mt, nt, lane); }
            else { if (w4 != 1) acc = tile_mmx<false, false>(RSLOT(1), RSLOT(9), mt, nt, w4 == 3 ? 2 : 0, w4 == 0 ? 2 : 4, acc, lane); store_cr(RSLOT(0), acc, mt, nt, lane); } }
        LSYNC();
        TSEC(7);
#pragma unroll 1
        for (int rl_ = 0; rl_ <= ((PROBE_RPT >> 22) & 1); ++rl_)
        {
            const int prod = wave >> 1, mt = (wave & 1) * 32;
            bf16_t* actj = RACT + (size_t)jslot * 4096; bf16_t* rptj = RRPT + (size_t)jslot * 4096;
#pragma unroll
            for (int nt2 = 0; nt2 < 2; ++nt2) {
                const int nt = nt2 * 32;
                if (prod == 0) { f32x16 acc = init_cr(RSLOT(3), mt, nt, lane); acc = tile_mmx<false, false>(RSLOT(7), RSLOT(10), mt, nt, 0, nt ? 4 : 2, acc, lane); store_g_perm(rptj, acc, mt, nt, lane); }
                else if (prod == 1) { f32x16 acc = zero16();
                    if (!(mt && !nt)) { acc = init_cr(RSLOT(11), mt, nt, lane); acc = tile_mmx<false, false>(RSLOT(0), RSLOT(10), mt, nt, mt ? 2 : 0, nt ? 4 : 2, acc, lane); }
                    store_cr(RSLOT(8), acc, mt, nt, lane); }
                else if (prod == 2) { f32x16 acc = tile_mmx<false, true>(RSLOT(7), RSLOT(4), mt, nt, 0, 4, zero16(), lane);
                    { const int c = nt + (lane & 31), hh = lane >> 5;
#pragma unroll
                      for (int r = 0; r < 16; ++r) { const int row = mt + (r & 3) + 8 * (r >> 2) + 4 * hh; if (row == c) acc[r] += lamC[row]; } }
                    store_g_perm(actj, acc, mt, nt, lane); }
                else { f32x16 acc = init_rc(RSLOT(5), mt, nt, lane); acc = tile_mmx<false, true>(RSLOT(0), RSLOT(4), mt, nt, mt ? 2 : 0, 4, acc, lane); store_cr(RSLOT(9), acc, mt, nt, lane); }
            }
        }
        LSYNC();
#pragma unroll 1
        for (int rl_ = 0; rl_ <= ((PROBE_RPT >> 22) & 1); ++rl_)
        { const int mt = ((wave >> 1) & 1) * 32, nt = (wave & 1) * 32;
            const f32x16 acc = tile_mmx<false, true>(RSLOT(wave < 4 ? 9 : 8), RSLOT(6), mt, nt, 0, (wave >= 4 && !mt) ? 2 : 4, zero16(), lane);
            store_g_cr((wave < 4 ? RSL : RYL) + (size_t)jslot * 4096, acc, mt, nt, lane); }
        TSEC(9);
    }
#undef RWA_ISSUE
    if (PROBE_SEC && bid == 0 && tid0 == 0) { const unsigned long long t0_ = __builtin_amdgcn_s_memrealtime(); while (__builtin_amdgcn_s_memrealtime() - t0_ < 64ull * tacc_) __builtin_amdgcn_s_sleep(8); }
#undef TSEC
    LSYNC();
}

__device__ __forceinline__ void p_rwkv_S(const Args& a, LAS unsigned char* lds, int bid, int nb, int stage) {
    const int tid = opaque_tid(), lane = tid & 63, wave = __builtin_amdgcn_readfirstlane(tid >> 6), vl = lane & 15, g = lane >> 4;
    const int role = wave >> 2, mt = wave & 3;
    const bf16_t* OPB = (const bf16_t*)(a.ws + (role ? WS_RRPT : WS_RACT)); const bf16_t* INB = (const bf16_t*)(a.ws + (role ? WS_RYL : WS_RSL));
    float* RST = (float*)(a.ws + WS_RST); bf16_t* YOUT = (bf16_t*)(a.ws + WS_YOUT);
    LAS unsigned char* bfr = lds;
    const int vcu = (nb % 8 == 0) ? (bid % 8) * (nb / 8) + bid / 8 : bid;
    const int nstg = stage ? RSTG1 : RSTG0, cs0 = stage ? RSTG0 : 0;
    const unsigned long long ts0_ = (PROBE_SEC == 20 || PROBE_SEC == 21) ? __builtin_amdgcn_s_memrealtime() : 0ull; unsigned long long ts1_ = ts0_;
    for (int u = vcu; u < 256; u += nb) {
        const int chain = u >> 2, vq = u & 3, d = chain >> 5, b = (chain >> 3) & 3, h = chain & 7;
        f32x4 S = {0.f, 0.f, 0.f, 0.f};
        float* rst = RST + ((size_t)u * 64 + lane) * 16 + 4 * mt;
        if (stage != 0 && role == 0) S = *(const f32x4*)rst;
        __syncthreads();
        if (role == 0) { u32x2 w; w.x = pk2(S[0], S[1]); w.y = pk2(S[2], S[3]); *(LAS u32x2*)(bfr + ((mt >> 1) * 64 + lane) * 16 + (mt & 1) * 8) = w; }
        __syncthreads();
        bf16_t* Yd = YOUT + (size_t)d * NTL * 512 + h * 64 + vq * 16 + vl;
        const bf16_t* opp = OPB + (size_t)chain * RSLOT * 4096 + mt * 1024 + lane * 8;
        const bf16_t* inp = INB + (size_t)chain * RSLOT * 4096 + vq * 1024 + mt * 256 + lane * 4;
        bf16x8 fa[8][2]; u32x2 ini[8];
#define RW_LOAD(q, c_) do { fa[q][0] = *(const bf16x8*)(opp + (size_t)(c_) * 4096); fa[q][1] = *(const bf16x8*)(opp + (size_t)(c_) * 4096 + 512); ini[q] = *(const u32x2*)(inp + (size_t)(c_) * 4096); } while (0)
        bf16_t* const ydummy = (bf16_t*)(a.ws + WS_SIG) + lane;
#define RW_STEP_S(q, c_) do { \
            const LAS unsigned char* bp = bfr + ((c_) & 1) * 2048 + lane * 16; \
            const bf16x8 b0 = *(const LAS bf16x8*)(bp), b1 = *(const LAS bf16x8*)(bp + 1024); \
            f32x4 acc = {bflo(ini[q].x), bfhi(ini[q].x), bflo(ini[q].y), bfhi(ini[q].y)}; \
            acc = __builtin_amdgcn_mfma_f32_16x16x32_bf16(fa[q][0], b0, acc, 0, 0, 0); acc = __builtin_amdgcn_mfma_f32_16x16x32_bf16(fa[q][1], b1, acc, 0, 0, 0); \
            S = acc; { u32x2 w; w.x = pk2(acc[0], acc[1]); w.y = pk2(acc[2], acc[3]); *(LAS u32x2*)(bfr + (((c_) + 1) & 1) * 2048 + ((mt >> 1) * 64 + lane) * 16 + (mt & 1) * 8) = w; } \
            asm volatile("s_waitcnt lgkmcnt(0)" ::: "memory"); __builtin_amdgcn_s_barrier(); asm volatile("" ::: "memory"); } while (0)
#define RW_STEP_Y(q, c_) do { \
            const LAS unsigned char* bp = bfr + ((c_) & 1) * 2048 + lane * 16; \
            const bf16x8 b0 = *(const LAS bf16x8*)(bp), b1 = *(const LAS bf16x8*)(bp + 1024); \
            f32x4 acc = {bflo(ini[q].x), bfhi(ini[q].x), bflo(ini[q].y), bfhi(ini[q].y)}; \
            acc = __builtin_amdgcn_mfma_f32_16x16x32_bf16(fa[q][0], b0, acc, 0, 0, 0); acc = __builtin_amdgcn_mfma_f32_16x16x32_bf16(fa[q][1], b1, acc, 0, 0, 0); \
            { const int cs_ = cs0 + (c_); const bool out_ = cs_ >= CTXL / RC; \
              _Pragma("unroll") for (int r = 0; r < 4; ++r) { const int i_ = cs_ * RC + 16 * mt + 4 * g + r - CTXL; const int pos_ = d ? (SEQ - 1 - i_) : i_; \
                    bf16_t* yp_ = out_ ? Yd + (size_t)(b * SEQ + pos_) * 512 : ydummy; *yp_ = (bf16_t)f2bf(acc[r]); } } \
            asm volatile("s_waitcnt lgkmcnt(0)" ::: "memory"); __builtin_amdgcn_s_barrier(); asm volatile("" ::: "memory"); } while (0)
        RW_LOAD(0, 0); RW_LOAD(1, 1); RW_LOAD(2, 2); RW_LOAD(3, 3); RW_LOAD(4, 4); RW_LOAD(5, 5); RW_LOAD(6, 6);
        static_assert(RSTG0 % 8 == 0 && RSTG1 % 8 == 4, "the prefetch ring below: full groups of 8 chunks, then 4");
#define RW_PAIR(STEP, q) do { RW_LOAD(((q) + 7) & 7, min(c + (q) + 7, nstg - 1)); STEP(q, c + (q)); } while (0)
        int c = 0;
        if (PROBE_SEC == 21) ts1_ = __builtin_amdgcn_s_memrealtime();
        if (role == 0) {
#pragma unroll 1
            for (; c + 8 <= nstg; c += 8) {
                RW_PAIR(RW_STEP_S, 0); RW_PAIR(RW_STEP_S, 1); RW_PAIR(RW_STEP_S, 2); RW_PAIR(RW_STEP_S, 3); RW_PAIR(RW_STEP_S, 4); RW_PAIR(RW_STEP_S, 5); RW_PAIR(RW_STEP_S, 6); RW_PAIR(RW_STEP_S, 7);
            }
            if (c < nstg) { RW_STEP_S(0, c); RW_STEP_S(1, c + 1); RW_STEP_S(2, c + 2); RW_STEP_S(3, c + 3); }
        } else {
#pragma unroll 1
            for (; c + 8 <= nstg; c += 8) {
                RW_PAIR(RW_STEP_Y, 0); RW_PAIR(RW_STEP_Y, 1); RW_PAIR(RW_STEP_Y, 2); RW_PAIR(RW_STEP_Y, 3); RW_PAIR(RW_STEP_Y, 4); RW_PAIR(RW_STEP_Y, 5); RW_PAIR(RW_STEP_Y, 6); RW_PAIR(RW_STEP_Y, 7);
            }
            if (c < nstg) { RW_STEP_Y(0, c); RW_STEP_Y(1, c + 1); RW_STEP_Y(2, c + 2); RW_STEP_Y(3, c + 3); }
        }
#undef RW_PAIR
#undef RW_LOAD
#undef RW_STEP_S
#undef RW_STEP_Y
        if (stage == 0 && role == 0) *(f32x4*)rst = S;
    }
    if ((PROBE_SEC == 20 || PROBE_SEC == 21) && bid == 0 && tid == 0) { const unsigned long long t0_ = __builtin_amdgcn_s_memrealtime(), dt_ = t0_ - (PROBE_SEC == 21 ? ts1_ : ts0_); while (__builtin_amdgcn_s_memrealtime() - t0_ < 64ull * dt_) __builtin_amdgcn_s_sleep(8); }
    __syncthreads();
}

__device__ __forceinline__ float grp8_sum(float v) { v += dppf<0xB1>(v); v += dppf<0x4E>(v); v += dppf<0x141>(v); return v; }
__device__ __forceinline__ void p_rwkv_readout(const Args& a, int bid, int nb) {
    const int tid = opaque_tid(), lane = tid & 63, wave = tid >> 6, hf = wave & 1, c0 = hf * 256 + lane * 4, h = c0 >> 6;
    const bf16_t* Z = (const bf16_t*)(a.ws + WS_Z); const bf16_t* Y = (const bf16_t*)(a.ws + WS_YOUT); const float* BON = (const float*)(a.ws + WS_BON);
    const bf16_t* GATE = (const bf16_t*)(a.ws + WS_GATE); bf16_t* MIX = (bf16_t*)(a.ws + WS_MIX);
    const f32x4 lnw = *(const f32x4*)(a.in[19] + c0), lnb = *(const f32x4*)(a.in[20] + c0);
    f32x4 cw[9];
#pragma unroll
    for (int tap = 0; tap < 9; ++tap) cw[tap] = *(const f32x4*)(a.in[10] + tap * 1536 + 1024 + c0);
    const bool bal = (nb == 256);
    const int it0 = bal ? (bid < 128 ? bid * 8 + wave : 2048 + (bid - 128) * 8 + wave) : bid * 8 + wave, itn = bal ? (bid < 128 ? 2 : 6) : (NTL / 2 - it0 + nb * 8 - 1) / (nb * 8), its = bal ? 1024 : nb * 8;
#pragma unroll 1
    for (int ii = 0, it = it0; ii < itn; ++ii, it += its) {
        const int tok0 = (it >> 1) * 4, b = tok0 >> 12, pos0 = tok0 & 4095, ti = pos0 >> 6, tj0 = pos0 & 63;
        u32x2 q[3][6], yf[4], yb[4], gt[4]; float bo0[4], bo1[4];
#pragma unroll
        for (int aa = 0; aa < 3; ++aa) {
            const int iic = min(max(ti + aa - 1, 0), 63);
#pragma unroll
            for (int e = 0; e < 6; ++e) q[aa][e] = *(const u32x2*)(Z + zidx(b * SEQ + iic * 64 + min(max(tj0 + e - 1, 0), 63), COL_V + c0));
        }
#pragma unroll
        for (int t = 0; t < 4; ++t) { const int tok = tok0 + t;
            yf[t] = *(const u32x2*)(Y + (size_t)tok * 512 + c0); yb[t] = *(const u32x2*)(Y + (size_t)(NTL + tok) * 512 + c0);
            gt[t] = *(const u32x2*)(GATE + (size_t)tok * 512 + c0); bo0[t] = BON[(size_t)tok * 8 + h]; bo1[t] = BON[(size_t)(NTL + tok) * 8 + h]; }
        asm volatile("" ::: "memory");
        f32x4 v[4];
#pragma unroll
        for (int t = 0; t < 4; ++t) v[t] = (f32x4){0.f, 0.f, 0.f, 0.f};
#pragma unroll
        for (int aa = 0; aa < 3; ++aa) {
            const bool rowok = (unsigned)(ti + aa - 1) < 64u;
#pragma unroll
            for (int e = 0; e < 6; ++e) { const bool ok = rowok && (unsigned)(tj0 + e - 1) < 64u; if (!ok) q[aa][e] = (u32x2){0u, 0u}; }
#pragma unroll
            for (int t = 0; t < 4; ++t)
#pragma unroll
                for (int bb2 = 0; bb2 < 3; ++bb2) { const u32x2 x = q[aa][t + bb2]; const f32x4 w = cw[aa * 3 + bb2];
                    v[t][0] += bflo(x.x) * w[0]; v[t][1] += bfhi(x.x) * w[1]; v[t][2] += bflo(x.y) * w[2]; v[t][3] += bfhi(x.y) * w[3]; }
        }
#pragma unroll
        for (int t = 0; t < 4; ++t) {
            const int tok = tok0 + t;
            const float bonus = bo0[t] + bo1[t];
            f32x4 y = {bflo(yf[t].x) + bflo(yb[t].x), bfhi(yf[t].x) + bfhi(yb[t].x), bflo(yf[t].y) + bflo(yb[t].y), bfhi(yf[t].y) + bfhi(yb[t].y)};
            const float mu = row16_sum((y[0] + y[1]) + (y[2] + y[3])) * (1.f / 64.f);
            y = y - mu;
            const float rstd = __builtin_amdgcn_rsqf(row16_sum((y[0] * y[0] + y[1] * y[1]) + (y[2] * y[2] + y[3] * y[3])) * (1.f / 64.f) + 64e-5f);
            const f32x4 gv = {bflo(gt[t].x), bfhi(gt[t].x), bflo(gt[t].y), bfhi(gt[t].y)};
            const f32x4 o = (y * rstd * lnw + lnb + bonus * v[t]) * gv;
            u32x2 w; w.x = pk2(o[0], o[1]); w.y = pk2(o[2], o[3]);
            *(u32x2*)(MIX + (size_t)tok * DM + c0) = w;
        }
    }
}

constexpr int NPH = 16;
__global__ void __launch_bounds__(NTHREADS, 2) mega(Args a) {
    __builtin_assume(__builtin_amdgcn_workitem_id_y() == 0); __builtin_assume(__builtin_amdgcn_workitem_id_z() == 0);
    extern __shared__ __attribute__((aligned(16))) unsigned char lds_raw[];
    LAS unsigned char* lds = (LAS unsigned char*)lds_raw;
    cg::grid_group grid = cg::this_grid();
    const int tid = threadIdx.x, bid = blockIdx.x, nb = gridDim.x;
    unsigned char* ws = a.ws;
    float* MOD = (float*)(ws + WS_MOD);
    const int lo = a.ph_lo, hi = a.ph_hi;
    volatile LAS unsigned* misc = (volatile LAS unsigned*)(lds + 131072);
    if (tid < 4) misc[tid] = 0u;
    __syncthreads();
    const XcdBarrier xbar = xcd_barrier_post((unsigned*)(ws + WS_CTL), misc);
#define IN(k) (lo <= (k) && (k) < hi)
#define SEAM(k) do { if (IN(k) && IN((k) + 1)) xcd_barrier(xbar); } while (0)
    if (lo < 0) grid.sync();
    unsigned long long pht0_ = 0, phtacc_ = 0;
#define PHASE(k, ...) if (PROBE_PHT == (k) || ((k) == 1 && PROBE_PHT >= 30 && PROBE_PHT <= 35 && PROBE_PHT != 34) || ((k) == 2 && PROBE_PHT == 34)) pht0_ = __builtin_amdgcn_s_memrealtime(); if (IN(k)) { __VA_ARGS__ if ((PROBE_RPT >> (k)) & 1) { xcd_barrier(xbar); __VA_ARGS__ } } SEAM(k); if (PROBE_PHT == (k)) phtacc_ = __builtin_amdgcn_s_memrealtime() - pht0_;
    PHASE(1, {
        p0_mod(a, lds, bid, nb);
        __syncthreads();
        if (PROBE_PHT == 30) phtacc_ = __builtin_amdgcn_s_memrealtime() - pht0_;
        if (nb == 256) { if (bid >= 192) p0_weights(a, lds, bid - 192, nb - 192, 0); } else p0_weights(a, lds, bid, nb, 0);
        __syncthreads();
        if (PROBE_PHT == 31) phtacc_ = __builtin_amdgcn_s_memrealtime() - pht0_;
        const bool split = (nb == 256);
        bf16_t* HM = (bf16_t*)(ws + WS_HMOD); const int t_ = opaque_tid(), lane = t_ & 63, wave = t_ >> 6;
        constexpr int HR0 = 5600;
        const int rbase = split ? (bid < 100 ? bid * 8 + wave : HR0 + (bid - 100) * 8 + wave) : bid * 8 + wave;
        const int rstr = split ? (bid < 100 ? 800 : 1248) : nb * 8, rend = split ? (bid < 100 ? HR0 : NTOK) : NTOK;
        RowV rv[4];
        _Pragma("unroll") for (int q = 0; q < 4; ++q) { const int row = min(rbase + q * rstr, NTOK - 1); rv[q] = row_load(row < NTL ? a.in[0] + (size_t)row * DM : a.in[2] + (size_t)(row - NTL) * DM, lane); }
        if (!split) p0_s5(a, lds, bid, nb); else if (bid < 100) p0_s5(a, lds, bid, 100, 0, 100);
        if (PROBE_PHT == 32) phtacc_ = __builtin_amdgcn_s_memrealtime() - pht0_;
        mod_wait(a);
        if (PROBE_PHT == 33) phtacc_ = __builtin_amdgcn_s_memrealtime() - pht0_;
        for (int row0 = rbase; row0 < rend; row0 += 4 * rstr) {
            if (row0 != rbase) { _Pragma("unroll") for (int q = 0; q < 4; ++q) { const int row = min(row0 + q * rstr, NTOK - 1); rv[q] = row_load(row < NTL ? a.in[0] + (size_t)row * DM : a.in[2] + (size_t)(row - NTL) * DM, lane); } }
            _Pragma("unroll") for (int q = 0; q < 4; ++q) { const int row = row0 + q * rstr;
                if (row < rend) { const int mb = row < NTL ? (row >> 12) : 4; norm_mod_finish(rv[q], a.in[6], MOD + mb * 6144, MOD + mb * 6144 + 1024, HM + (size_t)row * DM, lane); } }
        }
        if (PROBE_PHT == 35) { asm volatile("s_waitcnt vmcnt(0)" ::: "memory"); phtacc_ = __builtin_amdgcn_s_memrealtime() - pht0_; }
    })
    PHASE(2, {
        pg8::Gemm g{(const bf16_t*)(ws + WS_HMOD), (const bf16_t*)(ws + WS_WTIN), DM, DM, DM};
        pg8::StaticOrder S; S.init(NTOK, DINP, nb, bid);
        pg8::EpiZ E{(bf16_t*)(ws + WS_Z), (bf16_t*)(ws + WS_AALL), (bf16_t*)(ws + WS_SIG)};
        pg8::gemm_phase(lds, g, S, E);
        constexpr int G1_FULL = (NTOK / 256) * (DINP / 256) - 2 * 256;
        static_assert(G1_FULL == 100, "phase 1 splits the S5 table slices and the rmsnorm rows at workgroup 100");
        if (nb == 256 && bid >= G1_FULL) { __syncthreads(); p0_weights(a, lds, bid - G1_FULL, nb - G1_FULL, 1); p0_s5(a, lds, bid - G1_FULL, nb - G1_FULL, 100, 256); }
        else if (nb != 256) { __syncthreads(); p0_weights(a, lds, bid, nb, 1); }
        if (PROBE_PHT == 34) { asm volatile("s_waitcnt vmcnt(0)" ::: "memory"); phtacc_ = __builtin_amdgcn_s_memrealtime() - pht0_; }
    })
    PHASE(3, {
        int k3_ = S5U; asm volatile("" : "+s"(k3_));
        pg8::Gemm g{(const bf16_t*)(ws + WS_AALL), (const bf16_t*)(ws + WS_BT2), S5K1, S5U, k3_};
        pg8::S5Order2 S{nb, bid};
        pg8::EpiE E{(float*)(ws + WS_E)};
        _Pragma("unroll 1") for (int r_ = 0; r_ <= ((PROBE_RPT >> 26) & 1); ++r_) pg8::gemm_phase(lds, g, S, E);
        constexpr int NE = 32 * S5NRT;
        if (nb > NE + 32) { if (bid >= NE) { _Pragma("unroll 1") for (int r_ = 0; r_ <= ((PROBE_RPT >> 27) & 1); ++r_) p1_s5(a, lds, bid - NE, nb - NE); } }
        else { __syncthreads(); p1_s5(a, lds, bid, nb); }
    })
    PHASE(4, { p_s5_carry(a, lds, bid, nb); if ((PROBE_RPT >> 23) & 1) { for (int q_ = 0; q_ < 10; ++q_) xcd_barrier(xbar); } })
    PHASE(5, {
        const bool xcd8 = (nb == 256); const int yidx = xcd8 ? (bid & 7) * 16 + (bid >> 3) : bid; const bool ywg = xcd8 ? (bid >> 3) < 16 : bid < nb / 2;
        if (ywg) {
            pg8::Gemm g{(const bf16_t*)(ws + WS_AALL), (const bf16_t*)(ws + WS_BT1), S5K1, S5K1, S5K1};
            pg8::S5Order1 S{nb / 2, yidx};
            pg8::EpiY E{(const bf16_t*)(ws + WS_AALL), a.in[28], (bf16_t*)(ws + WS_ZG)};
            _Pragma("unroll 1") for (int r_ = 0; r_ <= ((PROBE_RPT >> 24) & 1); ++r_) pg8::gemm_phase(lds, g, S, E);
        } else {
            pg8::Gemm g2{(const bf16_t*)(ws + WS_SIG), (const bf16_t*)(ws + WS_G2T), 256, 256, 256};
            pg8::StaticOrder S2; S2.init(NTL, 512, nb - nb / 2, xcd8 ? (bid & 7) * 16 + (bid >> 3) - 16 : bid - nb / 2);
            pg8::EpiG E2{(bf16_t*)(ws + WS_GATE)};
            _Pragma("unroll 1") for (int r_ = 0; r_ <= ((PROBE_RPT >> 25) & 1); ++r_) pg8::gemm_phase(lds, g2, S2, E2);
        }
    })
#pragma unroll 1
    for (int rep6 = 0; rep6 <= ((PROBE_RPT >> 6) & 1); ++rep6) {
        if (rep6) xcd_barrier(xbar);
#pragma unroll 1
        for (int st = 0; st < 2; ++st) {
            if (PROBE_PHT == 6 + 2 * st) pht0_ = __builtin_amdgcn_s_memrealtime();
            if (IN(6 + 2 * st)) { p_rwkv_A(a, lds, bid, nb, st); if ((PROBE_RPT >> 16) & 1) { xcd_barrier(xbar); p_rwkv_A(a, lds, bid, nb, st); } }
            if (IN(6 + 2 * st) && IN(7 + 2 * st)) xcd_barrier(xbar);
            if (PROBE_PHT == 6 + 2 * st) phtacc_ = __builtin_amdgcn_s_memrealtime() - pht0_;
            if (PROBE_PHT == 7 + 2 * st) pht0_ = __builtin_amdgcn_s_memrealtime();
            if (IN(7 + 2 * st)) { p_rwkv_S(a, lds, bid, nb, st); if ((PROBE_RPT >> 17) & 1) { xcd_barrier(xbar); p_rwkv_S(a, lds, bid, nb, st); } }
            if (st == 0 && IN(7) && IN(8)) xcd_barrier(xbar);
            if (PROBE_PHT == 7 && st == 0) phtacc_ = __builtin_amdgcn_s_memrealtime() - pht0_;
        }
    }
    SEAM(9);
    if (PROBE_PHT == 9) phtacc_ = __builtin_amdgcn_s_memrealtime() - pht0_;
    PHASE(10, {
        p_rwkv_readout(a, bid, nb);
        __syncthreads();
        pg8::Gemm g{(const bf16_t*)(ws + WS_ZG), (const bf16_t*)(ws + WS_WTGLU), 16, 512, 512, NTL * 16};
        pg8::StaticOrder S; S.init(NTL, 512, nb, bid);
        pg8::EpiGLU E{(const bf16_t*)(ws + WS_ZG), a.in[30], (bf16_t*)(ws + WS_MIX)};
        pg8::gemm_phase(lds, g, S, E);
    })
    if (PROBE_PHT >= 41 && PROBE_PHT <= 44) pht0_ = __builtin_amdgcn_s_memrealtime();
    PHASE(11, {
        pg8::Gemm g{(const bf16_t*)(ws + WS_MIX), (const bf16_t*)(ws + WS_WTOUT), DM, DM, DM};
        pg8::StaticOrder S; S.init(NTL, DM, nb, bid);
        pg8::PanelSumsq st{(float*)(ws + WS_XBUF), (unsigned*)(ws + WS_CTL + 16384)};
        pg8::EpiWoutNorm E{a.in[0], (float*)(ws + WS_X1F), MOD, a.in[7], (bf16_t*)(ws + WS_HMOD), st, (unsigned long long*)(ws + WS_CTL + 49152 + 512)};
        pg8::gemm_phase(lds, g, S, E);
    })
    PHASE(13, {
        pg8::Gemm g{(const bf16_t*)(ws + WS_HMOD), (const bf16_t*)(ws + WS_WT13), 16, DM, DM, NTL * 16};
        pg8::StaticOrder S; S.init(NTL, 2 * DFF, nb, bid);
        pg8::EpiUp E{(bf16_t*)(ws + WS_ACT)};
        pg8::gemm_phase(lds, g, S, E);
    })
    if (PROBE_PHT == 14) pht0_ = __builtin_amdgcn_s_memrealtime();
    if (IN(14)) {
        pg8::Gemm g{(const bf16_t*)(ws + WS_ACT), (const bf16_t*)(ws + WS_WT2), 16, DFF, DFF, NTL * 16};
        pg8::StaticOrder S; S.init(NTL, DM, nb, bid);
        pg8::PanelSumsq st{(float*)(ws + WS_XBUF) + 64 * 256 * 4, (unsigned*)(ws + WS_CTL + 32768)};
        pg8::EpiDownNorm E{a.out, (const float*)(ws + WS_X1F), MOD, a.in[34], st};
        pg8::gemm_phase(lds, g, S, E);
    }
    if (PROBE_PHT == 14) { asm volatile("s_waitcnt vmcnt(0)" ::: "memory"); __syncthreads(); phtacc_ = __builtin_amdgcn_s_memrealtime() - pht0_; }
#undef PHASE
    if (PROBE_PHT >= 41 && PROBE_PHT <= 44 && bid == PROBE_BID && tid == 0) phtacc_ = *(volatile unsigned long long*)(ws + WS_CTL + 49152 + 512) - pht0_;
    if (PROBE_PHT >= 0 && bid == PROBE_BID && tid == 0) { const unsigned long long t0_ = __builtin_amdgcn_s_memrealtime(); while (__builtin_amdgcn_s_memrealtime() - t0_ < 64ull * phtacc_) __builtin_amdgcn_s_sleep(8); }
#undef IN
#undef SEAM
}

extern "C" void kernel_launch(void* const* d_in, const int* in_sizes, int n_in, void* d_out, int out_size, void* d_ws, size_t ws_size, hipStream_t stream) {
    static int grid_blocks = 0;
    if (!grid_blocks) {
        int dev = 0, cus = 0, per_cu = 0;
        (void)hipGetDevice(&dev);
        (void)hipDeviceGetAttribute(&cus, hipDeviceAttributeMultiprocessorCount, dev);
        if (hipFuncSetAttribute((const void*)mega, hipFuncAttributeMaxDynamicSharedMemorySize, LDS_BYTES) != hipSuccess) fprintf(stderr, "hipFuncSetAttribute failed\n");
        (void)hipOccupancyMaxActiveBlocksPerMultiprocessor(&per_cu, (const void*)mega, NTHREADS, LDS_BYTES);
        if (ws_size < WS_END || n_in != 35) { fprintf(stderr, "kernel_launch: need %zu bytes of workspace (have %zu), 35 inputs (have %d)\n", (size_t)WS_END, ws_size, n_in); grid_blocks = -1; return; }
        if (per_cu < 1) { fprintf(stderr, "kernel_launch: occupancy query says %d blocks per CU\n", per_cu); per_cu = 1; }
        grid_blocks = cus;
        if (cus != 256) fprintf(stderr, "kernel_launch: built for a 256-CU device (the fused-norm GEMM epilogues need exactly one 256x256 unit per workgroup); got %d CUs\n", cus);
    }
    if (grid_blocks < 0) return;
    Args a{};
    for (int i = 0; i < 35; ++i) a.in[i] = (const float*)d_in[i];
    a.out = (float*)d_out; a.ws = (unsigned char*)d_ws; a.ph_lo = 0; a.ph_hi = NPH;
    (void)hipMemsetAsync((char*)d_ws + WS_CTL, 0, CTL_BYTES, stream);
    void* args[] = {&a};
    hipError_t e = hipLaunchCooperativeKernel((const void*)mega, dim3(grid_blocks), dim3(NTHREADS), args, LDS_BYTES, stream);
    if (e != hipSuccess) fprintf(stderr, "cooperative launch failed: %s (grid %d)\n", hipGetErrorString(e), grid_blocks);
}
```
